# Optimizing an MI355X kernel written in HIP

```python
import jax
import jax.numpy as jnp
from jax import lax
import numpy as np

D_MODEL = 1024
BATCH = 8
SEQ = 2048
DEPTH = 4

GRID_W = 64
CTX_LEN = 256

FNET_GROUPS = 4
FNET_CH = 64
D_FNET = FNET_GROUPS * FNET_CH

MLA_HEADS = 6
MLA_Q_RANK = 256
MLA_KV_RANK = 128
MLA_NOPE = 64
MLA_ROPE = 32
MLA_QK = MLA_NOPE + MLA_ROPE
MLA_V = 64

SWA_HEADS = 6
SWA_KV_HEADS = 2
SWA_HEAD_DIM = 64
WINDOW = 128
BLOCK = 128
Q_BLOCK = 128

D_MIX = D_FNET + MLA_HEADS * MLA_V + SWA_HEADS * SWA_HEAD_DIM
IN_SIZES = (D_FNET, MLA_Q_RANK, MLA_KV_RANK, MLA_ROPE,
            SWA_HEADS * SWA_HEAD_DIM, SWA_KV_HEADS * SWA_HEAD_DIM, SWA_KV_HEADS * SWA_HEAD_DIM)
D_IN = sum(IN_SIZES)
IN_SPLITS = tuple(int(v) for v in np.cumsum(IN_SIZES)[:-1])

N_EXPERTS = 16
N_EXPERT_GROUPS = 4
EXPERTS_PER_GROUP = N_EXPERTS // N_EXPERT_GROUPS
TOP_K = 2
D_EXPERT = 512

ROPE_THETA = 10000.0
EPS = 1e-6

kernel_name = "hybrid_dit_fnet_mla_swa_moe"


def rmsnorm(x, g):
    xf = x.astype(jnp.float32)
    y = xf * lax.rsqrt(jnp.mean(xf * xf, axis=-1, keepdims=True) + EPS)
    return (y * g.astype(jnp.float32)).astype(x.dtype)


def axial_rope_table(rows, cols, d_rot):
    d_axis = d_rot // 2
    inv = ROPE_THETA ** (-jnp.arange(0, d_axis, 2, dtype=jnp.float32) / d_axis)
    ar = rows.astype(jnp.float32)[:, None] * inv
    ac = cols.astype(jnp.float32)[:, None] * inv
    ang = jnp.concatenate([ar, ar, ac, ac], axis=-1)
    return jnp.cos(ang)[:, None, :], jnp.sin(ang)[:, None, :]


def apply_axial_rope(x, cos, sin):
    a1, a2, b1, b2 = jnp.split(x, 4, axis=-1)
    rot = jnp.concatenate([-a2, a1, -b2, b1], axis=-1)
    return (x * cos + rot * sin).astype(x.dtype)


def rope_tail(x, cos, sin):
    return jnp.concatenate([x[..., :MLA_NOPE], apply_axial_rope(x[..., MLA_NOPE:], cos, sin)], axis=-1)


def mixer_inputs(h, w_in, cq_g, ckv_g, w_uq, w_uk, w_uv, mq_g, mk_g, sq_g, sk_g, rope, with_queries=True):
    B, N, _ = h.shape
    p = h @ w_in
    u_f, cq, ckv, k_r, q_s, k_s, v_s = jnp.split(p, IN_SPLITS, axis=-1)
    ckv = rmsnorm(ckv, ckv_g)
    k_nope = (ckv @ w_uk).reshape(B, N, MLA_HEADS, MLA_NOPE)
    v_m = (ckv @ w_uv).reshape(B, N, MLA_HEADS, MLA_V)
    k_rope = jnp.broadcast_to(k_r[:, :, None, :], (B, N, MLA_HEADS, MLA_ROPE))
    k_m = rmsnorm(jnp.concatenate([k_nope, k_rope], axis=-1), mk_g)
    k_s = rmsnorm(k_s.reshape(B, N, SWA_KV_HEADS, SWA_HEAD_DIM), sk_g)
    v_s = v_s.reshape(B, N, SWA_KV_HEADS, SWA_HEAD_DIM)
    if rope is not None:
        cos_m, sin_m, cos_s, sin_s = rope
        k_m = rope_tail(k_m, cos_m, sin_m)
        k_s = apply_axial_rope(k_s, cos_s, sin_s)
    if not with_queries:
        return None, None, k_m, v_m, None, k_s, v_s
    q_m = rmsnorm((rmsnorm(cq, cq_g) @ w_uq).reshape(B, N, MLA_HEADS, MLA_QK), mq_g)
    q_s = rmsnorm(q_s.reshape(B, N, SWA_HEADS, SWA_HEAD_DIM), sq_g)
    if rope is not None:
        q_m = rope_tail(q_m, cos_m, sin_m)
        q_s = apply_axial_rope(q_s, cos_s, sin_s)
    return u_f, q_m, k_m, v_m, q_s, k_s, v_s


def fourier_mix(u, w):
    B, N, _ = u.shape
    ug = u.reshape(B, N, FNET_GROUPS, FNET_CH).astype(jnp.float32)
    f = jnp.fft.fft2(ug, axes=(1, 3), norm='ortho').real.astype(u.dtype)
    return jnp.einsum('bngc,gce->bnge', f, w).reshape(B, N, D_FNET)


def dense_attend_blocks(q, k, v):
    B, S, H, d = q.shape
    nb = S // Q_BLOCK
    qb = jnp.moveaxis(q.reshape(B, nb, Q_BLOCK, H, d), 1, 0)
    scale = d ** -0.5

    def one_block(qi):
        s = jnp.einsum('bqhd,bkhd->bhqk', qi, k, preferred_element_type=jnp.float32) * scale
        p = jax.nn.softmax(s, axis=-1).astype(v.dtype)
        return jnp.einsum('bhqk,bkhd->bqhd', p, v)

    out = lax.map(one_block, qb)
    return jnp.moveaxis(out, 0, 1).reshape(B, S, H * v.shape[-1])


def window_attend(q, k, v, k_ctx, v_ctx, sink):
    B, S, H, d = q.shape
    kvh = k.shape[2]
    g = H // kvh
    nb = S // BLOCK
    qb = q.reshape(B, nb, BLOCK, kvh, g, d)

    def band(t):
        tp = jnp.pad(t, ((0, 0), (BLOCK, BLOCK), (0, 0), (0, 0)))
        tb = tp.reshape(B, nb + 2, BLOCK, kvh, d)
        return jnp.concatenate([tb[:, :-2], tb[:, 1:-1], tb[:, 2:]], axis=2)

    kb, vb = band(k), band(v)
    scale = d ** -0.5
    s_loc = jnp.einsum('bnqkgd,bnjkd->bnkgqj', qb, kb, preferred_element_type=jnp.float32) * scale
    kpos = jnp.arange(3 * BLOCK) - BLOCK
    rel = kpos[None, :] - jnp.arange(BLOCK)[:, None]
    kabs = jnp.arange(nb)[:, None, None] * BLOCK + kpos[None, None, :]
    valid = (jnp.abs(rel) <= WINDOW)[None] & (kabs >= 0) & (kabs < S)
    s_loc = jnp.where(valid[None, :, None, None], s_loc, -jnp.inf)
    s_ctx = jnp.einsum('bnqkgd,bjkd->bnkgqj', qb, k_ctx, preferred_element_type=jnp.float32) * scale
    s_sink = jnp.broadcast_to(sink.astype(jnp.float32).reshape(1, 1, kvh, g, 1, 1), s_loc.shape[:-1] + (1,))
    p = jax.nn.softmax(jnp.concatenate([s_loc, s_ctx, s_sink], axis=-1), axis=-1).astype(v.dtype)
    n_loc = 3 * BLOCK
    n_ctx = k_ctx.shape[1]
    out = (jnp.einsum('bnkgqj,bnjkd->bnqkgd', p[..., :n_loc], vb)
           + jnp.einsum('bnkgqj,bjkd->bnqkgd', p[..., n_loc:n_loc + n_ctx], v_ctx))
    return out.reshape(B, S, H * d)


def context_gqa_attend(q, k, v, sink):
    B, C, H, d = q.shape
    kvh = k.shape[2]
    g = H // kvh
    qg = q.reshape(B, C, kvh, g, d)
    s = jnp.einsum('bqkgd,bjkd->bkgqj', qg, k, preferred_element_type=jnp.float32) * d ** -0.5
    s_sink = jnp.broadcast_to(sink.astype(jnp.float32).reshape(1, kvh, g, 1, 1), s.shape[:-1] + (1,))
    p = jax.nn.softmax(jnp.concatenate([s, s_sink], axis=-1), axis=-1).astype(v.dtype)
    out = jnp.einsum('bkgqj,bjkd->bqkgd', p[..., :k.shape[1]], v)
    return out.reshape(B, C, H * d)


def moe_ffn(h, router_w, router_b, w_gate, w_up, w_down):
    T = h.shape[0]
    aff = jax.nn.sigmoid(jnp.einsum('td,de->te', h, router_w, preferred_element_type=jnp.float32))
    sel = aff + router_b.astype(jnp.float32)
    gscore = lax.top_k(sel.reshape(T, N_EXPERT_GROUPS, EXPERTS_PER_GROUP), TOP_K)[0].sum(-1)
    gbest = jnp.argmax(gscore, axis=-1)
    in_group = (jnp.arange(N_EXPERTS) // EXPERTS_PER_GROUP)[None, :] == gbest[:, None]
    _, idx = lax.top_k(jnp.where(in_group, sel, -jnp.inf), TOP_K)
    wsel = jnp.take_along_axis(aff, idx, axis=-1)
    wsel = wsel / jnp.sum(wsel, axis=-1, keepdims=True)
    gates = jnp.einsum('tk,tke->te', wsel, jax.nn.one_hot(idx, N_EXPERTS, dtype=jnp.float32)).astype(h.dtype)
    y = jnp.zeros_like(h)
    for e in range(N_EXPERTS):
        a = jax.nn.silu(h @ w_gate[e]) * (h @ w_up[e])
        y = y + gates[:, e:e + 1] * (a @ w_down[e])
    return y


def setup_inputs(seed: int = 0) -> dict:
    key = jax.random.key(seed)
    ks = jax.random.split(key, 26)
    f32 = jnp.float32

    def nrm(k, shape, fan_in, mult=1.0):
        return jax.random.normal(k, shape, f32) * (mult * fan_in ** -0.5)

    def gain(k, shape):
        return 1.0 + 0.1 * jax.random.normal(k, shape, f32)

    return {
        'x': jax.random.normal(ks[0], (BATCH, SEQ, D_MODEL), f32),
        'c': jax.random.normal(ks[1], (BATCH, D_MODEL), f32),
        'ctx': jax.random.normal(ks[2], (BATCH, CTX_LEN, D_MODEL), f32),
        'c_ctx': jax.random.normal(ks[3], (D_MODEL,), f32),
        'ada_w': nrm(ks[4], (DEPTH, D_MODEL, 6 * D_MODEL), D_MODEL, 0.5),
        'ada_b': 0.02 * jax.random.normal(ks[5], (DEPTH, 6 * D_MODEL), f32),
        'norm1_g': gain(ks[6], (DEPTH, D_MODEL)),
        'norm2_g': gain(ks[7], (DEPTH, D_MODEL)),
        'w_in': nrm(ks[8], (DEPTH, D_MODEL, D_IN), D_MODEL),
        'fnet_w': nrm(ks[9], (DEPTH, FNET_GROUPS, FNET_CH, FNET_CH), FNET_CH),
        'mla_cq_g': gain(ks[10], (DEPTH, MLA_Q_RANK)),
        'mla_ckv_g': gain(ks[11], (DEPTH, MLA_KV_RANK)),
        'mla_w_uq': nrm(ks[12], (DEPTH, MLA_Q_RANK, MLA_HEADS * MLA_QK), MLA_Q_RANK),
        'mla_w_uk': nrm(ks[13], (DEPTH, MLA_KV_RANK, MLA_HEADS * MLA_NOPE), MLA_KV_RANK),
        'mla_w_uv': nrm(ks[14], (DEPTH, MLA_KV_RANK, MLA_HEADS * MLA_V), MLA_KV_RANK),
        'mla_q_g': gain(ks[15], (DEPTH, MLA_QK)),
        'mla_k_g': gain(ks[16], (DEPTH, MLA_QK)),
        'swa_q_g': gain(ks[17], (DEPTH, SWA_HEAD_DIM)),
        'swa_k_g': gain(ks[18], (DEPTH, SWA_HEAD_DIM)),
        'swa_sink': 0.5 * jax.random.normal(ks[19], (DEPTH, SWA_HEADS), f32),
        'w_out': nrm(ks[20], (DEPTH, D_MIX, D_MODEL), D_MIX),
        'router_w': nrm(ks[21], (D_MODEL, N_EXPERTS), D_MODEL),
        'router_b': 0.01 * jax.random.normal(ks[22], (N_EXPERTS,), f32),
        'exp_w_gate': nrm(ks[23], (DEPTH, N_EXPERTS, D_MODEL, D_EXPERT), D_MODEL),
        'exp_w_up': nrm(ks[24], (DEPTH, N_EXPERTS, D_MODEL, D_EXPERT), D_MODEL),
        'exp_w_down': nrm(ks[25], (DEPTH, N_EXPERTS, D_EXPERT, D_MODEL), D_EXPERT),
    }


def reference(x, c, ctx, c_ctx, ada_w, ada_b, norm1_g, norm2_g, w_in, fnet_w,
              mla_cq_g, mla_ckv_g, mla_w_uq, mla_w_uk, mla_w_uv, mla_q_g, mla_k_g,
              swa_q_g, swa_k_g, swa_sink, w_out, router_w, router_b,
              exp_w_gate, exp_w_up, exp_w_down):
    B, S, D = x.shape
    C = ctx.shape[1]
    ROWS = S // GRID_W
    rows = jnp.repeat(jnp.arange(ROWS), GRID_W)
    cols = jnp.arange(ROWS * GRID_W) % GRID_W
    rope = axial_rope_table(rows, cols, MLA_ROPE) + axial_rope_table(rows, cols, SWA_HEAD_DIM)
    silu_c = jax.nn.silu(c)
    silu_cc = jax.nn.silu(c_ctx)

    for l in range(DEPTH):
        last = l == DEPTH - 1
        sh1, sc1, g1, sh2, sc2, g2 = jnp.split((silu_c @ ada_w[l] + ada_b[l])[:, None, :], 6, axis=-1)
        csh1, csc1, cg1, csh2, csc2, cg2 = jnp.split(silu_cc @ ada_w[l] + ada_b[l], 6, axis=-1)
        mix_w = (w_in[l], mla_cq_g[l], mla_ckv_g[l], mla_w_uq[l], mla_w_uk[l], mla_w_uv[l],
                 mla_q_g[l], mla_k_g[l], swa_q_g[l], swa_k_g[l])

        hx = rmsnorm(x, norm1_g[l]) * (1.0 + sc1) + sh1
        hc = rmsnorm(ctx, norm1_g[l]) * (1.0 + csc1) + csh1
        fx, qmx, kmx, vmx, qsx, ksx, vsx = mixer_inputs(hx, *mix_w, rope=rope)
        fc, qmc, kmc, vmc, qsc, ksc, vsc = mixer_inputs(hc, *mix_w, rope=None, with_queries=not last)
        out_x = jnp.concatenate([
            fourier_mix(fx, fnet_w[l]),
            dense_attend_blocks(qmx, jnp.concatenate([kmx, kmc], axis=1), jnp.concatenate([vmx, vmc], axis=1)),
            window_attend(qsx, ksx, vsx, ksc, vsc, swa_sink[l]),
        ], axis=-1)
        x = x + g1 * (out_x @ w_out[l])
        if not last:
            out_c = jnp.concatenate([
                fourier_mix(fc, fnet_w[l]),
                dense_attend_blocks(qmc, kmc, vmc),
                context_gqa_attend(qsc, ksc, vsc, swa_sink[l]),
            ], axis=-1)
            ctx = ctx + cg1 * (out_c @ w_out[l])

        moe_w = (router_w, router_b, exp_w_gate[l], exp_w_up[l], exp_w_down[l])
        h2x = (rmsnorm(x, norm2_g[l]) * (1.0 + sc2) + sh2).reshape(B * S, D)
        if last:
            x = x + g2 * moe_ffn(h2x, *moe_w).reshape(B, S, D)
        else:
            h2c = (rmsnorm(ctx, norm2_g[l]) * (1.0 + csc2) + csh2).reshape(B * C, D)
            y = moe_ffn(jnp.concatenate([h2x, h2c], axis=0), *moe_w)
            x = x + g2 * y[:B * S].reshape(B, S, D)
            ctx = ctx + cg2 * y[B * S:].reshape(B, C, D)
    return x
```

```cpp
#include <hip/hip_runtime.h>
#include <cstdint>
#include <cstdio>

#ifndef N_LAUNCH_MODE
#define N_LAUNCH_MODE 0
#endif

#define LAS __attribute__((address_space(3)))
typedef unsigned short bf16_t;
typedef short bf16x8 __attribute__((ext_vector_type(8)));
typedef float f32x4 __attribute__((ext_vector_type(4)));
typedef float f32x16 __attribute__((ext_vector_type(16)));
typedef unsigned u32x4 __attribute__((ext_vector_type(4)));
typedef unsigned u32x2 __attribute__((ext_vector_type(2)));

constexpr int D = 1024, NB = 8, SEQ = 2048, CL = 256, DEPTH = 4;
constexpr int TL = NB * SEQ, TC = NB * CL, T = TL + TC;
constexpr int DIN = 1312, DINP = 1408;
constexpr int NE = 16, DE = 512;
constexpr int PC_CQ = 256, PC_CKV = 512, PC_QS = 640, PC_KS = 1024, PC_VS = 1152, PC_KR = 1280;
constexpr float EPS = 1e-6f;
constexpr float LOG2E = 1.4426950408889634f;
constexpr int NTHREADS = 256;
constexpr int LDS_BYTES = 65536 + 16;

constexpr size_t al256(size_t x) { return (x + 255) & ~(size_t)255; }
constexpr size_t WS_CTL = 0;
constexpr size_t CTL_BYTES = 32768;
constexpr size_t CTL_CNT_OFF = 16384;
constexpr size_t WS_MOD = WS_CTL + CTL_BYTES;
constexpr size_t WS_ROPES = WS_MOD + al256((size_t)DEPTH * 9 * 6144 * 4);
constexpr size_t WS_ROPEM = WS_ROPES + (size_t)2048 * 32 * 8;
constexpr size_t WS_FW = WS_ROPEM + (size_t)2048 * 16 * 8;
constexpr size_t WS_CS = WS_FW + (size_t)DEPTH * 4 * 128 * 64 * 2;
constexpr size_t WS_CSC = WS_CS + (size_t)2048 * 4096 * 2;
constexpr size_t WS_WIN = WS_CSC + (size_t)256 * 512 * 2;
constexpr size_t WS_WUQ = WS_WIN + (size_t)DEPTH * DINP * 1024 * 2;
constexpr size_t WS_WUKV = WS_WUQ + (size_t)DEPTH * 640 * 256 * 2;
constexpr size_t WS_WOUT = WS_WUKV + (size_t)DEPTH * 768 * 128 * 2;
constexpr size_t WS_WGU = WS_WOUT + (size_t)DEPTH * 1024 * 1024 * 2;
constexpr size_t WS_WDN = WS_WGU + (size_t)DEPTH * NE * 1024 * 1024 * 2;
constexpr size_t WS_CTX = WS_WDN + (size_t)DEPTH * NE * 1024 * 512 * 2;
constexpr size_t WS_SSQ = WS_CTX + (size_t)TC * D * 4;
constexpr size_t WS_HBUF = WS_SSQ + (size_t)T * 8 * 4;
constexpr size_t WS_R = WS_HBUF + (size_t)T * D * 2;
constexpr size_t WS_PBUF = WS_R;
constexpr size_t WS_QRAW = WS_PBUF + (size_t)T * DIN * 2;
constexpr size_t WS_KNRAW = WS_QRAW + (size_t)T * 576 * 2;
constexpr size_t WS_QM = WS_KNRAW + (size_t)T * 384 * 2;
constexpr size_t WS_KM = WS_QM + (size_t)T * 576 * 2;
constexpr size_t WS_VMT = WS_KM + (size_t)T * 576 * 2;
constexpr size_t WS_QS = WS_VMT + (size_t)384 * T * 2;
constexpr size_t WS_KS = WS_QS + (size_t)T * 384 * 2;
constexpr size_t WS_VST = WS_KS + (size_t)T * 128 * 2;
constexpr size_t WS_ABT = WS_VST + (size_t)128 * T * 2;
constexpr size_t WS_OUTX = WS_ABT + (size_t)512 * T * 2;
constexpr size_t WS_MIX_END = WS_OUTX + (size_t)T * D * 2;
constexpr size_t WS_YSLOT = WS_R;
constexpr size_t WS_ACT = WS_YSLOT + (size_t)2 * T * D * 2;
constexpr size_t WS_LIST = WS_ACT + (size_t)(2 * T + 2048) * DE * 2;
constexpr size_t WS_MOE_END = WS_LIST + (size_t)NE * T * 8;
constexpr size_t WS_END = WS_MIX_END > WS_MOE_END ? WS_MIX_END : WS_MOE_END;

#define XB_TMO      128
#define XB_XCNT(j)  (256  + 64 * (j))
#define XB_XSUB(j)  (1280 + 64 * (j))
#define XB_XGEN(j)  (2304 + 64 * (j))
#define XB_TOP      3328
#define XB_TOPGEN   3392
#define XCD_BAR_WORDS 3456
#define XB_SPIN_CAP (1u << 22)

__device__ __forceinline__ unsigned xb_ld(unsigned* p)              { return __hip_atomic_load(p, __ATOMIC_RELAXED, __HIP_MEMORY_SCOPE_AGENT); }
__device__ __forceinline__ unsigned xb_add(unsigned* p, unsigned v) { return __hip_atomic_fetch_add(p, v, __ATOMIC_RELAXED, __HIP_MEMORY_SCOPE_AGENT); }
__device__ __forceinline__ unsigned xb_xcc_id() { return (unsigned)__builtin_amdgcn_s_getreg((3 << 11) | 20) & 0xFu; }
#define XB_SPIN(cond, bar) do { unsigned _sp = 0; while (cond) { __builtin_amdgcn_s_sleep(1); \
    if ((++_sp & 255u) == 0u) { if (xb_ld(&(bar)[XB_TMO])) break; if (_sp > XB_SPIN_CAP) { atomicAdd(&(bar)[XB_TMO], 1u); break; } } } } while (0)

struct XcdBarrier { unsigned* bar; unsigned x; volatile LAS unsigned* st; };

__device__ __forceinline__ XcdBarrier xcd_barrier_post(unsigned* bar, volatile LAS unsigned* st) {
    XcdBarrier b; b.bar = bar; b.x = xb_xcc_id(); b.st = st;
    if (threadIdx.x == 0) (void)xb_add(&bar[XB_XCNT(b.x)], 1u);
    return b;
}
__device__ __forceinline__ void xcd_barrier_complete(unsigned* bar, unsigned x, unsigned& nloc, unsigned& nx) {
    const unsigned G = gridDim.x * gridDim.y * gridDim.z;
    unsigned sum, cnt, mine, sp = 0u;
    for (;;) {
        sum = 0u; cnt = 0u; mine = 0u;
#pragma unroll
        for (unsigned j = 0; j < 16; ++j) { const unsigned c = xb_ld(&bar[XB_XCNT(j)]); sum += c; cnt += (c > 0u) ? 1u : 0u; mine = (j == x) ? c : mine; }
        if (sum == G) break;
        __builtin_amdgcn_s_sleep(1);
        if ((++sp & 255u) == 0u) { if (xb_ld(&bar[XB_TMO])) break; if (sp > XB_SPIN_CAP) { atomicAdd(&bar[XB_TMO], 1u); break; } }
    }
    nloc = mine > 0u ? mine : 1u; nx = cnt > 0u ? cnt : 1u;
}
__device__ __forceinline__ void xcd_barrier(const XcdBarrier& b) {
    asm volatile("s_waitcnt vmcnt(0)" ::: "memory");
    __syncthreads();
    if (threadIdx.x == 0) {
        unsigned* bar = b.bar;
        __builtin_amdgcn_s_waitcnt(0);
        unsigned nloc = b.st[0], nx = b.st[1];
        if (nloc == 0u) { xcd_barrier_complete(bar, b.x, nloc, nx); b.st[0] = nloc; b.st[1] = nx; }
        const unsigned old = xb_add(&bar[XB_XSUB(b.x)], 1u);
        const unsigned gen = old / nloc;
        if (old + 1u == (gen + 1u) * nloc) {
            __builtin_amdgcn_fence(__ATOMIC_RELEASE, "agent");
            asm volatile("s_waitcnt vmcnt(0)" ::: "memory");
            const unsigned og = xb_add(&bar[XB_TOP], 1u);
            const unsigned tg = og / nx;
            if (og + 1u == (tg + 1u) * nx) xb_add(&bar[XB_TOPGEN], 1u);
            else XB_SPIN(xb_ld(&bar[XB_TOPGEN]) == tg, bar);
            __builtin_amdgcn_fence(__ATOMIC_ACQUIRE, "agent");
            xb_add(&bar[XB_XGEN(b.x)], 1u);
            asm volatile("s_waitcnt vmcnt(0)" ::: "memory");
        } else {
            XB_SPIN(xb_ld(&bar[XB_XGEN(b.x)]) == gen, bar);
            __builtin_amdgcn_fence(__ATOMIC_ACQUIRE, "agent");
            asm volatile("s_waitcnt vmcnt(0)" ::: "memory");
        }
    }
    __syncthreads();
}

__device__ __forceinline__ unsigned cvt_pk_bf16(float lo, float hi) { unsigned r; asm("v_cvt_pk_bf16_f32 %0, %1, %2" : "=v"(r) : "v"(lo), "v"(hi)); return r; }
__device__ __forceinline__ float bf2f(bf16_t v) { return __uint_as_float((unsigned)v << 16); }
__device__ __forceinline__ bf16_t f2bf(float v) { return (bf16_t)(cvt_pk_bf16(v, 0.f) & 0xffffu); }
__device__ __forceinline__ float wave_sum(float v) {
#pragma unroll
    for (int o = 32; o >= 1; o >>= 1) v += __shfl_xor(v, o);
    return v;
}
__device__ __forceinline__ float fast_exp2(float x) { return __builtin_amdgcn_exp2f(x); }
__device__ __forceinline__ float silu_f(float v) { return v / (1.0f + __expf(-v)); }
#define VM_WAIT0() asm volatile("s_waitcnt vmcnt(0)" ::: "memory")
#define LAUNDER_S(x) asm volatile("" : "+s"(x))
#define GLDS16(gp, lp) __builtin_amdgcn_global_load_lds((const unsigned*)(gp), (LAS unsigned*)(lp), 16, 0, 0)

struct Params {
    const float* in[26];
    float* out;
    unsigned char* ws;
    int ph_lo, ph_hi;
};
enum { I_X = 0, I_C, I_CTX, I_CCTX, I_ADAW, I_ADAB, I_N1G, I_N2G, I_WIN, I_FNETW, I_CQG, I_CKVG, I_WUQ, I_WUK, I_WUV, I_MQG, I_MKG, I_SQG, I_SKG, I_SINK, I_WOUT, I_RW, I_RB, I_EG, I_EU, I_ED };

struct GemmDesc {
    const bf16_t* A; const bf16_t* B;
    long lda, ldb;
    int K;
    const int* aidx; int aidx_stride;
    int mvalid;
};

__device__ __forceinline__ void gemm_core(const GemmDesc& d, f32x4 (&acc)[4][4], LAS unsigned char* lds, const int tid) {
    const int lane = tid & 63, wid = tid >> 6, wr = wid >> 1, wc = wid & 1, fr = lane & 15, fq = lane >> 4;
    const int srow = tid >> 3;
    const int schunk = (tid & 7) ^ ((tid >> 4) & 7);
    const bf16_t* pa[4]; const bf16_t* pb[4];
#pragma unroll
    for (int i = 0; i < 4; ++i) {
        const int r = i * 32 + srow;
        long ar;
        if (d.aidx) { const int rr = r < d.mvalid ? r : 0; ar = (long)(d.aidx[(long)rr * d.aidx_stride] >> 1); } else ar = r;
        pa[i] = d.A + ar * d.lda + schunk * 8;
        pb[i] = d.B + (long)r * d.ldb + schunk * 8;
    }
    const int nt = d.K >> 6;
#pragma unroll
    for (int mb = 0; mb < 4; ++mb)
#pragma unroll
        for (int nb = 0; nb < 4; ++nb) acc[mb][nb] = (f32x4){0.f, 0.f, 0.f, 0.f};
    const int swz = (fr >> 1) & 7;
    const int aoff = (wr * 64 + fr) * 128, boff = 16384 + (wc * 64 + fr) * 128;
    LAS unsigned char* la = lds + tid * 16;
    for (int t = 0; t < nt; ++t) {
        const long ko = (long)t * 64;
#pragma unroll
        for (int i = 0; i < 4; ++i) {
            GLDS16(pa[i] + ko, la + i * 4096);
            GLDS16(pb[i] + ko, la + 16384 + i * 4096);
        }
        VM_WAIT0(); __syncthreads();
#pragma unroll
        for (int ks = 0; ks < 2; ++ks) {
            bf16x8 af[4], bfr[4];
            const int co = ((ks * 4 + fq) ^ swz) << 4;
#pragma unroll
            for (int mb = 0; mb < 4; ++mb) af[mb] = *(LAS bf16x8*)(lds + aoff + mb * 2048 + co);
#pragma unroll
            for (int nb = 0; nb < 4; ++nb) bfr[nb] = *(LAS bf16x8*)(lds + boff + nb * 2048 + co);
#pragma unroll
            for (int mb = 0; mb < 4; ++mb)
#pragma unroll
                for (int nb = 0; nb < 4; ++nb) acc[mb][nb] = __builtin_amdgcn_mfma_f32_16x16x32_bf16(bfr[nb], af[mb], acc[mb][nb], 0, 0, 0);
        }
        __syncthreads();
    }
}

template <int DQK, bool MASK>
__device__ __forceinline__ void attn_unit(const bf16_t* Qp, int ldq, const bf16_t* Kp, int ldk, const bf16_t* VTp,
                                          int seg0_tok, int seg0_tiles, int seg1_tok, int seg1_tiles,
                                          int qpos0, int seg0_pos, float sink2, bool has_sink, bf16_t* Op, LAS unsigned char* lds, const int tid) {
    constexpr int NKS = DQK / 16;
    constexpr int BUFB = 20480;
    const int lane = tid & 63, wid = tid >> 6, lq = lane & 31, h = lane >> 5;
    bf16x8 qf[NKS];
    {
        const bf16_t* qrow = Qp + (long)(wid * 32 + lq) * ldq + 8 * h;
#pragma unroll
        for (int ks = 0; ks < NKS; ++ks) qf[ks] = *(const bf16x8*)(qrow + ks * 16);
    }
    f32x16 ot[2];
#pragma unroll
    for (int i = 0; i < 16; ++i) { ot[0][i] = 0.f; ot[1][i] = 0.f; }
    float m_run = -INFINITY, l_run = 0.f;
    const int nT = seg0_tiles + seg1_tiles;
    const int srow = tid >> 3, sch8 = (tid & 7) ^ ((tid >> 4) & 7);
    const int srow2 = tid >> 2, sch4 = (tid & 3) ^ ((tid >> 4) & 3);

    auto stage = [&](int i) {
        const long tok = i < seg0_tiles ? (long)seg0_tok + i * 64 : (long)seg1_tok + (i - seg0_tiles) * 64;
        LAS unsigned char* lb = lds + tid * 16;
#pragma unroll
        for (int it = 0; it < 2; ++it) {
            GLDS16(Kp + (tok + it * 32 + srow) * ldk + sch8 * 8, lb + it * 4096);
            GLDS16(VTp + (long)(it * 32 + srow) * T + tok + sch8 * 8, lb + 12288 + it * 4096);
        }
        if (DQK == 96) GLDS16(Kp + (tok + srow2) * ldk + 64 + sch4 * 8, lb + 8192);
    };
    const int qpos = qpos0 + wid * 32 + lq;
    const int kswz = (lq >> 1) & 7, kswz2 = (lq >> 2) & 3;

    for (int i = 0; i < nT; ++i) {
        stage(i);
        VM_WAIT0(); __syncthreads();
        bool active = true;
        if (MASK && i < seg0_tiles) {
            const int k0 = seg0_pos + i * 64, q0w = qpos0 + wid * 32;
            active = (k0 + 63 >= q0w - 128) && (k0 <= q0w + 31 + 128);
        }
        if (active) {
            LAS unsigned char* lb = lds;
            f32x16 st[2];
#pragma unroll
            for (int r = 0; r < 16; ++r) { st[0][r] = 0.f; st[1][r] = 0.f; }
#pragma unroll
            for (int ks = 0; ks < 4; ++ks)
#pragma unroll
                for (int kb = 0; kb < 2; ++kb) {
                    const bf16x8 kf = *(LAS bf16x8*)(lb + (kb * 32 + lq) * 128 + (((ks * 2 + h) ^ kswz) << 4));
                    st[kb] = __builtin_amdgcn_mfma_f32_32x32x16_bf16(kf, qf[ks], st[kb], 0, 0, 0);
                }
            if (DQK == 96) {
#pragma unroll
                for (int ks = 4; ks < NKS; ++ks)
#pragma unroll
                    for (int kb = 0; kb < 2; ++kb) {
                        const bf16x8 kf = *(LAS bf16x8*)(lb + 8192 + (kb * 32 + lq) * 64 + ((((ks - 4) * 2 + h) ^ kswz2) << 4));
                        st[kb] = __builtin_amdgcn_mfma_f32_32x32x16_bf16(kf, qf[ks], st[kb], 0, 0, 0);
                    }
            }
            if (MASK && i < seg0_tiles) {
                const int kbase = seg0_pos + i * 64 + 4 * h - qpos;
#pragma unroll
                for (int kb = 0; kb < 2; ++kb)
#pragma unroll
                    for (int r = 0; r < 16; ++r) {
                        const int dlt = kbase + kb * 32 + (r & 3) + 8 * (r >> 2);
                        if (dlt > 128 || dlt < -128) st[kb][r] = -INFINITY;
                    }
            }
            float mx = st[0][0];
#pragma unroll
            for (int r = 1; r < 16; ++r) mx = fmaxf(mx, st[0][r]);
#pragma unroll
            for (int r = 0; r < 16; ++r) mx = fmaxf(mx, st[1][r]);
            mx = fmaxf(mx, __shfl_xor(mx, 32));
            const float m_new = fmaxf(m_run, mx);
            const float m_use = (m_new == -INFINITY) ? 0.f : m_new;
            const float alpha = fast_exp2(m_run - m_use);
            float ls = 0.f;
#pragma unroll
            for (int kb = 0; kb < 2; ++kb)
#pragma unroll
                for (int r = 0; r < 16; ++r) { const float p = fast_exp2(st[kb][r] - m_use); st[kb][r] = p; ls += p; }
            l_run = l_run * alpha + ls;
            m_run = m_new;
#pragma unroll
            for (int r = 0; r < 16; ++r) { ot[0][r] *= alpha; ot[1][r] *= alpha; }
#pragma unroll
            for (int s = 0; s < 4; ++s) {
                union { u32x4 u; bf16x8 v; } pf;
                const int kb = s >> 1, r0 = 8 * (s & 1);
                pf.u.x = cvt_pk_bf16(st[kb][r0 + 0], st[kb][r0 + 1]); pf.u.y = cvt_pk_bf16(st[kb][r0 + 2], st[kb][r0 + 3]);
                pf.u.z = cvt_pk_bf16(st[kb][r0 + 4], st[kb][r0 + 5]); pf.u.w = cvt_pk_bf16(st[kb][r0 + 6], st[kb][r0 + 7]);
#pragma unroll
                for (int db = 0; db < 2; ++db) {
                    LAS unsigned char* vr = lb + 12288 + (db * 32 + lq) * 128 + 8 * h;
                    union { u32x2 u[2]; bf16x8 v; } vf;
                    vf.u[0] = *(LAS u32x2*)(vr + (((2 * s) ^ kswz) << 4));
                    vf.u[1] = *(LAS u32x2*)(vr + (((2 * s + 1) ^ kswz) << 4));
                    ot[db] = __builtin_amdgcn_mfma_f32_32x32x16_bf16(vf.v, pf.v, ot[db], 0, 0, 0);
                }
            }
        }
        __syncthreads();
    }
    float l = l_run + __shfl_xor(l_run, 32);
    if (has_sink) l += fast_exp2(sink2 - m_run);
    const float inv = 1.0f / l;
    bf16_t* orow = Op + (long)(wid * 32 + lq) * D + 4 * h;
#pragma unroll
    for (int db = 0; db < 2; ++db)
#pragma unroll
        for (int g = 0; g < 4; ++g) {
            u32x2 w; w.x = cvt_pk_bf16(ot[db][4 * g] * inv, ot[db][4 * g + 1] * inv); w.y = cvt_pk_bf16(ot[db][4 * g + 2] * inv, ot[db][4 * g + 3] * inv);
            *(u32x2*)(orow + db * 32 + 8 * g) = w;
        }
}

__device__ __forceinline__ int nmap(int mode, int n) {
    if (mode == 1) return n < 640 ? n : (n < 672 ? n + 640 : n - 32);
    if (mode == 2) return ((n >> 4) << 5) + (n & 15);
    if (mode == 3) return ((n >> 4) << 5) + 16 + (n & 15);
    return n;
}
__device__ __forceinline__ void conv_tile(const float* src, int K, int N, bf16_t* dst, int ldd, int mode, const float* kscale, int tk, int tn, LAS unsigned char* lds, const int tid) {
    LAS float* sT = (LAS float*)lds;
    const int k0 = tk * 64, n0 = tn * 64;
    {
        const int c4 = (tid & 15) * 4, rr = tid >> 4;
#pragma unroll
        for (int i = 0; i < 4; ++i) {
            const int kk = rr + 16 * i;
            f32x4 v = (f32x4){0.f, 0.f, 0.f, 0.f};
            if (n0 + c4 < N) v = *(const f32x4*)(src + (long)(k0 + kk) * N + n0 + c4);
            if (kscale) { const float s = kscale[k0 + kk]; v = v * s; }
            sT[kk * 65 + c4 + 0] = v[0]; sT[kk * 65 + c4 + 1] = v[1]; sT[kk * 65 + c4 + 2] = v[2]; sT[kk * 65 + c4 + 3] = v[3];
        }
    }
    __syncthreads();
    {
        const int n = tid >> 2, kc = (tid & 3) * 16;
        if (n0 + n < N) {
            unsigned w[8];
#pragma unroll
            for (int j = 0; j < 8; ++j) w[j] = cvt_pk_bf16(sT[(kc + 2 * j) * 65 + n], sT[(kc + 2 * j + 1) * 65 + n]);
            bf16_t* dp = dst + (long)nmap(mode, n0 + n) * ldd + k0 + kc;
            *(u32x4*)dp = (u32x4){w[0], w[1], w[2], w[3]};
            *(u32x4*)(dp + 8) = (u32x4){w[4], w[5], w[6], w[7]};
        }
    }
    __syncthreads();
}

__device__ __forceinline__ void ada_unit(const Params& P, int l, int n0, LAS unsigned char* lds, const int tid) {
    LAS float* sS = (LAS float*)lds;
    LAS float* sR = sS;
    for (int i = tid; i < 9 * 1024; i += NTHREADS) {
        const int r = i >> 10, k = i & 1023;
        const float v = r < 8 ? P.in[I_C][r * 1024 + k] : P.in[I_CCTX][k];
        sS[i] = silu_f(v);
    }
    __syncthreads();
    const int kg = tid >> 4, c4 = (tid & 15) * 4;
    const float* w = P.in[I_ADAW] + (long)l * 1024 * 6144 + n0 + c4;
    f32x4 acc[9];
#pragma unroll
    for (int r = 0; r < 9; ++r) acc[r] = (f32x4){0.f, 0.f, 0.f, 0.f};
    for (int kk = 0; kk < 64; ++kk) {
        const int k = kg * 64 + kk;
        const f32x4 wv = *(const f32x4*)(w + (long)k * 6144);
#pragma unroll
        for (int r = 0; r < 9; ++r) acc[r] += wv * sS[r * 1024 + k];
    }
    __syncthreads();
#pragma unroll
    for (int r = 0; r < 9; ++r) {
#pragma unroll
        for (int j = 0; j < 4; ++j) sR[(kg * 9 + r) * 64 + c4 + j] = acc[r][j];
    }
    __syncthreads();
    float* mod = (float*)(P.ws + WS_MOD);
    for (int i = tid; i < 9 * 64; i += NTHREADS) {
        const int r = i >> 6, c = i & 63;
        float s = P.in[I_ADAB][l * 6144 + n0 + c];
#pragma unroll
        for (int g = 0; g < 16; ++g) s += sR[(g * 9 + r) * 64 + c];
        mod[((long)l * 9 + r) * 6144 + n0 + c] = s;
    }
    __syncthreads();
}

__device__ __forceinline__ void phase0(const Params& P, LAS unsigned char* lds, const int tid) {
    unsigned char* ws = P.ws;
    constexpr int U_WIN = 4 * 16 * 21, U_WUQ = 4 * 4 * 9, U_WUK = 4 * 2 * 6, U_WUV = U_WUK, U_WOUT = 4 * 256, U_EG = 64 * 128, U_EU = U_EG, U_ED = 64 * 128;
    constexpr int O_WUQ = U_WIN, O_WUK = O_WUQ + U_WUQ, O_WUV = O_WUK + U_WUK, O_WOUT = O_WUV + U_WUV, O_EG = O_WOUT + U_WOUT, O_EU = O_EG + U_EG, O_ED = O_EU + U_EU;
    constexpr int O_ADA = O_ED + U_ED, U_ADA = 4 * 96;
    constexpr int O_CS = O_ADA + U_ADA, U_CS = 256;
    constexpr int O_CSC = O_CS + U_CS, U_CSC = 8;
    constexpr int O_ROPE = O_CSC + U_CSC, U_ROPE = 8;
    constexpr int O_FW = O_ROPE + U_ROPE, U_FW = 16;
    constexpr int U_TOTAL = O_FW + U_FW;
    for (int u = blockIdx.x; u < U_TOTAL; u += gridDim.x) {
        if (u < O_WUQ) { const int m = u / 336, r = u % 336; conv_tile(P.in[I_WIN] + (long)m * 1024 * DIN, 1024, DIN, (bf16_t*)(ws + WS_WIN) + (long)m * DINP * 1024, 1024, 1, nullptr, r / 21, r % 21, lds, tid); }
        else if (u < O_WUK) { const int v = u - O_WUQ, m = v / 36, r = v % 36; conv_tile(P.in[I_WUQ] + (long)m * 256 * 576, 256, 576, (bf16_t*)(ws + WS_WUQ) + (long)m * 640 * 256, 256, 0, P.in[I_CQG] + m * 256, r / 9, r % 9, lds, tid); }
        else if (u < O_WUV) { const int v = u - O_WUK, m = v / 12, r = v % 12; conv_tile(P.in[I_WUK] + (long)m * 128 * 384, 128, 384, (bf16_t*)(ws + WS_WUKV) + (long)m * 768 * 128, 128, 0, P.in[I_CKVG] + m * 128, r / 6, r % 6, lds, tid); }
        else if (u < O_WOUT) { const int v = u - O_WUV, m = v / 12, r = v % 12; conv_tile(P.in[I_WUV] + (long)m * 128 * 384, 128, 384, (bf16_t*)(ws + WS_WUKV) + (long)m * 768 * 128 + 384 * 128, 128, 0, P.in[I_CKVG] + m * 128, r / 6, r % 6, lds, tid); }
        else if (u < O_EG) { const int v = u - O_WOUT, m = v / 256, r = v % 256; conv_tile(P.in[I_WOUT] + (long)m * 1024 * 1024, 1024, 1024, (bf16_t*)(ws + WS_WOUT) + (long)m * 1024 * 1024, 1024, 0, nullptr, r / 16, r % 16, lds, tid); }
        else if (u < O_EU) { const int v = u - O_EG, m = v / 128, r = v % 128; conv_tile(P.in[I_EG] + (long)m * 1024 * 512, 1024, 512, (bf16_t*)(ws + WS_WGU) + (long)m * 1024 * 1024, 1024, 2, nullptr, r / 8, r % 8, lds, tid); }
        else if (u < O_ED) { const int v = u - O_EU, m = v / 128, r = v % 128; conv_tile(P.in[I_EU] + (long)m * 1024 * 512, 1024, 512, (bf16_t*)(ws + WS_WGU) + (long)m * 1024 * 1024, 1024, 3, nullptr, r / 8, r % 8, lds, tid); }
        else if (u < O_ADA) { const int v = u - O_ED, m = v / 128, r = v % 128; conv_tile(P.in[I_ED] + (long)m * 512 * 1024, 512, 1024, (bf16_t*)(ws + WS_WDN) + (long)m * 1024 * 512, 512, 0, nullptr, r / 16, r % 16, lds, tid); }
        else if (u < O_CS) { const int v = u - O_ADA; ada_unit(P, v / 96, (v % 96) * 64, lds, tid); }
        else if (u < O_CSC) {
            const int v = u - O_CS; bf16_t* cs = (bf16_t*)(ws + WS_CS);
            const float sc = 0.022097086912079608f;
            for (int i = tid; i < 8 * 2048; i += NTHREADS) {
                const int k = v * 8 + (i >> 11), np = (i & 2047) * 2;
                float o[2];
#pragma unroll
                for (int j = 0; j < 2; ++j) { const int n = (np + j) & 2047; const float rev = (float)((k * n) & 2047) * (1.0f / 2048.0f);
                    o[j] = (np < 2048) ? __builtin_amdgcn_cosf(rev) * sc : -__builtin_amdgcn_sinf(rev) * sc; }
                *(unsigned*)(cs + (long)k * 4096 + np) = cvt_pk_bf16(o[0], o[1]);
            }
        }
        else if (u < O_ROPE) {
            const int v = u - O_CSC; bf16_t* cs = (bf16_t*)(ws + WS_CSC);
            const float sc = 0.0625f;
            for (int i = tid; i < 32 * 256; i += NTHREADS) {
                const int k = v * 32 + (i >> 8), np = (i & 255) * 2;
                float o[2];
#pragma unroll
                for (int j = 0; j < 2; ++j) { const int n = (np + j) & 255; const float rev = (float)((k * n) & 255) * (1.0f / 256.0f);
                    o[j] = (np < 256) ? __builtin_amdgcn_cosf(rev) * sc : -__builtin_amdgcn_sinf(rev) * sc; }
                *(unsigned*)(cs + (long)k * 512 + np) = cvt_pk_bf16(o[0], o[1]);
            }
        }
        else if (u < O_FW) {
            const int v = u - O_ROPE; float2* rs = (float2*)(ws + WS_ROPES); float2* rm = (float2*)(ws + WS_ROPEM);
            for (int i = tid; i < 256 * 32; i += NTHREADS) {
                const int pos = v * 256 + (i >> 5), j = i & 31; const int pr = pos >> 6, pc = pos & 63;
                const float inv = fast_exp2(-13.287712379549449f * (float)(2 * (j & 15)) * (1.0f / 32.0f));
                const float ang = (float)(j < 16 ? pr : pc) * inv;
                float rev = ang * 0.15915494309189535f; rev -= floorf(rev);
                rs[pos * 32 + j] = make_float2(__builtin_amdgcn_cosf(rev), __builtin_amdgcn_sinf(rev));
            }
            for (int i = tid; i < 256 * 16; i += NTHREADS) {
                const int pos = v * 256 + (i >> 4), j = i & 15; const int pr = pos >> 6, pc = pos & 63;
                const float inv = fast_exp2(-13.287712379549449f * (float)(2 * (j & 7)) * (1.0f / 16.0f));
                const float ang = (float)(j < 8 ? pr : pc) * inv;
                float rev = ang * 0.15915494309189535f; rev -= floorf(rev);
                rm[pos * 16 + j] = make_float2(__builtin_amdgcn_cosf(rev), __builtin_amdgcn_sinf(rev));
            }
        }
        else {
            const int v = u - O_FW, l = v >> 2, g = v & 3;
            const float* w = P.in[I_FNETW] + (long)(l * 4 + g) * 64 * 64;
            bf16_t* fw = (bf16_t*)(ws + WS_FW) + (long)(l * 4 + g) * 128 * 64;
            for (int i = tid; i < 128 * 64; i += NTHREADS) {
                const int f = i >> 6, c = i & 63, cs = f >> 6, e = f & 63;
                float s = 0.f;
                for (int m = 0; m < 64; ++m) {
                    const float rev = (float)((m * c) & 63) * (1.0f / 64.0f);
                    const float tw = cs ? __builtin_amdgcn_sinf(rev) : __builtin_amdgcn_cosf(rev);
                    s += tw * w[m * 64 + e];
                }
                fw[f * 64 + c] = f2bf(s * 0.125f);
            }
        }
    }
}

__device__ __forceinline__ float* xrow(const Params& P, int t) { return t < TL ? P.out + (long)t * D : (float*)(P.ws + WS_CTX) + (long)(t - TL) * D; }

__device__ __forceinline__ void phase_norm1(const Params& P, int l, const int tid) {
    const int lane = tid & 63, gw = blockIdx.x * 4 + (tid >> 6), nw = gridDim.x * 4;
    const float* mod = (const float*)(P.ws + WS_MOD);
    const float* n1g = P.in[I_N1G] + l * D;
    const bf16_t* ys = (const bf16_t*)(P.ws + WS_YSLOT);
    bf16_t* hb = (bf16_t*)(P.ws + WS_HBUF);
    for (int t = gw; t < T; t += nw) {
        const int r = t < TL ? (t >> 11) : 8;
        float* xr = xrow(P, t);
        f32x4 v[4];
        if (l == 0) {
            const float* src = t < TL ? P.in[I_X] + (long)t * D : P.in[I_CTX] + (long)(t - TL) * D;
#pragma unroll
            for (int i = 0; i < 4; ++i) { v[i] = *(const f32x4*)(src + i * 256 + lane * 4); *(f32x4*)(xr + i * 256 + lane * 4) = v[i]; }
        } else {
            const float* g2 = mod + ((long)(l - 1) * 9 + r) * 6144 + 5120;
            const bf16_t* y0 = ys + (long)(2 * t) * D;
#pragma unroll
            for (int i = 0; i < 4; ++i) {
                const int c = i * 256 + lane * 4;
                v[i] = *(const f32x4*)(xr + c);
                const u32x2 a = *(const u32x2*)(y0 + c), b = *(const u32x2*)(y0 + D + c);
                const f32x4 g = *(const f32x4*)(g2 + c);
                f32x4 y;
                y[0] = __uint_as_float(a.x << 16) + __uint_as_float(b.x << 16); y[1] = __uint_as_float(a.x & 0xffff0000u) + __uint_as_float(b.x & 0xffff0000u);
                y[2] = __uint_as_float(a.y << 16) + __uint_as_float(b.y << 16); y[3] = __uint_as_float(a.y & 0xffff0000u) + __uint_as_float(b.y & 0xffff0000u);
                v[i] += g * y;
                *(f32x4*)(xr + c) = v[i];
            }
        }
        float ss = 0.f;
#pragma unroll
        for (int i = 0; i < 4; ++i) ss += v[i][0] * v[i][0] + v[i][1] * v[i][1] + v[i][2] * v[i][2] + v[i][3] * v[i][3];
        ss = wave_sum(ss);
        const float rs = rsqrtf(ss * (1.0f / D) + EPS);
        const float* md = mod + ((long)l * 9 + r) * 6144;
#pragma unroll
        for (int i = 0; i < 4; ++i) {
            const int c = i * 256 + lane * 4;
            const f32x4 g = *(const f32x4*)(n1g + c), sh = *(const f32x4*)(md + c), sc = *(const f32x4*)(md + 1024 + c);
            const f32x4 hv = v[i] * rs * g * (sc + 1.0f) + sh;
            u32x2 w; w.x = cvt_pk_bf16(hv[0], hv[1]); w.y = cvt_pk_bf16(hv[2], hv[3]);
            *(u32x2*)(hb + (long)t * D + c) = w;
        }
    }
}

__device__ __forceinline__ void phase_final(const Params& P, const int tid) {
    const int lane = tid & 63, gw = blockIdx.x * 4 + (tid >> 6), nw = gridDim.x * 4;
    const float* mod = (const float*)(P.ws + WS_MOD);
    const bf16_t* ys = (const bf16_t*)(P.ws + WS_YSLOT);
    for (int t = gw; t < TL; t += nw) {
        const int r = t >> 11;
        float* xr = P.out + (long)t * D;
        const float* g2 = mod + ((long)(DEPTH - 1) * 9 + r) * 6144 + 5120;
        const bf16_t* y0 = ys + (long)(2 * t) * D;
#pragma unroll
        for (int i = 0; i < 4; ++i) {
            const int c = i * 256 + lane * 4;
            f32x4 v = *(const f32x4*)(xr + c);
            const u32x2 a = *(const u32x2*)(y0 + c), b = *(const u32x2*)(y0 + D + c);
            const f32x4 g = *(const f32x4*)(g2 + c);
            f32x4 y;
            y[0] = __uint_as_float(a.x << 16) + __uint_as_float(b.x << 16); y[1] = __uint_as_float(a.x & 0xffff0000u) + __uint_as_float(b.x & 0xffff0000u);
            y[2] = __uint_as_float(a.y << 16) + __uint_as_float(b.y << 16); y[3] = __uint_as_float(a.y & 0xffff0000u) + __uint_as_float(b.y & 0xffff0000u);
            v += g * y;
            *(f32x4*)(xr + c) = v;
        }
    }
}

__device__ __forceinline__ void phase_prep(const Params& P, int l, const int tid) {
    const int lane = tid & 63, gw = blockIdx.x * 4 + (tid >> 6), nw = gridDim.x * 4;
    const bool last = (l == DEPTH - 1);
    const bf16_t* pbuf = (const bf16_t*)(P.ws + WS_PBUF);
    const bf16_t* qraw = (const bf16_t*)(P.ws + WS_QRAW);
    const bf16_t* knraw = (const bf16_t*)(P.ws + WS_KNRAW);
    bf16_t* qm = (bf16_t*)(P.ws + WS_QM); bf16_t* km = (bf16_t*)(P.ws + WS_KM);
    bf16_t* qs = (bf16_t*)(P.ws + WS_QS); bf16_t* ks = (bf16_t*)(P.ws + WS_KS);
    const float2* ropeS = (const float2*)(P.ws + WS_ROPES); const float2* ropeM = (const float2*)(P.ws + WS_ROPEM);
    const float mqg0 = P.in[I_MQG][l * 96 + lane], mqg1 = lane < 32 ? P.in[I_MQG][l * 96 + 64 + lane] : 0.f;
    const float mkg0 = P.in[I_MKG][l * 96 + lane], mkg1 = lane < 32 ? P.in[I_MKG][l * 96 + 64 + lane] : 0.f;
    const float sqg = P.in[I_SQG][l * 64 + lane], skg = P.in[I_SKG][l * 64 + lane];
    const float qsc_m = 0.10206207261596577f * LOG2E;
    const float qsc_s = 0.125f * LOG2E;
    for (int t = gw; t < T; t += nw) {
        const bool lat = t < TL;
        const int pos = t & 2047;
        float2 cm = make_float2(1.f, 0.f), cs2 = make_float2(1.f, 0.f);
        if (lat) { cm = ropeM[pos * 16 + ((lane >> 4) & 1) * 8 + (lane & 7)]; cs2 = ropeS[pos * 32 + (lane >> 5) * 16 + (lane & 15)]; }
        const float sgn_m = (lane & 8) ? 1.f : -1.f, sgn_s = (lane & 16) ? 1.f : -1.f;
        if (lat || !last) {
#pragma unroll 2
            for (int h = 0; h < 6; ++h) {
                const bf16_t* src = qraw + (long)t * 576 + h * 96;
                float a = bf2f(src[lane]), b = lane < 32 ? bf2f(src[64 + lane]) : 0.f;
                const float ss = wave_sum(a * a + b * b);
                const float rs = rsqrtf(ss * (1.0f / 96.0f) + EPS);
                a = a * rs * mqg0; b = b * rs * mqg1;
                const float pb = __shfl_xor(b, 8);
                b = b * cm.x + sgn_m * pb * cm.y;
                bf16_t* dst = qm + (long)t * 576 + h * 96;
                dst[lane] = f2bf(a * qsc_m);
                if (lane < 32) dst[64 + lane] = f2bf(b * qsc_m);
            }
        }
        {
            const float kr = lane < 32 ? bf2f(pbuf[(long)t * DIN + PC_KR + lane]) : 0.f;
#pragma unroll 2
            for (int h = 0; h < 6; ++h) {
                float a = bf2f(knraw[(long)t * 384 + h * 64 + lane]);
                const float ss = wave_sum(a * a + kr * kr);
                const float rs = rsqrtf(ss * (1.0f / 96.0f) + EPS);
                a = a * rs * mkg0; float b = kr * rs * mkg1;
                const float pb = __shfl_xor(b, 8);
                b = b * cm.x + sgn_m * pb * cm.y;
                bf16_t* dst = km + (long)t * 576 + h * 96;
                dst[lane] = f2bf(a);
                if (lane < 32) dst[64 + lane] = f2bf(b);
            }
        }
        if (lat || !last) {
#pragma unroll 2
            for (int h = 0; h < 6; ++h) {
                float a = bf2f(pbuf[(long)t * DIN + PC_QS + h * 64 + lane]);
                const float ss = wave_sum(a * a);
                a = a * rsqrtf(ss * (1.0f / 64.0f) + EPS) * sqg;
                const float pa = __shfl_xor(a, 16);
                a = a * cs2.x + sgn_s * pa * cs2.y;
                qs[(long)t * 384 + h * 64 + lane] = f2bf(a * qsc_s);
            }
        }
#pragma unroll
        for (int h = 0; h < 2; ++h) {
            float a = bf2f(pbuf[(long)t * DIN + PC_KS + h * 64 + lane]);
            const float ss = wave_sum(a * a);
            a = a * rsqrtf(ss * (1.0f / 64.0f) + EPS) * skg;
            const float pa = __shfl_xor(a, 16);
            a = a * cs2.x + sgn_s * pa * cs2.y;
            ks[(long)t * 128 + h * 64 + lane] = f2bf(a);
        }
    }
}

__device__ __forceinline__ void phase_norm2_router(const Params& P, int l, LAS unsigned char* lds, const int tid) {
    const int lane = tid & 63, gw = blockIdx.x * 4 + (tid >> 6), nw = gridDim.x * 4;
    LAS float* rwT = (LAS float*)lds;
    for (int i = tid; i < 16 * 1024; i += NTHREADS) { const int c = i >> 4, e = i & 15; rwT[e * 1024 + c] = P.in[I_RW][i]; }
    __syncthreads();
    const float* mod = (const float*)(P.ws + WS_MOD);
    const float* n2g = P.in[I_N2G] + l * D;
    bf16_t* hb = (bf16_t*)(P.ws + WS_HBUF);
    int* cnt = (int*)(P.ws + WS_CTL + CTL_CNT_OFF) + l * 16;
    int2* list = (int2*)(P.ws + WS_LIST);
    const int tmax = (l == DEPTH - 1) ? TL : T;
    float rb[16];
#pragma unroll
    for (int e = 0; e < 16; ++e) rb[e] = P.in[I_RB][e];
    for (int t = gw; t < tmax; t += nw) {
        const int r = t < TL ? (t >> 11) : 8;
        const float* xr = xrow(P, t);
        f32x4 v[4];
        float ss = 0.f;
#pragma unroll
        for (int i = 0; i < 4; ++i) { v[i] = *(const f32x4*)(xr + i * 256 + lane * 4); ss += v[i][0] * v[i][0] + v[i][1] * v[i][1] + v[i][2] * v[i][2] + v[i][3] * v[i][3]; }
        ss = wave_sum(ss);
        const float rs = rsqrtf(ss * (1.0f / D) + EPS);
        const float* md = mod + ((long)l * 9 + r) * 6144;
#pragma unroll
        for (int i = 0; i < 4; ++i) {
            const int c = i * 256 + lane * 4;
            const f32x4 g = *(const f32x4*)(n2g + c), sh = *(const f32x4*)(md + 3072 + c), sc = *(const f32x4*)(md + 4096 + c);
            v[i] = v[i] * rs * g * (sc + 1.0f) + sh;
            u32x2 w; w.x = cvt_pk_bf16(v[i][0], v[i][1]); w.y = cvt_pk_bf16(v[i][2], v[i][3]);
            *(u32x2*)(hb + (long)t * D + c) = w;
        }
        float lg[16];
#pragma unroll
        for (int e = 0; e < 16; ++e) {
            float s = 0.f;
#pragma unroll
            for (int i = 0; i < 4; ++i) { const f32x4 w = *(LAS f32x4*)(rwT + e * 1024 + i * 256 + lane * 4); s += v[i][0] * w[0] + v[i][1] * w[1] + v[i][2] * w[2] + v[i][3] * w[3]; }
            lg[e] = wave_sum(s);
        }
        float aff[16], sel[16];
#pragma unroll
        for (int e = 0; e < 16; ++e) { aff[e] = 1.0f / (1.0f + __expf(-lg[e])); sel[e] = aff[e] + rb[e]; }
        int gbest = 0; float gmax = -INFINITY;
#pragma unroll
        for (int g = 0; g < 4; ++g) {
            float m1 = -INFINITY, m2 = -INFINITY;
#pragma unroll
            for (int j = 0; j < 4; ++j) { const float s = sel[g * 4 + j]; if (s > m1) { m2 = m1; m1 = s; } else if (s > m2) m2 = s; }
            const float gs = m1 + m2;
            if (gs > gmax) { gmax = gs; gbest = g; }
        }
        float s4[4], a4[4];
#pragma unroll
        for (int j = 0; j < 4; ++j) { s4[j] = -INFINITY; a4[j] = 0.f; }
#pragma unroll
        for (int g = 0; g < 4; ++g) if (g == gbest) {
#pragma unroll
            for (int j = 0; j < 4; ++j) { s4[j] = sel[g * 4 + j]; a4[j] = aff[g * 4 + j]; }
        }
        int i1 = 0; float b1 = s4[0];
#pragma unroll
        for (int j = 1; j < 4; ++j) if (s4[j] > b1) { b1 = s4[j]; i1 = j; }
        int i2 = -1; float b2 = -INFINITY;
#pragma unroll
        for (int j = 0; j < 4; ++j) if (j != i1 && s4[j] > b2) { b2 = s4[j]; i2 = j; }
        float w1 = 0.f, w2 = 0.f;
#pragma unroll
        for (int j = 0; j < 4; ++j) { if (j == i1) w1 = a4[j]; if (j == i2) w2 = a4[j]; }
        const float wn = 1.0f / (w1 + w2);
        if (lane == 0) {
            const int e1 = gbest * 4 + i1, e2 = gbest * 4 + i2;
            const int p1 = atomicAdd(&cnt[e1], 1), p2 = atomicAdd(&cnt[e2], 1);
            list[(long)e1 * T + p1] = make_int2(2 * t, __float_as_int(w1 * wn));
            list[(long)e2 * T + p2] = make_int2(2 * t + 1, __float_as_int(w2 * wn));
        }
    }
}

__global__ void __launch_bounds__(NTHREADS, 2) fwd_kernel(Params P) {
    extern __shared__ __attribute__((aligned(16))) unsigned char lds_raw[];
    LAS unsigned char* lds = (LAS unsigned char*)lds_raw;
    volatile LAS unsigned* xbw = (volatile LAS unsigned*)(lds + 65536);
    if (threadIdx.x < 4) xbw[threadIdx.x] = 0u;
    __syncthreads();
    XcdBarrier bar; bar.bar = (unsigned*)(P.ws + WS_CTL); bar.x = 0; bar.st = xbw;
    const int lo = P.ph_lo, hi = P.ph_hi;
    if (hi - lo > 1) bar = xcd_barrier_post((unsigned*)(P.ws + WS_CTL), xbw);
#ifndef PHASE_MASK
#define PHASE_MASK 0x3ff
#endif
#define EN(c) (((PHASE_MASK) >> (c)) & 1)
#define IN(k) (lo <= (k) && (k) < hi)
#define SEAM(k) do { if (IN((k) + 1)) xcd_barrier(bar); } while (0)
#define TID_ENTER() int tid = threadIdx.x; asm volatile("" : "+v"(tid)); const int lane = tid & 63, wid = tid >> 6, wr = wid >> 1, wc = wid & 1, fr = lane & 15, fq = lane >> 4; (void)wr; (void)wc; (void)fr; (void)fq
#define PHASE_ENTER() TID_ENTER(); unsigned char* ws = P.ws; int l = l0; LAUNDER_S(ws); LAUNDER_S(l); const bool last = (l == DEPTH - 1); const int MT_Q = last ? TL / 128 : T / 128; \
    const float* mod = (const float*)(ws + WS_MOD); float* ssq = (float*)(ws + WS_SSQ); (void)mod; (void)ssq; (void)MT_Q; (void)last

    if (EN(0) && IN(0)) { TID_ENTER(); phase0(P, lds, tid); SEAM(0); }

    for (int l0 = 0; l0 < DEPTH; ++l0) {
        const int pb = 1 + l0 * 9;
        if (EN(1) && IN(pb + 0)) { TID_ENTER(); int l = l0; LAUNDER_S(l); phase_norm1(P, l, tid); SEAM(pb + 0); }
        if (EN(2) && IN(pb + 1)) {
            PHASE_ENTER();
            const bf16_t* hb = (const bf16_t*)(ws + WS_HBUF);
            const bf16_t* w = (const bf16_t*)(ws + WS_WIN) + (long)l * DINP * 1024;
            bf16_t* pbuf = (bf16_t*)(ws + WS_PBUF); bf16_t* vst = (bf16_t*)(ws + WS_VST);
            const int nu = (T / 128) * 11;
            for (int u = blockIdx.x; u < nu; u += gridDim.x) {
                const int mt = u / 11, nt = u % 11;
                GemmDesc g; g.A = hb + (long)mt * 128 * D; g.lda = D; g.B = w + (long)nt * 128 * 1024; g.ldb = 1024; g.K = 1024; g.aidx = nullptr; g.aidx_stride = 0; g.mvalid = 128;
                f32x4 acc[4][4];
                gemm_core(g, acc, lds, tid);
#pragma unroll
                for (int mb = 0; mb < 4; ++mb) {
                    const int t = mt * 128 + wr * 64 + mb * 16 + fr;
                    float sq = 0.f;
#pragma unroll
                    for (int nb = 0; nb < 4; ++nb) {
                        const int col = nt * 128 + wc * 64 + nb * 16 + fq * 4;
                        const f32x4 a = acc[mb][nb];
                        sq += a[0] * a[0] + a[1] * a[1] + a[2] * a[2] + a[3] * a[3];
                        if (col < DIN) {
                            u32x2 w2; w2.x = cvt_pk_bf16(a[0], a[1]); w2.y = cvt_pk_bf16(a[2], a[3]);
                            *(u32x2*)(pbuf + (long)t * DIN + col) = w2;
                            if (nt == 9) {
#pragma unroll
                                for (int j = 0; j < 4; ++j) vst[(long)(col - PC_VS + j) * T + t] = f2bf(a[j]);
                            }
                        }
                    }
                    if (nt >= 2 && nt <= 4) {
                        sq += __shfl_xor(sq, 16); sq += __shfl_xor(sq, 32);
                        if (fq == 0) ssq[(long)t * 8 + (nt - 2) * 2 + wc] = sq;
                    }
                }
            }
            SEAM(pb + 1);
        }
        if (EN(3) && IN(pb + 2)) {
            PHASE_ENTER();
            const bf16_t* pbuf = (const bf16_t*)(ws + WS_PBUF);
            const bf16_t* wuq = (const bf16_t*)(ws + WS_WUQ) + (long)l * 640 * 256;
            const bf16_t* wukv = (const bf16_t*)(ws + WS_WUKV) + (long)l * 768 * 128;
            const bf16_t* fw = (const bf16_t*)(ws + WS_FW) + (long)l * 4 * 128 * 64;
            bf16_t* qraw = (bf16_t*)(ws + WS_QRAW); bf16_t* knraw = (bf16_t*)(ws + WS_KNRAW); bf16_t* vmt = (bf16_t*)(ws + WS_VMT); bf16_t* abt = (bf16_t*)(ws + WS_ABT);
            const int nuq = MT_Q * 5, nukv = (T / 128) * 6, nuf = MT_Q * 4;
            for (int u = blockIdx.x; u < nuq + nukv + nuf; u += gridDim.x) {
                int kind, mt, nt;
                if (u < nuq) { kind = 0; mt = u / 5; nt = u % 5; } else if (u < nuq + nukv) { kind = 1; const int v = u - nuq; mt = v / 6; nt = v % 6; } else { kind = 2; const int v = u - nuq - nukv; mt = v >> 2; nt = v & 3; }
                GemmDesc g; g.lda = DIN; g.aidx = nullptr; g.aidx_stride = 0; g.mvalid = 128;
                if (kind == 0) { g.A = pbuf + (long)mt * 128 * DIN + PC_CQ; g.B = wuq + (long)nt * 128 * 256; g.ldb = 256; g.K = 256; }
                else if (kind == 1) { g.A = pbuf + (long)mt * 128 * DIN + PC_CKV; g.B = wukv + (long)nt * 128 * 128; g.ldb = 128; g.K = 128; }
                else { g.A = pbuf + (long)mt * 128 * DIN + nt * 64; g.B = fw + (long)nt * 128 * 64; g.ldb = 64; g.K = 64; }
                f32x4 acc[4][4];
                gemm_core(g, acc, lds, tid);
#pragma unroll
                for (int mb = 0; mb < 4; ++mb) {
                    const int t = mt * 128 + wr * 64 + mb * 16 + fr;
                    const float* sp = ssq + (long)t * 8;
                    float rs = 1.f;
                    if (kind == 0) rs = rsqrtf((sp[0] + sp[1] + sp[2] + sp[3]) * (1.0f / 256.0f) + EPS);
                    else if (kind == 1) rs = rsqrtf((sp[4] + sp[5]) * (1.0f / 128.0f) + EPS);
#pragma unroll
                    for (int nb = 0; nb < 4; ++nb) {
                        const int cl = wc * 64 + nb * 16 + fq * 4;
                        const f32x4 a = acc[mb][nb] * rs;
                        if (kind == 0) {
                            const int col = nt * 128 + cl;
                            if (col < 576) { u32x2 w2; w2.x = cvt_pk_bf16(a[0], a[1]); w2.y = cvt_pk_bf16(a[2], a[3]); *(u32x2*)(qraw + (long)t * 576 + col) = w2; }
                        } else if (kind == 1) {
                            const int col = nt * 128 + cl;
                            if (nt < 3) { u32x2 w2; w2.x = cvt_pk_bf16(a[0], a[1]); w2.y = cvt_pk_bf16(a[2], a[3]); *(u32x2*)(knraw + (long)t * 384 + col) = w2; }
                            else {
#pragma unroll
                                for (int j = 0; j < 4; ++j) vmt[(long)(col - 384 + j) * T + t] = f2bf(a[j]);
                            }
                        } else {
                            const int cs = cl >> 6, row = nt * 64 + (cl & 63);
                            bf16_t* dst = t < TL ? abt + ((long)(t >> 11) * 256 + row) * 4096 + cs * 2048 + (t & 2047)
                                                 : abt + (long)8 * 256 * 4096 + ((long)((t - TL) >> 8) * 256 + row) * 512 + cs * 256 + ((t - TL) & 255);
#pragma unroll
                            for (int j = 0; j < 4; ++j) dst[(long)j * (t < TL ? 4096 : 512)] = f2bf(a[j]);
                        }
                    }
                }
            }
            SEAM(pb + 2);
        }
        if (EN(4) && IN(pb + 3)) { TID_ENTER(); int l = l0; LAUNDER_S(l); phase_prep(P, l, tid); SEAM(pb + 3); }
        if (EN(5) && IN(pb + 4)) {
            PHASE_ENTER();
            const bf16_t* qm = (const bf16_t*)(ws + WS_QM); const bf16_t* km = (const bf16_t*)(ws + WS_KM); const bf16_t* vmt = (const bf16_t*)(ws + WS_VMT);
            const bf16_t* qs = (const bf16_t*)(ws + WS_QS); const bf16_t* ks = (const bf16_t*)(ws + WS_KS); const bf16_t* vst = (const bf16_t*)(ws + WS_VST);
            const bf16_t* abt = (const bf16_t*)(ws + WS_ABT); const bf16_t* csl = (const bf16_t*)(ws + WS_CS); const bf16_t* csc = (const bf16_t*)(ws + WS_CSC);
            bf16_t* outx = (bf16_t*)(ws + WS_OUTX);
            constexpr int U_ML = 768, U_FL = 256, U_SL = 768, U_MC = 96, U_SC = 96, U_FC = 32;
            const int nu = last ? (U_ML + U_FL + U_SL) : (U_ML + U_FL + U_SL + U_MC + U_SC + U_FC);
            for (int u = blockIdx.x; u < nu; u += gridDim.x) {
#ifdef P5_ONLY_FOURIER
                if (!((u >= U_ML && u < U_ML + U_FL) || u >= U_ML + U_FL + U_SL + U_MC + U_SC)) continue;
#endif
                if (u < U_ML) {
                    const int b = u / 96, r = u % 96, h = r >> 4, qb = r & 15;
                    const int qt = b * SEQ + qb * 128;
                    attn_unit<96, false>(qm + (long)qt * 576 + h * 96, 576, km + h * 96, 576, vmt + (long)h * 64 * T,
                                         b * SEQ, 32, TL + b * CL, 4, 0, 0, 0.f, false, outx + (long)qt * D + 256 + h * 64, lds, tid);
                } else if (u < U_ML + U_FL) {
                    const int v = u - U_ML, b = v >> 5, mt = (v >> 1) & 15, nt = v & 1;
                    GemmDesc g; g.A = csl + (long)mt * 128 * 4096; g.lda = 4096; g.B = abt + ((long)b * 256 + nt * 128) * 4096; g.ldb = 4096; g.K = 4096;
                    g.aidx = nullptr; g.aidx_stride = 0; g.mvalid = 128;
                    f32x4 acc[4][4];
                    gemm_core(g, acc, lds, tid);
#pragma unroll
                    for (int mb = 0; mb < 4; ++mb) {
                        const int t = b * SEQ + mt * 128 + wr * 64 + mb * 16 + fr;
#pragma unroll
                        for (int nb = 0; nb < 4; ++nb) { const f32x4 a = acc[mb][nb]; u32x2 w2; w2.x = cvt_pk_bf16(a[0], a[1]); w2.y = cvt_pk_bf16(a[2], a[3]);
                            *(u32x2*)(outx + (long)t * D + nt * 128 + wc * 64 + nb * 16 + fq * 4) = w2; }
                    }
                } else if (u < U_ML + U_FL + U_SL) {
                    const int v = u - U_ML - U_FL, b = v / 96, r = v % 96, h = r >> 4, qb = r & 15, kvh = h / 3;
                    const int qt = b * SEQ + qb * 128;
                    int k0 = qb * 128 - 128; if (k0 < 0) k0 = 0;
                    int k1 = qb * 128 + 256; if (k1 > SEQ) k1 = SEQ;
                    const float sink2 = P.in[I_SINK][l * 6 + h] * LOG2E;
                    attn_unit<64, true>(qs + (long)qt * 384 + h * 64, 384, ks + kvh * 64, 128, vst + (long)kvh * 64 * T,
                                        b * SEQ + k0, (k1 - k0) >> 6, TL + b * CL, 4, qb * 128, k0, sink2, true, outx + (long)qt * D + 640 + h * 64, lds, tid);
                } else if (u < U_ML + U_FL + U_SL + U_MC) {
                    const int v = u - U_ML - U_FL - U_SL, b = v / 12, r = v % 12, h = r >> 1, qb = r & 1;
                    const int qt = TL + b * CL + qb * 128;
                    attn_unit<96, false>(qm + (long)qt * 576 + h * 96, 576, km + h * 96, 576, vmt + (long)h * 64 * T,
                                         TL + b * CL, 4, 0, 0, 0, 0, 0.f, false, outx + (long)qt * D + 256 + h * 64, lds, tid);
                } else if (u < U_ML + U_FL + U_SL + U_MC + U_SC) {
                    const int v = u - U_ML - U_FL - U_SL - U_MC, b = v / 12, r = v % 12, h = r >> 1, qb = r & 1, kvh = h / 3;
                    const int qt = TL + b * CL + qb * 128;
                    const float sink2 = P.in[I_SINK][l * 6 + h] * LOG2E;
                    attn_unit<64, false>(qs + (long)qt * 384 + h * 64, 384, ks + kvh * 64, 128, vst + (long)kvh * 64 * T,
                                         TL + b * CL, 4, 0, 0, 0, 0, sink2, true, outx + (long)qt * D + 640 + h * 64, lds, tid);
                } else {
                    const int v = u - U_ML - U_FL - U_SL - U_MC - U_SC, b = v >> 2, mt = (v >> 1) & 1, nt = v & 1;
                    GemmDesc g; g.A = csc + (long)mt * 128 * 512; g.lda = 512; g.B = abt + (long)8 * 256 * 4096 + ((long)b * 256 + nt * 128) * 512; g.ldb = 512; g.K = 512;
                    g.aidx = nullptr; g.aidx_stride = 0; g.mvalid = 128;
                    f32x4 acc[4][4];
                    gemm_core(g, acc, lds, tid);
#pragma unroll
                    for (int mb = 0; mb < 4; ++mb) {
                        const int t = TL + b * CL + mt * 128 + wr * 64 + mb * 16 + fr;
#pragma unroll
                        for (int nb = 0; nb < 4; ++nb) { const f32x4 a = acc[mb][nb]; u32x2 w2; w2.x = cvt_pk_bf16(a[0], a[1]); w2.y = cvt_pk_bf16(a[2], a[3]);
                            *(u32x2*)(outx + (long)t * D + nt * 128 + wc * 64 + nb * 16 + fq * 4) = w2; }
                    }
                }
            }
            SEAM(pb + 4);
        }
        if (EN(6) && IN(pb + 5)) {
            PHASE_ENTER();
            const bf16_t* outx = (const bf16_t*)(ws + WS_OUTX);
            const bf16_t* w = (const bf16_t*)(ws + WS_WOUT) + (long)l * 1024 * 1024;
            const int nu = MT_Q * 8;
            for (int u = blockIdx.x; u < nu; u += gridDim.x) {
                const int mt = u >> 3, nt = u & 7;
                GemmDesc g; g.A = outx + (long)mt * 128 * D; g.lda = D; g.B = w + (long)nt * 128 * 1024; g.ldb = 1024; g.K = 1024; g.aidx = nullptr; g.aidx_stride = 0; g.mvalid = 128;
                f32x4 acc[4][4];
                gemm_core(g, acc, lds, tid);
#pragma unroll
                for (int mb = 0; mb < 4; ++mb) {
                    const int t = mt * 128 + wr * 64 + mb * 16 + fr;
                    const int r = t < TL ? (t >> 11) : 8;
                    float* xr = xrow(P, t);
                    const float* g1 = mod + ((long)l * 9 + r) * 6144 + 2048;
#pragma unroll
                    for (int nb = 0; nb < 4; ++nb) {
                        const int col = nt * 128 + wc * 64 + nb * 16 + fq * 4;
                        const f32x4 gv = *(const f32x4*)(g1 + col);
                        f32x4 xv = *(f32x4*)(xr + col);
                        xv += gv * acc[mb][nb];
                        *(f32x4*)(xr + col) = xv;
                    }
                }
            }
            SEAM(pb + 5);
        }
        if (EN(7) && IN(pb + 6)) { TID_ENTER(); int l = l0; LAUNDER_S(l); phase_norm2_router(P, l, lds, tid); SEAM(pb + 6); }
        if (EN(8) && (IN(pb + 7) || IN(pb + 8))) {
            PHASE_ENTER();
            const int* cnt = (const int*)(ws + WS_CTL + CTL_CNT_OFF) + l * 16;
            const int2* list = (const int2*)(ws + WS_LIST);
            const bf16_t* hb = (const bf16_t*)(ws + WS_HBUF);
            bf16_t* act = (bf16_t*)(ws + WS_ACT); bf16_t* ysl = (bf16_t*)(ws + WS_YSLOT);
            const bf16_t* wgu = (const bf16_t*)(ws + WS_WGU) + (long)l * NE * 1024 * 1024;
            const bf16_t* wdn = (const bf16_t*)(ws + WS_WDN) + (long)l * NE * 1024 * 512;
            int tstart[17];
            {
                int s = 0;
#pragma unroll
                for (int e = 0; e < 16; ++e) { tstart[e] = s; s += (__builtin_amdgcn_readfirstlane(cnt[e]) + 127) >> 7; }
                tstart[16] = s;
            }
            const int nu = tstart[16] * 8;
            if (IN(pb + 7)) {
                for (int u = blockIdx.x; u < nu; u += gridDim.x) {
                    const int rt = u >> 3, nt = u & 7;
                    int e = 0;
#pragma unroll
                    for (int j = 1; j < 16; ++j) if (rt >= tstart[j]) e = j;
                    int ts_e = 0;
#pragma unroll
                    for (int j = 0; j < 16; ++j) if (j == e) ts_e = tstart[j];
                    const int mt = rt - ts_e, ce = cnt[e], mv = (ce - mt * 128) < 128 ? (ce - mt * 128) : 128;
                    GemmDesc g; g.A = hb; g.lda = D; g.B = wgu + ((long)e * 1024 + nt * 128) * 1024; g.ldb = 1024; g.K = 1024;
                    g.aidx = (const int*)(list + (long)e * T + mt * 128); g.aidx_stride = 2; g.mvalid = mv;
                    f32x4 acc[4][4];
                    gemm_core(g, acc, lds, tid);
#pragma unroll
                    for (int mb = 0; mb < 4; ++mb) {
                        const int rl = wr * 64 + mb * 16 + fr;
                        if (rl < mv) {
                            bf16_t* ar = act + ((long)rt * 128 + rl) * DE + nt * 64 + wc * 32 + fq * 4;
#pragma unroll
                            for (int p = 0; p < 2; ++p) {
                                const f32x4 gt = acc[mb][2 * p], up = acc[mb][2 * p + 1];
                                u32x2 w2; w2.x = cvt_pk_bf16(silu_f(gt[0]) * up[0], silu_f(gt[1]) * up[1]); w2.y = cvt_pk_bf16(silu_f(gt[2]) * up[2], silu_f(gt[3]) * up[3]);
                                *(u32x2*)(ar + p * 16) = w2;
                            }
                        }
                    }
                }
                SEAM(pb + 7);
            }
            if (IN(pb + 8)) {
                for (int u = blockIdx.x; u < nu; u += gridDim.x) {
                    const int rt = u >> 3, nt = u & 7;
                    int e = 0;
#pragma unroll
                    for (int j = 1; j < 16; ++j) if (rt >= tstart[j]) e = j;
                    int ts_e = 0;
#pragma unroll
                    for (int j = 0; j < 16; ++j) if (j == e) ts_e = tstart[j];
                    const int mt = rt - ts_e, ce = cnt[e], mv = (ce - mt * 128) < 128 ? (ce - mt * 128) : 128;
                    GemmDesc g; g.A = act + (long)rt * 128 * DE; g.lda = DE; g.B = wdn + ((long)e * 1024 + nt * 128) * 512; g.ldb = 512; g.K = 512;
                    g.aidx = nullptr; g.aidx_stride = 0; g.mvalid = 128;
                    f32x4 acc[4][4];
                    gemm_core(g, acc, lds, tid);
#pragma unroll
                    for (int mb = 0; mb < 4; ++mb) {
                        const int rl = wr * 64 + mb * 16 + fr;
                        if (rl < mv) {
                            const int2 le = list[(long)e * T + mt * 128 + rl];
                            const float wgt = __int_as_float(le.y);
                            bf16_t* yr = ysl + (long)le.x * D + nt * 128 + wc * 64 + fq * 4;
#pragma unroll
                            for (int nb = 0; nb < 4; ++nb) { const f32x4 a = acc[mb][nb] * wgt; u32x2 w2; w2.x = cvt_pk_bf16(a[0], a[1]); w2.y = cvt_pk_bf16(a[2], a[3]); *(u32x2*)(yr + nb * 16) = w2; }
                        }
                    }
                }
                SEAM(pb + 8);
            }
        }
    }
    if (EN(9) && IN(1 + DEPTH * 9)) { TID_ENTER(); phase_final(P, tid); }
#undef IN
#undef SEAM
}


#ifndef DUMP_MASK
#define DUMP_MASK 0
#endif
__device__ __forceinline__ float dbg_ld(const unsigned char* ws, size_t off, size_t len, size_t i) { return bf2f(((const bf16_t*)(ws + off))[i % len]); }
__global__ void dump_kernel(float* out, const unsigned char* ws, int mask) {
    const size_t n = (size_t)TL * D;
    for (size_t i = (size_t)blockIdx.x * blockDim.x + threadIdx.x; i < n; i += (size_t)gridDim.x * blockDim.x) {
        float v = 0.f;
        if (mask & 1) v += dbg_ld(ws, WS_HBUF, (size_t)T * D, i);
        if (mask & 2) v += dbg_ld(ws, WS_PBUF, (size_t)T * DIN, i) + dbg_ld(ws, WS_PBUF, (size_t)T * DIN, i + 7500000) + dbg_ld(ws, WS_VST, (size_t)128 * T, i);
        if (mask & 4) v += dbg_ld(ws, WS_QRAW, (size_t)T * 576, i) + dbg_ld(ws, WS_KNRAW, (size_t)T * 384, i) + dbg_ld(ws, WS_VMT, (size_t)T * 384, i) + dbg_ld(ws, WS_ABT, (size_t)T * 512, i);
        if (mask & 8) v += dbg_ld(ws, WS_QM, (size_t)T * 576, i) + dbg_ld(ws, WS_KM, (size_t)T * 576, i) + dbg_ld(ws, WS_QS, (size_t)T * 384, i) + dbg_ld(ws, WS_KS, (size_t)T * 128, i);
        if (mask & 16) v += dbg_ld(ws, WS_OUTX, (size_t)T * D, i);
        { const int c = (int)(i & 1023); const bool sel = ((mask & 64) && c < 256) || ((mask & 128) && c >= 256 && c < 640) || ((mask & 256) && c >= 640);
          if (sel) v += dbg_ld(ws, WS_OUTX, (size_t)T * D, i); }
        if (mask & 32) v += dbg_ld(ws, WS_CS, (size_t)2048 * 4096, i) + dbg_ld(ws, WS_WOUT, (size_t)4 * 1024 * 1024, i) + dbg_ld(ws, WS_WGU, (size_t)64 * 1024 * 1024, i) + dbg_ld(ws, WS_WDN, (size_t)64 * 1024 * 512, i)
                         + ((const float*)(ws + WS_MOD))[i % (size_t)(4 * 9 * 6144)] + ((const float*)(ws + WS_ROPES))[i % (size_t)(2048 * 64)] + ((const float*)(ws + WS_ROPEM))[i % (size_t)(2048 * 32)] + dbg_ld(ws, WS_FW, (size_t)16 * 128 * 64, i);
        out[i] = v;
    }
}
extern "C" void kernel_launch(void* const* d_in, const int* in_sizes, int n_in, void* d_out, int out_size, void* d_ws, size_t ws_size, hipStream_t stream) {
    static int grid = 0;
    if (grid == 0) {
        if (n_in != 26 || ws_size < WS_END) { fprintf(stderr, "kernel_launch: expected 26 inputs and >= %zu bytes of workspace (got %d, %zu)\n", (size_t)WS_END, n_in, ws_size); grid = -1; return; }
        int dev = 0, cus = 0, per_cu = 0;
        hipGetDevice(&dev);
        hipDeviceGetAttribute(&cus, hipDeviceAttributeMultiprocessorCount, dev);
        hipFuncSetAttribute((const void*)fwd_kernel, hipFuncAttributeMaxDynamicSharedMemorySize, LDS_BYTES);
        if (hipOccupancyMaxActiveBlocksPerMultiprocessor(&per_cu, (const void*)fwd_kernel, NTHREADS, LDS_BYTES) != hipSuccess || per_cu < 1) per_cu = 1;
        (void)hipGetLastError();
        grid = cus * (per_cu < 2 ? per_cu : 2);
    }
    if (grid < 0) return;
    hipMemsetAsync((char*)d_ws + WS_CTL, 0, CTL_BYTES, stream);
    Params p{};
    for (int i = 0; i < 26; ++i) p.in[i] = (const float*)d_in[i];
    p.out = (float*)d_out; p.ws = (unsigned char*)d_ws;
#ifndef STOP_PH
#define STOP_PH (2 + DEPTH * 9)
#endif
    constexpr int NPH = STOP_PH;
#if N_LAUNCH_MODE == 1
    p.ph_lo = 0; p.ph_hi = NPH;
    hipLaunchKernelGGL(fwd_kernel, dim3(grid), dim3(NTHREADS), LDS_BYTES, stream, p);
#else
    for (int k = 0; k < NPH; ++k) { p.ph_lo = k; p.ph_hi = k + 1; hipLaunchKernelGGL(fwd_kernel, dim3(grid), dim3(NTHREADS), LDS_BYTES, stream, p); }
#endif
    if (DUMP_MASK) hipLaunchKernelGGL(dump_kernel, dim3(1024), dim3(256), 0, stream, (float*)d_out, (const unsigned char*)d_ws, (int)DUMP_MASK);
}
```

```cpp
#include <hip/hip_runtime.h>
#include <cstdint>
#include <cstdio>

#ifndef N_LAUNCH_MODE
#define N_LAUNCH_MODE 1
#endif

#define LAS __attribute__((address_space(3)))
typedef unsigned short bf16_t;
typedef short bf16x8 __attribute__((ext_vector_type(8)));
typedef float f32x4 __attribute__((ext_vector_type(4)));
typedef float f32x16 __attribute__((ext_vector_type(16)));
typedef unsigned u32x4 __attribute__((ext_vector_type(4)));
typedef unsigned u32x2 __attribute__((ext_vector_type(2)));

constexpr int D = 1024, NB = 8, SEQ = 2048, CL = 256, DEPTH = 4;
constexpr int TL = NB * SEQ, TC = NB * CL, T = TL + TC;
constexpr int DIN = 1312, DINP = 1408;
constexpr int NE = 16, DE = 512;
constexpr int PC_CQ = 256, PC_CKV = 512, PC_QS = 640, PC_KS = 1024, PC_VS = 1152, PC_KR = 1280;
constexpr float EPS = 1e-6f;
constexpr float LOG2E = 1.4426950408889634f;
constexpr int NTHREADS = 256;
constexpr int LDS_BYTES = 65536 + 16;

constexpr size_t al256(size_t x) { return (x + 255) & ~(size_t)255; }
constexpr size_t WS_CTL = 0;
constexpr size_t CTL_BYTES = 32768;
constexpr size_t CTL_CNT_OFF = 16384;
constexpr size_t WS_MOD = WS_CTL + CTL_BYTES;
constexpr size_t WS_ROPES = WS_MOD + al256((size_t)DEPTH * 9 * 6144 * 4);
constexpr size_t WS_ROPEM = WS_ROPES + (size_t)2048 * 32 * 8;
constexpr size_t WS_FW = WS_ROPEM + (size_t)2048 * 16 * 8;
constexpr size_t WS_CS = WS_FW + (size_t)DEPTH * 4 * 128 * 64 * 2;
constexpr size_t WS_CSC = WS_CS + (size_t)2048 * 4096 * 2;
constexpr size_t WS_WIN = WS_CSC + (size_t)256 * 512 * 2;
constexpr size_t WS_WUQ = WS_WIN + (size_t)DEPTH * DINP * 1024 * 2;
constexpr size_t WS_WUKV = WS_WUQ + (size_t)DEPTH * 640 * 256 * 2;
constexpr size_t WS_WOUT = WS_WUKV + (size_t)DEPTH * 768 * 128 * 2;
constexpr size_t WS_WGU = WS_WOUT + (size_t)DEPTH * 1024 * 1024 * 2;
constexpr size_t WS_WDN = WS_WGU + (size_t)DEPTH * NE * 1024 * 1024 * 2;
constexpr size_t WS_CTX = WS_WDN + (size_t)DEPTH * NE * 1024 * 512 * 2;
constexpr size_t WS_SSQ = WS_CTX + (size_t)TC * D * 4;
constexpr size_t WS_HBUF = WS_SSQ + (size_t)T * 8 * 4;
constexpr size_t WS_R = WS_HBUF + (size_t)T * D * 2;
constexpr size_t WS_PBUF = WS_R;
constexpr size_t WS_QRAW = WS_PBUF + (size_t)T * DIN * 2;
constexpr size_t WS_KNRAW = WS_QRAW + (size_t)T * 576 * 2;
constexpr size_t WS_QM = WS_KNRAW + (size_t)T * 384 * 2;
constexpr size_t WS_KM = WS_QM + (size_t)T * 576 * 2;
constexpr size_t WS_VMT = WS_KM + (size_t)T * 576 * 2;
constexpr size_t WS_QS = WS_VMT + (size_t)384 * T * 2;
constexpr size_t WS_KS = WS_QS + (size_t)T * 384 * 2;
constexpr size_t WS_VST = WS_KS + (size_t)T * 128 * 2;
constexpr size_t WS_ABT = WS_VST + (size_t)128 * T * 2;
constexpr size_t WS_OUTX = WS_ABT + (size_t)512 * T * 2;
constexpr size_t WS_MIX_END = WS_OUTX + (size_t)T * D * 2;
constexpr size_t WS_YSLOT = WS_R;
constexpr size_t WS_ACT = WS_YSLOT + (size_t)2 * T * D * 2;
constexpr size_t WS_LIST = WS_ACT + (size_t)(2 * T + 2048) * DE * 2;
constexpr size_t WS_MOE_END = WS_LIST + (size_t)NE * T * 8;
constexpr size_t WS_END = WS_MIX_END > WS_MOE_END ? WS_MIX_END : WS_MOE_END;

#define XB_TMO      128
#define XB_XCNT(j)  (256  + 64 * (j))
#define XB_XSUB(j)  (1280 + 64 * (j))
#define XB_XGEN(j)  (2304 + 64 * (j))
#define XB_TOP      3328
#define XB_TOPGEN   3392
#define XCD_BAR_WORDS 3456
#define XB_SPIN_CAP (1u << 22)

__device__ __forceinline__ unsigned xb_ld(unsigned* p)              { return __hip_atomic_load(p, __ATOMIC_RELAXED, __HIP_MEMORY_SCOPE_AGENT); }
__device__ __forceinline__ unsigned xb_add(unsigned* p, unsigned v) { return __hip_atomic_fetch_add(p, v, __ATOMIC_RELAXED, __HIP_MEMORY_SCOPE_AGENT); }
__device__ __forceinline__ unsigned xb_xcc_id() { return (unsigned)__builtin_amdgcn_s_getreg((3 << 11) | 20) & 0xFu; }
#define XB_SPIN(cond, bar) do { unsigned _sp = 0; while (cond) { __builtin_amdgcn_s_sleep(1); \
    if ((++_sp & 255u) == 0u) { if (xb_ld(&(bar)[XB_TMO])) break; if (_sp > XB_SPIN_CAP) { atomicAdd(&(bar)[XB_TMO], 1u); break; } } } } while (0)

struct XcdBarrier { unsigned* bar; unsigned x; volatile LAS unsigned* st; };

__device__ __forceinline__ XcdBarrier xcd_barrier_post(unsigned* bar, volatile LAS unsigned* st) {
    XcdBarrier b; b.bar = bar; b.x = xb_xcc_id(); b.st = st;
    if (threadIdx.x == 0) (void)xb_add(&bar[XB_XCNT(b.x)], 1u);
    return b;
}
__device__ __forceinline__ void xcd_barrier_complete(unsigned* bar, unsigned x, unsigned& nloc, unsigned& nx) {
    const unsigned G = gridDim.x * gridDim.y * gridDim.z;
    unsigned sum, cnt, mine, sp = 0u;
    for (;;) {
        sum = 0u; cnt = 0u; mine = 0u;
#pragma unroll
        for (unsigned j = 0; j < 16; ++j) { const unsigned c = xb_ld(&bar[XB_XCNT(j)]); sum += c; cnt += (c > 0u) ? 1u : 0u; mine = (j == x) ? c : mine; }
        if (sum == G) break;
        __builtin_amdgcn_s_sleep(1);
        if ((++sp & 255u) == 0u) { if (xb_ld(&bar[XB_TMO])) break; if (sp > XB_SPIN_CAP) { atomicAdd(&bar[XB_TMO], 1u); break; } }
    }
    nloc = mine > 0u ? mine : 1u; nx = cnt > 0u ? cnt : 1u;
}
__device__ __forceinline__ void xcd_barrier(const XcdBarrier& b) {
    asm volatile("s_waitcnt vmcnt(0)" ::: "memory");
    __syncthreads();
    if (threadIdx.x == 0) {
        unsigned* bar = b.bar;
        __builtin_amdgcn_s_waitcnt(0);
        unsigned nloc = b.st[0], nx = b.st[1];
        if (nloc == 0u) { xcd_barrier_complete(bar, b.x, nloc, nx); b.st[0] = nloc; b.st[1] = nx; }
        const unsigned old = xb_add(&bar[XB_XSUB(b.x)], 1u);
        const unsigned gen = old / nloc;
        if (old + 1u == (gen + 1u) * nloc) {
            __builtin_amdgcn_fence(__ATOMIC_RELEASE, "agent");
            asm volatile("s_waitcnt vmcnt(0)" ::: "memory");
            const unsigned og = xb_add(&bar[XB_TOP], 1u);
            const unsigned tg = og / nx;
            if (og + 1u == (tg + 1u) * nx) xb_add(&bar[XB_TOPGEN], 1u);
            else XB_SPIN(xb_ld(&bar[XB_TOPGEN]) == tg, bar);
            __builtin_amdgcn_fence(__ATOMIC_ACQUIRE, "agent");
            xb_add(&bar[XB_XGEN(b.x)], 1u);
            asm volatile("s_waitcnt vmcnt(0)" ::: "memory");
        } else {
            XB_SPIN(xb_ld(&bar[XB_XGEN(b.x)]) == gen, bar);
            __builtin_amdgcn_fence(__ATOMIC_ACQUIRE, "agent");
            asm volatile("s_waitcnt vmcnt(0)" ::: "memory");
        }
    }
    __syncthreads();
}

__device__ __forceinline__ unsigned cvt_pk_bf16(float lo, float hi) { unsigned r; asm("v_cvt_pk_bf16_f32 %0, %1, %2" : "=v"(r) : "v"(lo), "v"(hi)); return r; }
__device__ __forceinline__ float bf2f(bf16_t v) { return __uint_as_float((unsigned)v << 16); }
__device__ __forceinline__ bf16_t f2bf(float v) { return (bf16_t)(cvt_pk_bf16(v, 0.f) & 0xffffu); }
__device__ __forceinline__ float wave_sum(float v) {
#pragma unroll
    for (int o = 32; o >= 1; o >>= 1) v += __shfl_xor(v, o);
    return v;
}
__device__ __forceinline__ float fast_exp2(float x) { return __builtin_amdgcn_exp2f(x); }
__device__ __forceinline__ float silu_f(float v) { return v / (1.0f + __expf(-v)); }
#define VM_WAIT0() asm volatile("s_waitcnt vmcnt(0)" ::: "memory")
#define LAUNDER_S(x) asm volatile("" : "+s"(x))
#define GLDS16(gp, lp) __builtin_amdgcn_global_load_lds((const unsigned*)(gp), (LAS unsigned*)(lp), 16, 0, 0)

struct Params {
    const float* in[26];
    float* out;
    unsigned char* ws;
    int ph_lo, ph_hi;
};
enum { I_X = 0, I_C, I_CTX, I_CCTX, I_ADAW, I_ADAB, I_N1G, I_N2G, I_WIN, I_FNETW, I_CQG, I_CKVG, I_WUQ, I_WUK, I_WUV, I_MQG, I_MKG, I_SQG, I_SKG, I_SINK, I_WOUT, I_RW, I_RB, I_EG, I_EU, I_ED };

struct GemmDesc {
    const bf16_t* A; const bf16_t* B;
    long lda, ldb;
    int K;
    const int* aidx; int aidx_stride;
    int mvalid;
};

__device__ __forceinline__ void gemm_core(const GemmDesc& d, f32x4 (&acc)[4][4], LAS unsigned char* lds, const int tid) {
    const int lane = tid & 63, wid = tid >> 6, wr = wid >> 1, wc = wid & 1, fr = lane & 15, fq = lane >> 4;
    const int srow = tid >> 3;
    const int schunk = (tid & 7) ^ ((tid >> 4) & 7);
    const bf16_t* pa[4]; const bf16_t* pb[4];
#pragma unroll
    for (int i = 0; i < 4; ++i) {
        const int r = i * 32 + srow;
        long ar;
        if (d.aidx) { const int rr = r < d.mvalid ? r : 0; ar = (long)(d.aidx[(long)rr * d.aidx_stride] >> 1); } else ar = r;
        pa[i] = d.A + ar * d.lda + schunk * 8;
        pb[i] = d.B + (long)r * d.ldb + schunk * 8;
    }
    const int nt = d.K >> 6;
#pragma unroll
    for (int mb = 0; mb < 4; ++mb)
#pragma unroll
        for (int nb = 0; nb < 4; ++nb) acc[mb][nb] = (f32x4){0.f, 0.f, 0.f, 0.f};
    const int swz = (fr >> 1) & 7;
    const int aoff = (wr * 64 + fr) * 128, boff = 16384 + (wc * 64 + fr) * 128;
    LAS unsigned char* la = lds + tid * 16;
    for (int t = 0; t < nt; ++t) {
        const long ko = (long)t * 64;
#pragma unroll
        for (int i = 0; i < 4; ++i) {
            GLDS16(pa[i] + ko, la + i * 4096);
            GLDS16(pb[i] + ko, la + 16384 + i * 4096);
        }
        VM_WAIT0(); __syncthreads();
#pragma unroll
        for (int ks = 0; ks < 2; ++ks) {
            bf16x8 af[4], bfr[4];
            const int co = ((ks * 4 + fq) ^ swz) << 4;
#pragma unroll
            for (int mb = 0; mb < 4; ++mb) af[mb] = *(LAS bf16x8*)(lds + aoff + mb * 2048 + co);
#pragma unroll
            for (int nb = 0; nb < 4; ++nb) bfr[nb] = *(LAS bf16x8*)(lds + boff + nb * 2048 + co);
#pragma unroll
            for (int mb = 0; mb < 4; ++mb)
#pragma unroll
                for (int nb = 0; nb < 4; ++nb) acc[mb][nb] = __builtin_amdgcn_mfma_f32_16x16x32_bf16(bfr[nb], af[mb], acc[mb][nb], 0, 0, 0);
        }
        __syncthreads();
    }
}

template <int DQK, bool MASK>
__device__ __forceinline__ void attn_unit(const bf16_t* Qp, int ldq, const bf16_t* Kp, int ldk, const bf16_t* VTp,
                                          int seg0_tok, int seg0_tiles, int seg1_tok, int seg1_tiles,
                                          int qpos0, int seg0_pos, float sink2, bool has_sink, bf16_t* Op, LAS unsigned char* lds, const int tid) {
    constexpr int NKS = DQK / 16;
    constexpr int BUFB = 20480;
    const int lane = tid & 63, wid = tid >> 6, lq = lane & 31, h = lane >> 5;
    bf16x8 qf[NKS];
    {
        const bf16_t* qrow = Qp + (long)(wid * 32 + lq) * ldq + 8 * h;
#pragma unroll
        for (int ks = 0; ks < NKS; ++ks) qf[ks] = *(const bf16x8*)(qrow + ks * 16);
    }
    f32x16 ot[2];
#pragma unroll
    for (int i = 0; i < 16; ++i) { ot[0][i] = 0.f; ot[1][i] = 0.f; }
    float m_run = -INFINITY, l_run = 0.f;
    const int nT = seg0_tiles + seg1_tiles;
    const int srow = tid >> 3, sch8 = (tid & 7) ^ ((tid >> 4) & 7);
    const int srow2 = tid >> 2, sch4 = (tid & 3) ^ ((tid >> 4) & 3);

    auto stage = [&](int i) {
        const long tok = i < seg0_tiles ? (long)seg0_tok + i * 64 : (long)seg1_tok + (i - seg0_tiles) * 64;
        LAS unsigned char* lb = lds + tid * 16;
#pragma unroll
        for (int it = 0; it < 2; ++it) {
            GLDS16(Kp + (tok + it * 32 + srow) * ldk + sch8 * 8, lb + it * 4096);
            GLDS16(VTp + (long)(it * 32 + srow) * T + tok + sch8 * 8, lb + 12288 + it * 4096);
        }
        if (DQK == 96) GLDS16(Kp + (tok + srow2) * ldk + 64 + sch4 * 8, lb + 8192);
    };
    const int qpos = qpos0 + wid * 32 + lq;
    const int kswz = (lq >> 1) & 7, kswz2 = (lq >> 2) & 3;

    for (int i = 0; i < nT; ++i) {
        stage(i);
        VM_WAIT0(); __syncthreads();
        bool active = true;
        if (MASK && i < seg0_tiles) {
            const int k0 = seg0_pos + i * 64, q0w = qpos0 + wid * 32;
            active = (k0 + 63 >= q0w - 128) && (k0 <= q0w + 31 + 128);
        }
        if (active) {
            LAS unsigned char* lb = lds;
            f32x16 st[2];
#pragma unroll
            for (int r = 0; r < 16; ++r) { st[0][r] = 0.f; st[1][r] = 0.f; }
#pragma unroll
            for (int ks = 0; ks < 4; ++ks)
#pragma unroll
                for (int kb = 0; kb < 2; ++kb) {
                    const bf16x8 kf = *(LAS bf16x8*)(lb + (kb * 32 + lq) * 128 + (((ks * 2 + h) ^ kswz) << 4));
                    st[kb] = __builtin_amdgcn_mfma_f32_32x32x16_bf16(kf, qf[ks], st[kb], 0, 0, 0);
                }
            if (DQK == 96) {
#pragma unroll
                for (int ks = 4; ks < NKS; ++ks)
#pragma unroll
                    for (int kb = 0; kb < 2; ++kb) {
                        const bf16x8 kf = *(LAS bf16x8*)(lb + 8192 + (kb * 32 + lq) * 64 + ((((ks - 4) * 2 + h) ^ kswz2) << 4));
                        st[kb] = __builtin_amdgcn_mfma_f32_32x32x16_bf16(kf, qf[ks], st[kb], 0, 0, 0);
                    }
            }
            if (MASK && i < seg0_tiles) {
                const int kbase = seg0_pos + i * 64 + 4 * h - qpos;
#pragma unroll
                for (int kb = 0; kb < 2; ++kb)
#pragma unroll
                    for (int r = 0; r < 16; ++r) {
                        const int dlt = kbase + kb * 32 + (r & 3) + 8 * (r >> 2);
                        if (dlt > 128 || dlt < -128) st[kb][r] = -INFINITY;
                    }
            }
            float mx = st[0][0];
#pragma unroll
            for (int r = 1; r < 16; ++r) mx = fmaxf(mx, st[0][r]);
#pragma unroll
            for (int r = 0; r < 16; ++r) mx = fmaxf(mx, st[1][r]);
            mx = fmaxf(mx, __shfl_xor(mx, 32));
            const float m_new = fmaxf(m_run, mx);
            const float m_use = (m_new == -INFINITY) ? 0.f : m_new;
            const float alpha = fast_exp2(m_run - m_use);
            float ls = 0.f;
#pragma unroll
            for (int kb = 0; kb < 2; ++kb)
#pragma unroll
                for (int r = 0; r < 16; ++r) { const float p = fast_exp2(st[kb][r] - m_use); st[kb][r] = p; ls += p; }
            l_run = l_run * alpha + ls;
            m_run = m_new;
#pragma unroll
            for (int r = 0; r < 16; ++r) { ot[0][r] *= alpha; ot[1][r] *= alpha; }
#pragma unroll
            for (int s = 0; s < 4; ++s) {
                union { u32x4 u; bf16x8 v; } pf;
                const int kb = s >> 1, r0 = 8 * (s & 1);
                pf.u.x = cvt_pk_bf16(st[kb][r0 + 0], st[kb][r0 + 1]); pf.u.y = cvt_pk_bf16(st[kb][r0 + 2], st[kb][r0 + 3]);
                pf.u.z = cvt_pk_bf16(st[kb][r0 + 4], st[kb][r0 + 5]); pf.u.w = cvt_pk_bf16(st[kb][r0 + 6], st[kb][r0 + 7]);
#pragma unroll
                for (int db = 0; db < 2; ++db) {
                    LAS unsigned char* vr = lb + 12288 + (db * 32 + lq) * 128 + 8 * h;
                    union { u32x2 u[2]; bf16x8 v; } vf;
                    vf.u[0] = *(LAS u32x2*)(vr + (((2 * s) ^ kswz) << 4));
                    vf.u[1] = *(LAS u32x2*)(vr + (((2 * s + 1) ^ kswz) << 4));
                    ot[db] = __builtin_amdgcn_mfma_f32_32x32x16_bf16(vf.v, pf.v, ot[db], 0, 0, 0);
                }
            }
        }
        __syncthreads();
    }
    float l = l_run + __shfl_xor(l_run, 32);
    if (has_sink) l += fast_exp2(sink2 - m_run);
    const float inv = 1.0f / l;
    bf16_t* orow = Op + (long)(wid * 32 + lq) * D + 4 * h;
#pragma unroll
    for (int db = 0; db < 2; ++db)
#pragma unroll
        for (int g = 0; g < 4; ++g) {
            u32x2 w; w.x = cvt_pk_bf16(ot[db][4 * g] * inv, ot[db][4 * g + 1] * inv); w.y = cvt_pk_bf16(ot[db][4 * g + 2] * inv, ot[db][4 * g + 3] * inv);
            *(u32x2*)(orow + db * 32 + 8 * g) = w;
        }
}

__device__ __forceinline__ int nmap(int mode, int n) {
    if (mode == 1) return n < 640 ? n : (n < 672 ? n + 640 : n - 32);
    if (mode == 2) return ((n >> 4) << 5) + (n & 15);
    if (mode == 3) return ((n >> 4) << 5) + 16 + (n & 15);
    return n;
}
__device__ __forceinline__ void conv_tile(const float* src, int K, int N, bf16_t* dst, int ldd, int mode, const float* kscale, int tk, int tn, LAS unsigned char* lds, const int tid) {
    LAS float* sT = (LAS float*)lds;
    const int k0 = tk * 64, n0 = tn * 64;
    {
        const int c4 = (tid & 15) * 4, rr = tid >> 4;
#pragma unroll
        for (int i = 0; i < 4; ++i) {
            const int kk = rr + 16 * i;
            f32x4 v = (f32x4){0.f, 0.f, 0.f, 0.f};
            if (n0 + c4 < N) v = *(const f32x4*)(src + (long)(k0 + kk) * N + n0 + c4);
            if (kscale) { const float s = kscale[k0 + kk]; v = v * s; }
            sT[kk * 65 + c4 + 0] = v[0]; sT[kk * 65 + c4 + 1] = v[1]; sT[kk * 65 + c4 + 2] = v[2]; sT[kk * 65 + c4 + 3] = v[3];
        }
    }
    __syncthreads();
    {
        const int n = tid >> 2, kc = (tid & 3) * 16;
        if (n0 + n < N) {
            unsigned w[8];
#pragma unroll
            for (int j = 0; j < 8; ++j) w[j] = cvt_pk_bf16(sT[(kc + 2 * j) * 65 + n], sT[(kc + 2 * j + 1) * 65 + n]);
            bf16_t* dp = dst + (long)nmap(mode, n0 + n) * ldd + k0 + kc;
            *(u32x4*)dp = (u32x4){w[0], w[1], w[2], w[3]};
            *(u32x4*)(dp + 8) = (u32x4){w[4], w[5], w[6], w[7]};
        }
    }
    __syncthreads();
}

__device__ __forceinline__ void ada_unit(const Params& P, int l, int n0, LAS unsigned char* lds, const int tid) {
    LAS float* sS = (LAS float*)lds;
    LAS float* sR = sS;
    for (int i = tid; i < 9 * 1024; i += NTHREADS) {
        const int r = i >> 10, k = i & 1023;
        const float v = r < 8 ? P.in[I_C][r * 1024 + k] : P.in[I_CCTX][k];
        sS[i] = silu_f(v);
    }
    __syncthreads();
    const int kg = tid >> 4, c4 = (tid & 15) * 4;
    const float* w = P.in[I_ADAW] + (long)l * 1024 * 6144 + n0 + c4;
    f32x4 acc[9];
#pragma unroll
    for (int r = 0; r < 9; ++r) acc[r] = (f32x4){0.f, 0.f, 0.f, 0.f};
    for (int kk = 0; kk < 64; ++kk) {
        const int k = kg * 64 + kk;
        const f32x4 wv = *(const f32x4*)(w + (long)k * 6144);
#pragma unroll
        for (int r = 0; r < 9; ++r) acc[r] += wv * sS[r * 1024 + k];
    }
    __syncthreads();
#pragma unroll
    for (int r = 0; r < 9; ++r) {
#pragma unroll
        for (int j = 0; j < 4; ++j) sR[(kg * 9 + r) * 64 + c4 + j] = acc[r][j];
    }
    __syncthreads();
    float* mod = (float*)(P.ws + WS_MOD);
    for (int i = tid; i < 9 * 64; i += NTHREADS) {
        const int r = i >> 6, c = i & 63;
        float s = P.in[I_ADAB][l * 6144 + n0 + c];
#pragma unroll
        for (int g = 0; g < 16; ++g) s += sR[(g * 9 + r) * 64 + c];
        mod[((long)l * 9 + r) * 6144 + n0 + c] = s;
    }
    __syncthreads();
}

__device__ __forceinline__ void phase0(const Params& P, LAS unsigned char* lds, const int tid) {
    unsigned char* ws = P.ws;
    constexpr int U_WIN = 4 * 16 * 21, U_WUQ = 4 * 4 * 9, U_WUK = 4 * 2 * 6, U_WUV = U_WUK, U_WOUT = 4 * 256, U_EG = 64 * 128, U_EU = U_EG, U_ED = 64 * 128;
    constexpr int O_WUQ = U_WIN, O_WUK = O_WUQ + U_WUQ, O_WUV = O_WUK + U_WUK, O_WOUT = O_WUV + U_WUV, O_EG = O_WOUT + U_WOUT, O_EU = O_EG + U_EG, O_ED = O_EU + U_EU;
    constexpr int O_ADA = O_ED + U_ED, U_ADA = 4 * 96;
    constexpr int O_CS = O_ADA + U_ADA, U_CS = 256;
    constexpr int O_CSC = O_CS + U_CS, U_CSC = 8;
    constexpr int O_ROPE = O_CSC + U_CSC, U_ROPE = 8;
    constexpr int O_FW = O_ROPE + U_ROPE, U_FW = 16;
    constexpr int U_TOTAL = O_FW + U_FW;
    for (int u = blockIdx.x; u < U_TOTAL; u += gridDim.x) {
        if (u < O_WUQ) { const int m = u / 336, r = u % 336; conv_tile(P.in[I_WIN] + (long)m * 1024 * DIN, 1024, DIN, (bf16_t*)(ws + WS_WIN) + (long)m * DINP * 1024, 1024, 1, nullptr, r / 21, r % 21, lds, tid); }
        else if (u < O_WUK) { const int v = u - O_WUQ, m = v / 36, r = v % 36; conv_tile(P.in[I_WUQ] + (long)m * 256 * 576, 256, 576, (bf16_t*)(ws + WS_WUQ) + (long)m * 640 * 256, 256, 0, P.in[I_CQG] + m * 256, r / 9, r % 9, lds, tid); }
        else if (u < O_WUV) { const int v = u - O_WUK, m = v / 12, r = v % 12; conv_tile(P.in[I_WUK] + (long)m * 128 * 384, 128, 384, (bf16_t*)(ws + WS_WUKV) + (long)m * 768 * 128, 128, 0, P.in[I_CKVG] + m * 128, r / 6, r % 6, lds, tid); }
        else if (u < O_WOUT) { const int v = u - O_WUV, m = v / 12, r = v % 12; conv_tile(P.in[I_WUV] + (long)m * 128 * 384, 128, 384, (bf16_t*)(ws + WS_WUKV) + (long)m * 768 * 128 + 384 * 128, 128, 0, P.in[I_CKVG] + m * 128, r / 6, r % 6, lds, tid); }
        else if (u < O_EG) { const int v = u - O_WOUT, m = v / 256, r = v % 256; conv_tile(P.in[I_WOUT] + (long)m * 1024 * 1024, 1024, 1024, (bf16_t*)(ws + WS_WOUT) + (long)m * 1024 * 1024, 1024, 0, nullptr, r / 16, r % 16, lds, tid); }
        else if (u < O_EU) { const int v = u - O_EG, m = v / 128, r = v % 128; conv_tile(P.in[I_EG] + (long)m * 1024 * 512, 1024, 512, (bf16_t*)(ws + WS_WGU) + (long)m * 1024 * 1024, 1024, 2, nullptr, r / 8, r % 8, lds, tid); }
        else if (u < O_ED) { const int v = u - O_EU, m = v / 128, r = v % 128; conv_tile(P.in[I_EU] + (long)m * 1024 * 512, 1024, 512, (bf16_t*)(ws + WS_WGU) + (long)m * 1024 * 1024, 1024, 3, nullptr, r / 8, r % 8, lds, tid); }
        else if (u < O_ADA) { const int v = u - O_ED, m = v / 128, r = v % 128; conv_tile(P.in[I_ED] + (long)m * 512 * 1024, 512, 1024, (bf16_t*)(ws + WS_WDN) + (long)m * 1024 * 512, 512, 0, nullptr, r / 16, r % 16, lds, tid); }
        else if (u < O_CS) { const int v = u - O_ADA; ada_unit(P, v / 96, (v % 96) * 64, lds, tid); }
        else if (u < O_CSC) {
            const int v = u - O_CS; bf16_t* cs = (bf16_t*)(ws + WS_CS);
            const float sc = 0.022097086912079608f;
            for (int i = tid; i < 8 * 2048; i += NTHREADS) {
                const int k = v * 8 + (i >> 11), np = (i & 2047) * 2;
                float o[2];
#pragma unroll
                for (int j = 0; j < 2; ++j) { const int n = (np + j) & 2047; const float rev = (float)((k * n) & 2047) * (1.0f / 2048.0f);
                    o[j] = (np < 2048) ? __builtin_amdgcn_cosf(rev) * sc : -__builtin_amdgcn_sinf(rev) * sc; }
                *(unsigned*)(cs + (long)k * 4096 + np) = cvt_pk_bf16(o[0], o[1]);
            }
        }
        else if (u < O_ROPE) {
            const int v = u - O_CSC; bf16_t* cs = (bf16_t*)(ws + WS_CSC);
            const float sc = 0.0625f;
            for (int i = tid; i < 32 * 256; i += NTHREADS) {
                const int k = v * 32 + (i >> 8), np = (i & 255) * 2;
                float o[2];
#pragma unroll
                for (int j = 0; j < 2; ++j) { const int n = (np + j) & 255; const float rev = (float)((k * n) & 255) * (1.0f / 256.0f);
                    o[j] = (np < 256) ? __builtin_amdgcn_cosf(rev) * sc : -__builtin_amdgcn_sinf(rev) * sc; }
                *(unsigned*)(cs + (long)k * 512 + np) = cvt_pk_bf16(o[0], o[1]);
            }
        }
        else if (u < O_FW) {
            const int v = u - O_ROPE; float2* rs = (float2*)(ws + WS_ROPES); float2* rm = (float2*)(ws + WS_ROPEM);
            for (int i = tid; i < 256 * 32; i += NTHREADS) {
                const int pos = v * 256 + (i >> 5), j = i & 31; const int pr = pos >> 6, pc = pos & 63;
                const float inv = fast_exp2(-13.287712379549449f * (float)(2 * (j & 15)) * (1.0f / 32.0f));
                const float ang = (float)(j < 16 ? pr : pc) * inv;
                float rev = ang * 0.15915494309189535f; rev -= floorf(rev);
                rs[pos * 32 + j] = make_float2(__builtin_amdgcn_cosf(rev), __builtin_amdgcn_sinf(rev));
            }
            for (int i = tid; i < 256 * 16; i += NTHREADS) {
                const int pos = v * 256 + (i >> 4), j = i & 15; const int pr = pos >> 6, pc = pos & 63;
                const float inv = fast_exp2(-13.287712379549449f * (float)(2 * (j & 7)) * (1.0f / 16.0f));
                const float ang = (float)(j < 8 ? pr : pc) * inv;
                float rev = ang * 0.15915494309189535f; rev -= floorf(rev);
                rm[pos * 16 + j] = make_float2(__builtin_amdgcn_cosf(rev), __builtin_amdgcn_sinf(rev));
            }
        }
        else {
            const int v = u - O_FW, l = v >> 2, g = v & 3;
            const float* w = P.in[I_FNETW] + (long)(l * 4 + g) * 64 * 64;
            bf16_t* fw = (bf16_t*)(ws + WS_FW) + (long)(l * 4 + g) * 128 * 64;
            for (int i = tid; i < 128 * 64; i += NTHREADS) {
                const int f = i >> 6, c = i & 63, cs = f >> 6, e = f & 63;
                float s = 0.f;
                for (int m = 0; m < 64; ++m) {
                    const float rev = (float)((m * c) & 63) * (1.0f / 64.0f);
                    const float tw = cs ? __builtin_amdgcn_sinf(rev) : __builtin_amdgcn_cosf(rev);
                    s += tw * w[m * 64 + e];
                }
                fw[f * 64 + c] = f2bf(s * 0.125f);
            }
        }
    }
}

__device__ __forceinline__ float* xrow(const Params& P, int t) { return t < TL ? P.out + (long)t * D : (float*)(P.ws + WS_CTX) + (long)(t - TL) * D; }

__device__ __forceinline__ void phase_norm1(const Params& P, int l, const int tid) {
    const int lane = tid & 63, gw = blockIdx.x * 4 + (tid >> 6), nw = gridDim.x * 4;
    const float* mod = (const float*)(P.ws + WS_MOD);
    const float* n1g = P.in[I_N1G] + l * D;
    const bf16_t* ys = (const bf16_t*)(P.ws + WS_YSLOT);
    bf16_t* hb = (bf16_t*)(P.ws + WS_HBUF);
    for (int t = gw; t < T; t += nw) {
        const int r = t < TL ? (t >> 11) : 8;
        float* xr = xrow(P, t);
        f32x4 v[4];
        if (l == 0) {
            const float* src = t < TL ? P.in[I_X] + (long)t * D : P.in[I_CTX] + (long)(t - TL) * D;
#pragma unroll
            for (int i = 0; i < 4; ++i) { v[i] = *(const f32x4*)(src + i * 256 + lane * 4); *(f32x4*)(xr + i * 256 + lane * 4) = v[i]; }
        } else {
            const float* g2 = mod + ((long)(l - 1) * 9 + r) * 6144 + 5120;
            const bf16_t* y0 = ys + (long)(2 * t) * D;
#pragma unroll
            for (int i = 0; i < 4; ++i) {
                const int c = i * 256 + lane * 4;
                v[i] = *(const f32x4*)(xr + c);
                const u32x2 a = *(const u32x2*)(y0 + c), b = *(const u32x2*)(y0 + D + c);
                const f32x4 g = *(const f32x4*)(g2 + c);
                f32x4 y;
                y[0] = __uint_as_float(a.x << 16) + __uint_as_float(b.x << 16); y[1] = __uint_as_float(a.x & 0xffff0000u) + __uint_as_float(b.x & 0xffff0000u);
                y[2] = __uint_as_float(a.y << 16) + __uint_as_float(b.y << 16); y[3] = __uint_as_float(a.y & 0xffff0000u) + __uint_as_float(b.y & 0xffff0000u);
                v[i] += g * y;
                *(f32x4*)(xr + c) = v[i];
            }
        }
        float ss = 0.f;
#pragma unroll
        for (int i = 0; i < 4; ++i) ss += v[i][0] * v[i][0] + v[i][1] * v[i][1] + v[i][2] * v[i][2] + v[i][3] * v[i][3];
        ss = wave_sum(ss);
        const float rs = rsqrtf(ss * (1.0f / D) + EPS);
        const float* md = mod + ((long)l * 9 + r) * 6144;
#pragma unroll
        for (int i = 0; i < 4; ++i) {
            const int c = i * 256 + lane * 4;
            const f32x4 g = *(const f32x4*)(n1g + c), sh = *(const f32x4*)(md + c), sc = *(const f32x4*)(md + 1024 + c);
            const f32x4 hv = v[i] * rs * g * (sc + 1.0f) + sh;
            u32x2 w; w.x = cvt_pk_bf16(hv[0], hv[1]); w.y = cvt_pk_bf16(hv[2], hv[3]);
            *(u32x2*)(hb + (long)t * D + c) = w;
        }
    }
}

__device__ __forceinline__ void phase_final(const Params& P, const int tid) {
    const int lane = tid & 63, gw = blockIdx.x * 4 + (tid >> 6), nw = gridDim.x * 4;
    const float* mod = (const float*)(P.ws + WS_MOD);
    const bf16_t* ys = (const bf16_t*)(P.ws + WS_YSLOT);
    for (int t = gw; t < TL; t += nw) {
        const int r = t >> 11;
        float* xr = P.out + (long)t * D;
        const float* g2 = mod + ((long)(DEPTH - 1) * 9 + r) * 6144 + 5120;
        const bf16_t* y0 = ys + (long)(2 * t) * D;
#pragma unroll
        for (int i = 0; i < 4; ++i) {
            const int c = i * 256 + lane * 4;
            f32x4 v = *(const f32x4*)(xr + c);
            const u32x2 a = *(const u32x2*)(y0 + c), b = *(const u32x2*)(y0 + D + c);
            const f32x4 g = *(const f32x4*)(g2 + c);
            f32x4 y;
            y[0] = __uint_as_float(a.x << 16) + __uint_as_float(b.x << 16); y[1] = __uint_as_float(a.x & 0xffff0000u) + __uint_as_float(b.x & 0xffff0000u);
            y[2] = __uint_as_float(a.y << 16) + __uint_as_float(b.y << 16); y[3] = __uint_as_float(a.y & 0xffff0000u) + __uint_as_float(b.y & 0xffff0000u);
            v += g * y;
            *(f32x4*)(xr + c) = v;
        }
    }
}

__device__ __forceinline__ void phase_prep(const Params& P, int l, const int tid) {
    const int lane = tid & 63, gw = blockIdx.x * 4 + (tid >> 6), nw = gridDim.x * 4;
    const bool last = (l == DEPTH - 1);
    const bf16_t* pbuf = (const bf16_t*)(P.ws + WS_PBUF);
    const bf16_t* qraw = (const bf16_t*)(P.ws + WS_QRAW);
    const bf16_t* knraw = (const bf16_t*)(P.ws + WS_KNRAW);
    bf16_t* qm = (bf16_t*)(P.ws + WS_QM); bf16_t* km = (bf16_t*)(P.ws + WS_KM);
    bf16_t* qs = (bf16_t*)(P.ws + WS_QS); bf16_t* ks = (bf16_t*)(P.ws + WS_KS);
    const float2* ropeS = (const float2*)(P.ws + WS_ROPES); const float2* ropeM = (const float2*)(P.ws + WS_ROPEM);
    const float mqg0 = P.in[I_MQG][l * 96 + lane], mqg1 = lane < 32 ? P.in[I_MQG][l * 96 + 64 + lane] : 0.f;
    const float mkg0 = P.in[I_MKG][l * 96 + lane], mkg1 = lane < 32 ? P.in[I_MKG][l * 96 + 64 + lane] : 0.f;
    const float sqg = P.in[I_SQG][l * 64 + lane], skg = P.in[I_SKG][l * 64 + lane];
    const float qsc_m = 0.10206207261596577f * LOG2E;
    const float qsc_s = 0.125f * LOG2E;
    for (int t = gw; t < T; t += nw) {
        const bool lat = t < TL;
        const int pos = t & 2047;
        float2 cm = make_float2(1.f, 0.f), cs2 = make_float2(1.f, 0.f);
        if (lat) { cm = ropeM[pos * 16 + ((lane >> 4) & 1) * 8 + (lane & 7)]; cs2 = ropeS[pos * 32 + (lane >> 5) * 16 + (lane & 15)]; }
        const float sgn_m = (lane & 8) ? 1.f : -1.f, sgn_s = (lane & 16) ? 1.f : -1.f;
        if (lat || !last) {
#pragma unroll 2
            for (int h = 0; h < 6; ++h) {
                const bf16_t* src = qraw + (long)t * 576 + h * 96;
                float a = bf2f(src[lane]), b = lane < 32 ? bf2f(src[64 + lane]) : 0.f;
                const float ss = wave_sum(a * a + b * b);
                const float rs = rsqrtf(ss * (1.0f / 96.0f) + EPS);
                a = a * rs * mqg0; b = b * rs * mqg1;
                const float pb = __shfl_xor(b, 8);
                b = b * cm.x + sgn_m * pb * cm.y;
                bf16_t* dst = qm + (long)t * 576 + h * 96;
                dst[lane] = f2bf(a * qsc_m);
                if (lane < 32) dst[64 + lane] = f2bf(b * qsc_m);
            }
        }
        {
            const float kr = lane < 32 ? bf2f(pbuf[(long)t * DIN + PC_KR + lane]) : 0.f;
#pragma unroll 2
            for (int h = 0; h < 6; ++h) {
                float a = bf2f(knraw[(long)t * 384 + h * 64 + lane]);
                const float ss = wave_sum(a * a + kr * kr);
                const float rs = rsqrtf(ss * (1.0f / 96.0f) + EPS);
                a = a * rs * mkg0; float b = kr * rs * mkg1;
                const float pb = __shfl_xor(b, 8);
                b = b * cm.x + sgn_m * pb * cm.y;
                bf16_t* dst = km + (long)t * 576 + h * 96;
                dst[lane] = f2bf(a);
                if (lane < 32) dst[64 + lane] = f2bf(b);
            }
        }
        if (lat || !last) {
#pragma unroll 2
            for (int h = 0; h < 6; ++h) {
                float a = bf2f(pbuf[(long)t * DIN + PC_QS + h * 64 + lane]);
                const float ss = wave_sum(a * a);
                a = a * rsqrtf(ss * (1.0f / 64.0f) + EPS) * sqg;
                const float pa = __shfl_xor(a, 16);
                a = a * cs2.x + sgn_s * pa * cs2.y;
                qs[(long)t * 384 + h * 64 + lane] = f2bf(a * qsc_s);
            }
        }
#pragma unroll
        for (int h = 0; h < 2; ++h) {
            float a = bf2f(pbuf[(long)t * DIN + PC_KS + h * 64 + lane]);
            const float ss = wave_sum(a * a);
            a = a * rsqrtf(ss * (1.0f / 64.0f) + EPS) * skg;
            const float pa = __shfl_xor(a, 16);
            a = a * cs2.x + sgn_s * pa * cs2.y;
            ks[(long)t * 128 + h * 64 + lane] = f2bf(a);
        }
    }
}

__device__ __forceinline__ void phase_norm2_router(const Params& P, int l, LAS unsigned char* lds, const int tid) {
    const int lane = tid & 63, gw = blockIdx.x * 4 + (tid >> 6), nw = gridDim.x * 4;
    LAS float* rwT = (LAS float*)lds;
    for (int i = tid; i < 16 * 1024; i += NTHREADS) { const int c = i >> 4, e = i & 15; rwT[e * 1024 + c] = P.in[I_RW][i]; }
    __syncthreads();
    const float* mod = (const float*)(P.ws + WS_MOD);
    const float* n2g = P.in[I_N2G] + l * D;
    bf16_t* hb = (bf16_t*)(P.ws + WS_HBUF);
    int* cnt = (int*)(P.ws + WS_CTL + CTL_CNT_OFF) + l * 16;
    int2* list = (int2*)(P.ws + WS_LIST);
    const int tmax = (l == DEPTH - 1) ? TL : T;
    float rb[16];
#pragma unroll
    for (int e = 0; e < 16; ++e) rb[e] = P.in[I_RB][e];
    for (int t = gw; t < tmax; t += nw) {
        const int r = t < TL ? (t >> 11) : 8;
        const float* xr = xrow(P, t);
        f32x4 v[4];
        float ss = 0.f;
#pragma unroll
        for (int i = 0; i < 4; ++i) { v[i] = *(const f32x4*)(xr + i * 256 + lane * 4); ss += v[i][0] * v[i][0] + v[i][1] * v[i][1] + v[i][2] * v[i][2] + v[i][3] * v[i][3]; }
        ss = wave_sum(ss);
        const float rs = rsqrtf(ss * (1.0f / D) + EPS);
        const float* md = mod + ((long)l * 9 + r) * 6144;
#pragma unroll
        for (int i = 0; i < 4; ++i) {
            const int c = i * 256 + lane * 4;
            const f32x4 g = *(const f32x4*)(n2g + c), sh = *(const f32x4*)(md + 3072 + c), sc = *(const f32x4*)(md + 4096 + c);
            v[i] = v[i] * rs * g * (sc + 1.0f) + sh;
            u32x2 w; w.x = cvt_pk_bf16(v[i][0], v[i][1]); w.y = cvt_pk_bf16(v[i][2], v[i][3]);
            *(u32x2*)(hb + (long)t * D + c) = w;
        }
        float lg[16];
#pragma unroll
        for (int e = 0; e < 16; ++e) {
            float s = 0.f;
#pragma unroll
            for (int i = 0; i < 4; ++i) { const f32x4 w = *(LAS f32x4*)(rwT + e * 1024 + i * 256 + lane * 4); s += v[i][0] * w[0] + v[i][1] * w[1] + v[i][2] * w[2] + v[i][3] * w[3]; }
            lg[e] = wave_sum(s);
        }
        float aff[16], sel[16];
#pragma unroll
        for (int e = 0; e < 16; ++e) { aff[e] = 1.0f / (1.0f + __expf(-lg[e])); sel[e] = aff[e] + rb[e]; }
        int gbest = 0; float gmax = -INFINITY;
#pragma unroll
        for (int g = 0; g < 4; ++g) {
            float m1 = -INFINITY, m2 = -INFINITY;
#pragma unroll
            for (int j = 0; j < 4; ++j) { const float s = sel[g * 4 + j]; if (s > m1) { m2 = m1; m1 = s; } else if (s > m2) m2 = s; }
            const float gs = m1 + m2;
            if (gs > gmax) { gmax = gs; gbest = g; }
        }
        float s4[4], a4[4];
#pragma unroll
        for (int j = 0; j < 4; ++j) { s4[j] = -INFINITY; a4[j] = 0.f; }
#pragma unroll
        for (int g = 0; g < 4; ++g) if (g == gbest) {
#pragma unroll
            for (int j = 0; j < 4; ++j) { s4[j] = sel[g * 4 + j]; a4[j] = aff[g * 4 + j]; }
        }
        int i1 = 0; float b1 = s4[0];
#pragma unroll
        for (int j = 1; j < 4; ++j) if (s4[j] > b1) { b1 = s4[j]; i1 = j; }
        int i2 = -1; float b2 = -INFINITY;
#pragma unroll
        for (int j = 0; j < 4; ++j) if (j != i1 && s4[j] > b2) { b2 = s4[j]; i2 = j; }
        float w1 = 0.f, w2 = 0.f;
#pragma unroll
        for (int j = 0; j < 4; ++j) { if (j == i1) w1 = a4[j]; if (j == i2) w2 = a4[j]; }
        const float wn = 1.0f / (w1 + w2);
        if (lane == 0) {
            const int e1 = gbest * 4 + i1, e2 = gbest * 4 + i2;
            const int p1 = atomicAdd(&cnt[e1], 1), p2 = atomicAdd(&cnt[e2], 1);
            list[(long)e1 * T + p1] = make_int2(2 * t, __float_as_int(w1 * wn));
            list[(long)e2 * T + p2] = make_int2(2 * t + 1, __float_as_int(w2 * wn));
        }
    }
}

__global__ void __launch_bounds__(NTHREADS, 2) fwd_kernel(Params P) {
    extern __shared__ __attribute__((aligned(16))) unsigned char lds_raw[];
    LAS unsigned char* lds = (LAS unsigned char*)lds_raw;
    volatile LAS unsigned* xbw = (volatile LAS unsigned*)(lds + 65536);
    if (threadIdx.x < 4) xbw[threadIdx.x] = 0u;
    __syncthreads();
    XcdBarrier bar; bar.bar = (unsigned*)(P.ws + WS_CTL); bar.x = 0; bar.st = xbw;
    const int lo = P.ph_lo, hi = P.ph_hi;
    if (hi - lo > 1) bar = xcd_barrier_post((unsigned*)(P.ws + WS_CTL), xbw);
#ifndef PHASE_MASK
#define PHASE_MASK 0x3ff
#endif
#define EN(c) (((PHASE_MASK) >> (c)) & 1)
#define IN(k) (lo <= (k) && (k) < hi)
#define SEAM(k) do { if (IN((k) + 1)) xcd_barrier(bar); } while (0)
#define TID_ENTER() int tid = threadIdx.x; asm volatile("" : "+v"(tid)); const int lane = tid & 63, wid = tid >> 6, wr = wid >> 1, wc = wid & 1, fr = lane & 15, fq = lane >> 4; (void)wr; (void)wc; (void)fr; (void)fq
#define PHASE_ENTER() TID_ENTER(); unsigned char* ws = P.ws; int l = l0; LAUNDER_S(ws); LAUNDER_S(l); const bool last = (l == DEPTH - 1); const int MT_Q = last ? TL / 128 : T / 128; \
    const float* mod = (const float*)(ws + WS_MOD); float* ssq = (float*)(ws + WS_SSQ); (void)mod; (void)ssq; (void)MT_Q; (void)last

    if (EN(0) && IN(0)) { TID_ENTER(); phase0(P, lds, tid); SEAM(0); }

    for (int l0 = 0; l0 < DEPTH; ++l0) {
        const int pb = 1 + l0 * 9;
        if (EN(1) && IN(pb + 0)) { TID_ENTER(); int l = l0; LAUNDER_S(l); phase_norm1(P, l, tid); SEAM(pb + 0); }
        if (EN(2) && IN(pb + 1)) {
            PHASE_ENTER();
            const bf16_t* hb = (const bf16_t*)(ws + WS_HBUF);
            const bf16_t* w = (const bf16_t*)(ws + WS_WIN) + (long)l * DINP * 1024;
            bf16_t* pbuf = (bf16_t*)(ws + WS_PBUF); bf16_t* vst = (bf16_t*)(ws + WS_VST);
            const int nu = (T / 128) * 11;
            for (int u = blockIdx.x; u < nu; u += gridDim.x) {
                const int mt = u / 11, nt = u % 11;
                GemmDesc g; g.A = hb + (long)mt * 128 * D; g.lda = D; g.B = w + (long)nt * 128 * 1024; g.ldb = 1024; g.K = 1024; g.aidx = nullptr; g.aidx_stride = 0; g.mvalid = 128;
                f32x4 acc[4][4];
                gemm_core(g, acc, lds, tid);
#pragma unroll
                for (int mb = 0; mb < 4; ++mb) {
                    const int t = mt * 128 + wr * 64 + mb * 16 + fr;
                    float sq = 0.f;
#pragma unroll
                    for (int nb = 0; nb < 4; ++nb) {
                        const int col = nt * 128 + wc * 64 + nb * 16 + fq * 4;
                        const f32x4 a = acc[mb][nb];
                        sq += a[0] * a[0] + a[1] * a[1] + a[2] * a[2] + a[3] * a[3];
                        if (col < DIN) {
                            u32x2 w2; w2.x = cvt_pk_bf16(a[0], a[1]); w2.y = cvt_pk_bf16(a[2], a[3]);
                            *(u32x2*)(pbuf + (long)t * DIN + col) = w2;
                            if (nt == 9) {
#pragma unroll
                                for (int j = 0; j < 4; ++j) vst[(long)(col - PC_VS + j) * T + t] = f2bf(a[j]);
                            }
                        }
                    }
                    if (nt >= 2 && nt <= 4) {
                        sq += __shfl_xor(sq, 16); sq += __shfl_xor(sq, 32);
                        if (fq == 0) ssq[(long)t * 8 + (nt - 2) * 2 + wc] = sq;
                    }
                }
            }
            SEAM(pb + 1);
        }
        if (EN(3) && IN(pb + 2)) {
            PHASE_ENTER();
            const bf16_t* pbuf = (const bf16_t*)(ws + WS_PBUF);
            const bf16_t* wuq = (const bf16_t*)(ws + WS_WUQ) + (long)l * 640 * 256;
            const bf16_t* wukv = (const bf16_t*)(ws + WS_WUKV) + (long)l * 768 * 128;
            const bf16_t* fw = (const bf16_t*)(ws + WS_FW) + (long)l * 4 * 128 * 64;
            bf16_t* qraw = (bf16_t*)(ws + WS_QRAW); bf16_t* knraw = (bf16_t*)(ws + WS_KNRAW); bf16_t* vmt = (bf16_t*)(ws + WS_VMT); bf16_t* abt = (bf16_t*)(ws + WS_ABT);
            const int nuq = MT_Q * 5, nukv = (T / 128) * 6, nuf = MT_Q * 4;
            for (int u = blockIdx.x; u < nuq + nukv + nuf; u += gridDim.x) {
                int kind, mt, nt;
                if (u < nuq) { kind = 0; mt = u / 5; nt = u % 5; } else if (u < nuq + nukv) { kind = 1; const int v = u - nuq; mt = v / 6; nt = v % 6; } else { kind = 2; const int v = u - nuq - nukv; mt = v >> 2; nt = v & 3; }
                GemmDesc g; g.lda = DIN; g.aidx = nullptr; g.aidx_stride = 0; g.mvalid = 128;
                if (kind == 0) { g.A = pbuf + (long)mt * 128 * DIN + PC_CQ; g.B = wuq + (long)nt * 128 * 256; g.ldb = 256; g.K = 256; }
                else if (kind == 1) { g.A = pbuf + (long)mt * 128 * DIN + PC_CKV; g.B = wukv + (long)nt * 128 * 128; g.ldb = 128; g.K = 128; }
                else { g.A = pbuf + (long)mt * 128 * DIN + nt * 64; g.B = fw + (long)nt * 128 * 64; g.ldb = 64; g.K = 64; }
                f32x4 acc[4][4];
                gemm_core(g, acc, lds, tid);
#pragma unroll
                for (int mb = 0; mb < 4; ++mb) {
                    const int t = mt * 128 + wr * 64 + mb * 16 + fr;
                    const float* sp = ssq + (long)t * 8;
                    float rs = 1.f;
                    if (kind == 0) rs = rsqrtf((sp[0] + sp[1] + sp[2] + sp[3]) * (1.0f / 256.0f) + EPS);
                    else if (kind == 1) rs = rsqrtf((sp[4] + sp[5]) * (1.0f / 128.0f) + EPS);
#pragma unroll
                    for (int nb = 0; nb < 4; ++nb) {
                        const int cl = wc * 64 + nb * 16 + fq * 4;
                        const f32x4 a = acc[mb][nb] * rs;
                        if (kind == 0) {
                            const int col = nt * 128 + cl;
                            if (col < 576) { u32x2 w2; w2.x = cvt_pk_bf16(a[0], a[1]); w2.y = cvt_pk_bf16(a[2], a[3]); *(u32x2*)(qraw + (long)t * 576 + col) = w2; }
                        } else if (kind == 1) {
                            const int col = nt * 128 + cl;
                            if (nt < 3) { u32x2 w2; w2.x = cvt_pk_bf16(a[0], a[1]); w2.y = cvt_pk_bf16(a[2], a[3]); *(u32x2*)(knraw + (long)t * 384 + col) = w2; }
                            else {
#pragma unroll
                                for (int j = 0; j < 4; ++j) vmt[(long)(col - 384 + j) * T + t] = f2bf(a[j]);
                            }
                        } else {
                            const int cs = cl >> 6, row = nt * 64 + (cl & 63);
                            bf16_t* dst = t < TL ? abt + ((long)(t >> 11) * 256 + row) * 4096 + cs * 2048 + (t & 2047)
                                                 : abt + (long)8 * 256 * 4096 + ((long)((t - TL) >> 8) * 256 + row) * 512 + cs * 256 + ((t - TL) & 255);
#pragma unroll
                            for (int j = 0; j < 4; ++j) dst[(long)j * (t < TL ? 4096 : 512)] = f2bf(a[j]);
                        }
                    }
                }
            }
            SEAM(pb + 2);
        }
        if (EN(4) && IN(pb + 3)) { TID_ENTER(); int l = l0; LAUNDER_S(l); phase_prep(P, l, tid); SEAM(pb + 3); }
        if (EN(5) && IN(pb + 4)) {
            PHASE_ENTER();
            const bf16_t* qm = (const bf16_t*)(ws + WS_QM); const bf16_t* km = (const bf16_t*)(ws + WS_KM); const bf16_t* vmt = (const bf16_t*)(ws + WS_VMT);
            const bf16_t* qs = (const bf16_t*)(ws + WS_QS); const bf16_t* ks = (const bf16_t*)(ws + WS_KS); const bf16_t* vst = (const bf16_t*)(ws + WS_VST);
            const bf16_t* abt = (const bf16_t*)(ws + WS_ABT); const bf16_t* csl = (const bf16_t*)(ws + WS_CS); const bf16_t* csc = (const bf16_t*)(ws + WS_CSC);
            bf16_t* outx = (bf16_t*)(ws + WS_OUTX);
            constexpr int U_ML = 768, U_FL = 256, U_SL = 768, U_MC = 96, U_SC = 96, U_FC = 32;
            const int nu = last ? (U_ML + U_FL + U_SL) : (U_ML + U_FL + U_SL + U_MC + U_SC + U_FC);
            for (int u = blockIdx.x; u < nu; u += gridDim.x) {
#ifdef P5_ONLY_FOURIER
                if (!((u >= U_ML && u < U_ML + U_FL) || u >= U_ML + U_FL + U_SL + U_MC + U_SC)) continue;
#endif
                if (u < U_ML) {
                    const int b = u / 96, r = u % 96, h = r >> 4, qb = r & 15;
                    const int qt = b * SEQ + qb * 128;
                    attn_unit<96, false>(qm + (long)qt * 576 + h * 96, 576, km + h * 96, 576, vmt + (long)h * 64 * T,
                                         b * SEQ, 32, TL + b * CL, 4, 0, 0, 0.f, false, outx + (long)qt * D + 256 + h * 64, lds, tid);
                } else if (u < U_ML + U_FL) {
                    const int v = u - U_ML, b = v >> 5, mt = (v >> 1) & 15, nt = v & 1;
                    GemmDesc g; g.A = csl + (long)mt * 128 * 4096; g.lda = 4096; g.B = abt + ((long)b * 256 + nt * 128) * 4096; g.ldb = 4096; g.K = 4096;
                    g.aidx = nullptr; g.aidx_stride = 0; g.mvalid = 128;
                    f32x4 acc[4][4];
                    gemm_core(g, acc, lds, tid);
#pragma unroll
                    for (int mb = 0; mb < 4; ++mb) {
                        const int t = b * SEQ + mt * 128 + wr * 64 + mb * 16 + fr;
#pragma unroll
                        for (int nb = 0; nb < 4; ++nb) { const f32x4 a = acc[mb][nb]; u32x2 w2; w2.x = cvt_pk_bf16(a[0], a[1]); w2.y = cvt_pk_bf16(a[2], a[3]);
                            *(u32x2*)(outx + (long)t * D + nt * 128 + wc * 64 + nb * 16 + fq * 4) = w2; }
                    }
                } else if (u < U_ML + U_FL + U_SL) {
                    const int v = u - U_ML - U_FL, b = v / 96, r = v % 96, h = r >> 4, qb = r & 15, kvh = h / 3;
                    const int qt = b * SEQ + qb * 128;
                    int k0 = qb * 128 - 128; if (k0 < 0) k0 = 0;
                    int k1 = qb * 128 + 256; if (k1 > SEQ) k1 = SEQ;
                    const float sink2 = P.in[I_SINK][l * 6 + h] * LOG2E;
                    attn_unit<64, true>(qs + (long)qt * 384 + h * 64, 384, ks + kvh * 64, 128, vst + (long)kvh * 64 * T,
                                        b * SEQ + k0, (k1 - k0) >> 6, TL + b * CL, 4, qb * 128, k0, sink2, true, outx + (long)qt * D + 640 + h * 64, lds, tid);
                } else if (u < U_ML + U_FL + U_SL + U_MC) {
                    const int v = u - U_ML - U_FL - U_SL, b = v / 12, r = v % 12, h = r >> 1, qb = r & 1;
                    const int qt = TL + b * CL + qb * 128;
                    attn_unit<96, false>(qm + (long)qt * 576 + h * 96, 576, km + h * 96, 576, vmt + (long)h * 64 * T,
                                         TL + b * CL, 4, 0, 0, 0, 0, 0.f, false, outx + (long)qt * D + 256 + h * 64, lds, tid);
                } else if (u < U_ML + U_FL + U_SL + U_MC + U_SC) {
                    const int v = u - U_ML - U_FL - U_SL - U_MC, b = v / 12, r = v % 12, h = r >> 1, qb = r & 1, kvh = h / 3;
                    const int qt = TL + b * CL + qb * 128;
                    const float sink2 = P.in[I_SINK][l * 6 + h] * LOG2E;
                    attn_unit<64, false>(qs + (long)qt * 384 + h * 64, 384, ks + kvh * 64, 128, vst + (long)kvh * 64 * T,
                                         TL + b * CL, 4, 0, 0, 0, 0, sink2, true, outx + (long)qt * D + 640 + h * 64, lds, tid);
                } else {
                    const int v = u - U_ML - U_FL - U_SL - U_MC - U_SC, b = v >> 2, mt = (v >> 1) & 1, nt = v & 1;
                    GemmDesc g; g.A = csc + (long)mt * 128 * 512; g.lda = 512; g.B = abt + (long)8 * 256 * 4096 + ((long)b * 256 + nt * 128) * 512; g.ldb = 512; g.K = 512;
                    g.aidx = nullptr; g.aidx_stride = 0; g.mvalid = 128;
                    f32x4 acc[4][4];
                    gemm_core(g, acc, lds, tid);
#pragma unroll
                    for (int mb = 0; mb < 4; ++mb) {
                        const int t = TL + b * CL + mt * 128 + wr * 64 + mb * 16 + fr;
#pragma unroll
                        for (int nb = 0; nb < 4; ++nb) { const f32x4 a = acc[mb][nb]; u32x2 w2; w2.x = cvt_pk_bf16(a[0], a[1]); w2.y = cvt_pk_bf16(a[2], a[3]);
                            *(u32x2*)(outx + (long)t * D + nt * 128 + wc * 64 + nb * 16 + fq * 4) = w2; }
                    }
                }
            }
            SEAM(pb + 4);
        }
        if (EN(6) && IN(pb + 5)) {
            PHASE_ENTER();
            const bf16_t* outx = (const bf16_t*)(ws + WS_OUTX);
            const bf16_t* w = (const bf16_t*)(ws + WS_WOUT) + (long)l * 1024 * 1024;
            const int nu = MT_Q * 8;
            for (int u = blockIdx.x; u < nu; u += gridDim.x) {
                const int mt = u >> 3, nt = u & 7;
                GemmDesc g; g.A = outx + (long)mt * 128 * D; g.lda = D; g.B = w + (long)nt * 128 * 1024; g.ldb = 1024; g.K = 1024; g.aidx = nullptr; g.aidx_stride = 0; g.mvalid = 128;
                f32x4 acc[4][4];
                gemm_core(g, acc, lds, tid);
#pragma unroll
                for (int mb = 0; mb < 4; ++mb) {
                    const int t = mt * 128 + wr * 64 + mb * 16 + fr;
                    const int r = t < TL ? (t >> 11) : 8;
                    float* xr = xrow(P, t);
                    const float* g1 = mod + ((long)l * 9 + r) * 6144 + 2048;
#pragma unroll
                    for (int nb = 0; nb < 4; ++nb) {
                        const int col = nt * 128 + wc * 64 + nb * 16 + fq * 4;
                        const f32x4 gv = *(const f32x4*)(g1 + col);
                        f32x4 xv = *(f32x4*)(xr + col);
                        xv += gv * acc[mb][nb];
                        *(f32x4*)(xr + col) = xv;
                    }
                }
            }
            SEAM(pb + 5);
        }
        if (EN(7) && IN(pb + 6)) { TID_ENTER(); int l = l0; LAUNDER_S(l); phase_norm2_router(P, l, lds, tid); SEAM(pb + 6); }
        if (EN(8) && (IN(pb + 7) || IN(pb + 8))) {
            PHASE_ENTER();
            const int* cnt = (const int*)(ws + WS_CTL + CTL_CNT_OFF) + l * 16;
            const int2* list = (const int2*)(ws + WS_LIST);
            const bf16_t* hb = (const bf16_t*)(ws + WS_HBUF);
            bf16_t* act = (bf16_t*)(ws + WS_ACT); bf16_t* ysl = (bf16_t*)(ws + WS_YSLOT);
            const bf16_t* wgu = (const bf16_t*)(ws + WS_WGU) + (long)l * NE * 1024 * 1024;
            const bf16_t* wdn = (const bf16_t*)(ws + WS_WDN) + (long)l * NE * 1024 * 512;
            int tstart[17];
            {
                int s = 0;
#pragma unroll
                for (int e = 0; e < 16; ++e) { tstart[e] = s; s += (__builtin_amdgcn_readfirstlane(cnt[e]) + 127) >> 7; }
                tstart[16] = s;
            }
            const int nu = tstart[16] * 8;
            if (IN(pb + 7)) {
                for (int u = blockIdx.x; u < nu; u += gridDim.x) {
                    const int rt = u >> 3, nt = u & 7;
                    int e = 0;
#pragma unroll
                    for (int j = 1; j < 16; ++j) if (rt >= tstart[j]) e = j;
                    int ts_e = 0;
#pragma unroll
                    for (int j = 0; j < 16; ++j) if (j == e) ts_e = tstart[j];
                    const int mt = rt - ts_e, ce = cnt[e], mv = (ce - mt * 128) < 128 ? (ce - mt * 128) : 128;
                    GemmDesc g; g.A = hb; g.lda = D; g.B = wgu + ((long)e * 1024 + nt * 128) * 1024; g.ldb = 1024; g.K = 1024;
                    g.aidx = (const int*)(list + (long)e * T + mt * 128); g.aidx_stride = 2; g.mvalid = mv;
                    f32x4 acc[4][4];
                    gemm_core(g, acc, lds, tid);
#pragma unroll
                    for (int mb = 0; mb < 4; ++mb) {
                        const int rl = wr * 64 + mb * 16 + fr;
                        if (rl < mv) {
                            bf16_t* ar = act + ((long)rt * 128 + rl) * DE + nt * 64 + wc * 32 + fq * 4;
#pragma unroll
                            for (int p = 0; p < 2; ++p) {
                                const f32x4 gt = acc[mb][2 * p], up = acc[mb][2 * p + 1];
                                u32x2 w2; w2.x = cvt_pk_bf16(silu_f(gt[0]) * up[0], silu_f(gt[1]) * up[1]); w2.y = cvt_pk_bf16(silu_f(gt[2]) * up[2], silu_f(gt[3]) * up[3]);
                                *(u32x2*)(ar + p * 16) = w2;
                            }
                        }
                    }
                }
                SEAM(pb + 7);
            }
            if (IN(pb + 8)) {
                for (int u = blockIdx.x; u < nu; u += gridDim.x) {
                    const int rt = u >> 3, nt = u & 7;
                    int e = 0;
#pragma unroll
                    for (int j = 1; j < 16; ++j) if (rt >= tstart[j]) e = j;
                    int ts_e = 0;
#pragma unroll
                    for (int j = 0; j < 16; ++j) if (j == e) ts_e = tstart[j];
                    const int mt = rt - ts_e, ce = cnt[e], mv = (ce - mt * 128) < 128 ? (ce - mt * 128) : 128;
                    GemmDesc g; g.A = act + (long)rt * 128 * DE; g.lda = DE; g.B = wdn + ((long)e * 1024 + nt * 128) * 512; g.ldb = 512; g.K = 512;
                    g.aidx = nullptr; g.aidx_stride = 0; g.mvalid = 128;
                    f32x4 acc[4][4];
                    gemm_core(g, acc, lds, tid);
#pragma unroll
                    for (int mb = 0; mb < 4; ++mb) {
                        const int rl = wr * 64 + mb * 16 + fr;
                        if (rl < mv) {
                            const int2 le = list[(long)e * T + mt * 128 + rl];
                            const float wgt = __int_as_float(le.y);
                            bf16_t* yr = ysl + (long)le.x * D + nt * 128 + wc * 64 + fq * 4;
#pragma unroll
                            for (int nb = 0; nb < 4; ++nb) { const f32x4 a = acc[mb][nb] * wgt; u32x2 w2; w2.x = cvt_pk_bf16(a[0], a[1]); w2.y = cvt_pk_bf16(a[2], a[3]); *(u32x2*)(yr + nb * 16) = w2; }
                        }
                    }
                }
                SEAM(pb + 8);
            }
        }
    }
    if (EN(9) && IN(1 + DEPTH * 9)) { TID_ENTER(); phase_final(P, tid); }
#undef IN
#undef SEAM
}


#ifndef DUMP_MASK
#define DUMP_MASK 0
#endif
__device__ __forceinline__ float dbg_ld(const unsigned char* ws, size_t off, size_t len, size_t i) { return bf2f(((const bf16_t*)(ws + off))[i % len]); }
__global__ void dump_kernel(float* out, const unsigned char* ws, int mask) {
    const size_t n = (size_t)TL * D;
    for (size_t i = (size_t)blockIdx.x * blockDim.x + threadIdx.x; i < n; i += (size_t)gridDim.x * blockDim.x) {
        float v = 0.f;
        if (mask & 1) v += dbg_ld(ws, WS_HBUF, (size_t)T * D, i);
        if (mask & 2) v += dbg_ld(ws, WS_PBUF, (size_t)T * DIN, i) + dbg_ld(ws, WS_PBUF, (size_t)T * DIN, i + 7500000) + dbg_ld(ws, WS_VST, (size_t)128 * T, i);
        if (mask & 4) v += dbg_ld(ws, WS_QRAW, (size_t)T * 576, i) + dbg_ld(ws, WS_KNRAW, (size_t)T * 384, i) + dbg_ld(ws, WS_VMT, (size_t)T * 384, i) + dbg_ld(ws, WS_ABT, (size_t)T * 512, i);
        if (mask & 8) v += dbg_ld(ws, WS_QM, (size_t)T * 576, i) + dbg_ld(ws, WS_KM, (size_t)T * 576, i) + dbg_ld(ws, WS_QS, (size_t)T * 384, i) + dbg_ld(ws, WS_KS, (size_t)T * 128, i);
        if (mask & 16) v += dbg_ld(ws, WS_OUTX, (size_t)T * D, i);
        { const int c = (int)(i & 1023); const bool sel = ((mask & 64) && c < 256) || ((mask & 128) && c >= 256 && c < 640) || ((mask & 256) && c >= 640);
          if (sel) v += dbg_ld(ws, WS_OUTX, (size_t)T * D, i); }
        if (mask & 32) v += dbg_ld(ws, WS_CS, (size_t)2048 * 4096, i) + dbg_ld(ws, WS_WOUT, (size_t)4 * 1024 * 1024, i) + dbg_ld(ws, WS_WGU, (size_t)64 * 1024 * 1024, i) + dbg_ld(ws, WS_WDN, (size_t)64 * 1024 * 512, i)
                         + ((const float*)(ws + WS_MOD))[i % (size_t)(4 * 9 * 6144)] + ((const float*)(ws + WS_ROPES))[i % (size_t)(2048 * 64)] + ((const float*)(ws + WS_ROPEM))[i % (size_t)(2048 * 32)] + dbg_ld(ws, WS_FW, (size_t)16 * 128 * 64, i);
        out[i] = v;
    }
}
extern "C" void kernel_launch(void* const* d_in, const int* in_sizes, int n_in, void* d_out, int out_size, void* d_ws, size_t ws_size, hipStream_t stream) {
    static int grid = 0;
    if (grid == 0) {
        if (n_in != 26 || ws_size < WS_END) { fprintf(stderr, "kernel_launch: expected 26 inputs and >= %zu bytes of workspace (got %d, %zu)\n", (size_t)WS_END, n_in, ws_size); grid = -1; return; }
        int dev = 0, cus = 0, per_cu = 0;
        hipGetDevice(&dev);
        hipDeviceGetAttribute(&cus, hipDeviceAttributeMultiprocessorCount, dev);
        hipFuncSetAttribute((const void*)fwd_kernel, hipFuncAttributeMaxDynamicSharedMemorySize, LDS_BYTES);
        if (hipOccupancyMaxActiveBlocksPerMultiprocessor(&per_cu, (const void*)fwd_kernel, NTHREADS, LDS_BYTES) != hipSuccess || per_cu < 1) per_cu = 1;
        (void)hipGetLastError();
        grid = cus * (per_cu < 2 ? per_cu : 2);
    }
    if (grid < 0) return;
    hipMemsetAsync((char*)d_ws + WS_CTL, 0, CTL_BYTES, stream);
    Params p{};
    for (int i = 0; i < 26; ++i) p.in[i] = (const float*)d_in[i];
    p.out = (float*)d_out; p.ws = (unsigned char*)d_ws;
#ifndef STOP_PH
#define STOP_PH (2 + DEPTH * 9)
#endif
    constexpr int NPH = STOP_PH;
#if N_LAUNCH_MODE == 1
    p.ph_lo = 0; p.ph_hi = NPH;
    hipLaunchKernelGGL(fwd_kernel, dim3(grid), dim3(NTHREADS), LDS_BYTES, stream, p);
#else
    for (int k = 0; k < NPH; ++k) { p.ph_lo = k; p.ph_hi = k + 1; hipLaunchKernelGGL(fwd_kernel, dim3(grid), dim3(NTHREADS), LDS_BYTES, stream, p); }
#endif
    if (DUMP_MASK) hipLaunchKernelGGL(dump_kernel, dim3(1024), dim3(256), 0, stream, (float*)d_out, (const unsigned char*)d_ws, (int)DUMP_MASK);
}
```

```cpp
#include <hip/hip_runtime.h>
#include <cstdint>
#include <cstdio>

#ifndef PROBE_SEL1
#define PROBE_SEL1 -1
#endif
#ifndef PROBE_SEL2
#define PROBE_SEL2 -1
#endif
#ifndef N_LAUNCH_MODE
#define N_LAUNCH_MODE 1
#endif

#define LAS __attribute__((address_space(3)))
typedef unsigned short bf16_t;
typedef short bf16x8 __attribute__((ext_vector_type(8)));
typedef float f32x4 __attribute__((ext_vector_type(4)));
typedef float f32x16 __attribute__((ext_vector_type(16)));
typedef unsigned u32x4 __attribute__((ext_vector_type(4)));
typedef unsigned u32x2 __attribute__((ext_vector_type(2)));

constexpr int D = 1024, NB = 8, SEQ = 2048, CL = 256, DEPTH = 4;
constexpr int TL = NB * SEQ, TC = NB * CL, T = TL + TC;
constexpr int DIN = 1312, DINP = 1408;
constexpr int NE = 16, DE = 512;
constexpr int PC_CQ = 256, PC_CKV = 512, PC_QS = 640, PC_KS = 1024, PC_VS = 1152, PC_KR = 1280;
constexpr float EPS = 1e-6f;
constexpr float LOG2E = 1.4426950408889634f;
constexpr int NTHREADS = 256;
constexpr int LDS_BYTES = 81920;

constexpr size_t al256(size_t x) { return (x + 255) & ~(size_t)255; }
constexpr size_t WS_CTL = 0;
constexpr size_t CTL_BYTES = 32768;
constexpr size_t CTL_CNT_OFF = 16384;
constexpr size_t CTL_Q_OFF = 26624;
constexpr size_t CTL_LB_OFF = 28672;
constexpr size_t WS_MOD = WS_CTL + CTL_BYTES;
constexpr size_t WS_ROPES = WS_MOD + al256((size_t)DEPTH * 9 * 6144 * 4);
constexpr size_t WS_ROPEM = WS_ROPES + (size_t)2048 * 32 * 8;
constexpr size_t WS_FW = WS_ROPEM + (size_t)2048 * 16 * 8;
constexpr size_t WS_CS = WS_FW + (size_t)DEPTH * 4 * 128 * 128 * 2;
constexpr size_t WS_CSC = WS_CS + (size_t)2048 * 4096 * 2;
constexpr size_t WS_WIN = WS_CSC + (size_t)256 * 512 * 2;
constexpr size_t WS_WUQ = WS_WIN + (size_t)DEPTH * DINP * 1024;
constexpr size_t WS_WUKV = WS_WUQ + (size_t)DEPTH * 640 * 256 * 2;
constexpr size_t WS_WOUT = WS_WUKV + (size_t)DEPTH * 768 * 128 * 2;
constexpr size_t WS_WGU = WS_WOUT + (size_t)DEPTH * 1024 * 1024;
constexpr size_t WS_WDN = WS_WGU + (size_t)DEPTH * NE * 1024 * 1024;
constexpr size_t WS_CTX = WS_WDN + (size_t)DEPTH * NE * 1024 * 512;
constexpr size_t WS_SSQ = WS_CTX + (size_t)TC * D * 4;
constexpr size_t WS_HBUF = WS_SSQ + (size_t)T * 8 * 4;
constexpr size_t WS_R = WS_HBUF + (size_t)T * D * 2;
constexpr size_t WS_PBUF = WS_R;
constexpr size_t WS_QRAW = WS_PBUF + (size_t)T * DIN * 2;
constexpr size_t WS_KNRAW = WS_QRAW + (size_t)T * 576 * 2;
constexpr size_t WS_QM = WS_KNRAW + (size_t)T * 384 * 2;
constexpr size_t WS_KM = WS_QM + (size_t)T * 576 * 2;
constexpr size_t WS_VMT = WS_KM + (size_t)T * 576 * 2;
constexpr size_t WS_QS = WS_VMT + (size_t)384 * T * 2;
constexpr size_t WS_KS = WS_QS + (size_t)T * 384 * 2;
constexpr size_t WS_VST = WS_KS + (size_t)T * 128 * 2;
constexpr size_t WS_ABT = WS_VST + (size_t)128 * T * 2;
constexpr size_t WS_OUTX = WS_ABT + (size_t)512 * T * 2;
constexpr size_t WS_MIX_END = WS_OUTX + (size_t)T * D * 2;
constexpr size_t WS_ACT = WS_R;
constexpr size_t WS_LIST = WS_MIX_END;
constexpr size_t WS_YSLOT = WS_LIST + (size_t)NE * T * 8;
constexpr size_t WS_MOE_END = WS_YSLOT + (size_t)2 * T * D * 2;
constexpr size_t WS_TS = WS_MIX_END > WS_MOE_END ? WS_MIX_END : WS_MOE_END;
constexpr size_t WS_END = WS_TS + 1024 * 16 * 8;

#define XB_TMO      128
#define XB_XCNT(j)  (256  + 64 * (j))
#define XB_XSUB(j)  (1280 + 64 * (j))
#define XB_XGEN(j)  (2304 + 64 * (j))
#define XB_TOP      3328
#define XB_TOPGEN   3392
#define XCD_BAR_WORDS 3456
#define XB_SPIN_CAP (1u << 22)

__device__ __forceinline__ unsigned xb_ld(unsigned* p)              { return __hip_atomic_load(p, __ATOMIC_RELAXED, __HIP_MEMORY_SCOPE_AGENT); }
__device__ __forceinline__ unsigned xb_add(unsigned* p, unsigned v) { return __hip_atomic_fetch_add(p, v, __ATOMIC_RELAXED, __HIP_MEMORY_SCOPE_AGENT); }
__device__ __forceinline__ unsigned xb_xcc_id() { return (unsigned)__builtin_amdgcn_s_getreg((3 << 11) | 20) & 0xFu; }
#define XB_SPIN(cond, bar) do { unsigned _sp = 0; while (cond) { __builtin_amdgcn_s_sleep(1); \
    if ((++_sp & 255u) == 0u) { if (xb_ld(&(bar)[XB_TMO])) break; if (_sp > XB_SPIN_CAP) { atomicAdd(&(bar)[XB_TMO], 1u); break; } } } } while (0)

struct XcdBarrier { unsigned* bar; unsigned x; unsigned nloc, nx; };

__device__ __forceinline__ XcdBarrier xcd_barrier_post(unsigned* bar, unsigned& slot0) {
    XcdBarrier b; b.bar = bar; b.x = xb_xcc_id(); b.nloc = 0u; b.nx = 0u;
    if (threadIdx.x == 0) slot0 = xb_add(&bar[XB_XCNT(b.x)], 1u);
    return b;
}
__device__ __forceinline__ void xcd_local_barrier(unsigned* bar, unsigned* cnt, unsigned& gen, unsigned nsl) {
    asm volatile("s_waitcnt vmcnt(0)" ::: "memory");
    __syncthreads();
    ++gen;
    if (threadIdx.x == 0) {
        __builtin_amdgcn_s_waitcnt(0);
        (void)xb_add(cnt, 1u);
        const unsigned want = gen * nsl;
        XB_SPIN(xb_ld(cnt) < want, bar);
        __builtin_amdgcn_fence(__ATOMIC_ACQUIRE, "agent");
        asm volatile("s_waitcnt vmcnt(0)" ::: "memory");
    }
    __syncthreads();
}
__device__ __forceinline__ void xcd_barrier_complete(unsigned* bar, unsigned x, unsigned& nloc, unsigned& nx) {
    const unsigned G = gridDim.x * gridDim.y * gridDim.z;
    unsigned sum, cnt, mine, sp = 0u;
    for (;;) {
        sum = 0u; cnt = 0u; mine = 0u;
#pragma unroll
        for (unsigned j = 0; j < 16; ++j) { const unsigned c = xb_ld(&bar[XB_XCNT(j)]); sum += c; cnt += (c > 0u) ? 1u : 0u; mine = (j == x) ? c : mine; }
        if (sum == G) break;
        __builtin_amdgcn_s_sleep(1);
        if ((++sp & 255u) == 0u) { if (xb_ld(&bar[XB_TMO])) break; if (sp > XB_SPIN_CAP) { atomicAdd(&bar[XB_TMO], 1u); break; } }
    }
    nloc = mine > 0u ? mine : 1u; nx = cnt > 0u ? cnt : 1u;
}
__device__ __forceinline__ void xcd_barrier(XcdBarrier& b) {
    asm volatile("s_waitcnt vmcnt(0)" ::: "memory");
    __syncthreads();
    unsigned nl_out = b.nloc, nx_out = b.nx;
    if (threadIdx.x == 0) {
        unsigned* bar = b.bar;
        __builtin_amdgcn_s_waitcnt(0);
        unsigned nloc = b.nloc, nx = b.nx;
        if (nloc == 0u) { xcd_barrier_complete(bar, b.x, nloc, nx); b.nloc = nloc; b.nx = nx; }
        nl_out = nloc; nx_out = nx;
        const unsigned old = xb_add(&bar[XB_XSUB(b.x)], 1u);
        const unsigned gen = old / nloc;
        if (old + 1u == (gen + 1u) * nloc) {
            __builtin_amdgcn_fence(__ATOMIC_RELEASE, "agent");
            asm volatile("s_waitcnt vmcnt(0)" ::: "memory");
            const unsigned og = xb_add(&bar[XB_TOP], 1u);
            const unsigned tg = og / nx;
            if (og + 1u == (tg + 1u) * nx) xb_add(&bar[XB_TOPGEN], 1u);
            else XB_SPIN(xb_ld(&bar[XB_TOPGEN]) == tg, bar);
            __builtin_amdgcn_fence(__ATOMIC_ACQUIRE, "agent");
            xb_add(&bar[XB_XGEN(b.x)], 1u);
            asm volatile("s_waitcnt vmcnt(0)" ::: "memory");
        } else {
            XB_SPIN(xb_ld(&bar[XB_XGEN(b.x)]) == gen, bar);
            __builtin_amdgcn_fence(__ATOMIC_ACQUIRE, "agent");
            asm volatile("s_waitcnt vmcnt(0)" ::: "memory");
        }
    }
    b.nloc = __builtin_amdgcn_readfirstlane(nl_out); b.nx = __builtin_amdgcn_readfirstlane(nx_out);
    __syncthreads();
}

typedef float cvt_f2_t __attribute__((ext_vector_type(2)));
typedef __bf16 cvt_b2_t __attribute__((ext_vector_type(2)));
__device__ __forceinline__ unsigned cvt_pk_bf16(float lo, float hi) { const cvt_f2_t v = {lo, hi}; const cvt_b2_t r = __builtin_convertvector(v, cvt_b2_t); return __builtin_bit_cast(unsigned, r); }
__device__ __forceinline__ float bf2f(bf16_t v) { return __uint_as_float((unsigned)v << 16); }
__device__ __forceinline__ bf16_t f2bf(float v) { return (bf16_t)(cvt_pk_bf16(v, 0.f) & 0xffffu); }
__device__ __forceinline__ float bf_lo(unsigned w) { return __uint_as_float(w << 16); }
__device__ __forceinline__ float bf_hi(unsigned w) { return __uint_as_float(w & 0xffff0000u); }
template <int CTRL> __device__ __forceinline__ float dpp_mov(float v) { return __builtin_bit_cast(float, __builtin_amdgcn_update_dpp(0, __builtin_bit_cast(int, v), CTRL, 0xF, 0xF, true)); }
__device__ __forceinline__ float wave_sum16(const float (&p)[16], const int lane) {
    float q8[8], q4[4], q2[2];
    const bool b3 = (lane & 8) != 0, b2 = (lane & 4) != 0, b1 = (lane & 2) != 0, b0 = (lane & 1) != 0;
#pragma unroll
    for (int j = 0; j < 8; ++j) { const float keep = b3 ? p[j + 8] : p[j], send = b3 ? p[j] : p[j + 8]; q8[j] = keep + dpp_mov<0x128>(send); }
#pragma unroll
    for (int j = 0; j < 4; ++j) { const float keep = b2 ? q8[j + 4] : q8[j], send = b2 ? q8[j] : q8[j + 4]; q4[j] = keep + dpp_mov<0x141>(send); }
#pragma unroll
    for (int j = 0; j < 2; ++j) { const float keep = b1 ? q4[j + 2] : q4[j], send = b1 ? q4[j] : q4[j + 2]; q2[j] = keep + dpp_mov<0x4E>(send); }
    float t = (b0 ? q2[1] : q2[0]) + dpp_mov<0xB1>(b0 ? q2[0] : q2[1]);
    t += __shfl_xor(t, 16);
    t += __shfl_xor(t, 32);
    return t;
}
__device__ __forceinline__ float wave_sum(float v) {
    v += dpp_mov<0xB1>(v);
    v += dpp_mov<0x4E>(v);
    v += dpp_mov<0x141>(v);
    v += dpp_mov<0x140>(v);
    const int vi = __builtin_bit_cast(int, v);
    const float r0 = __builtin_bit_cast(float, __builtin_amdgcn_readlane(vi, 0)), r1 = __builtin_bit_cast(float, __builtin_amdgcn_readlane(vi, 16)), r2 = __builtin_bit_cast(float, __builtin_amdgcn_readlane(vi, 32)), r3 = __builtin_bit_cast(float, __builtin_amdgcn_readlane(vi, 48));
    return (r0 + r1) + (r2 + r3);
}
__device__ __forceinline__ float fast_exp2(float x) { return __builtin_amdgcn_exp2f(x); }
__device__ __forceinline__ float silu_f(float v) { return v / (1.0f + __expf(-v)); }
#define VM_WAIT0() asm volatile("s_waitcnt vmcnt(0)" ::: "memory")
#define LAUNDER_S(x) asm volatile("" : "+s"(x))
#define GLDS16S(sbase, voff, m0v) asm volatile("s_mov_b32 m0, %2\n\ts_nop 0\n\tglobal_load_lds_dwordx4 %0, %1\n\ts_nop 1" :: "v"(voff), "s"(sbase), "s"(m0v) : "memory")

struct Params {
    const float* in[26];
    float* out;
    unsigned char* ws;
    int ph_lo, ph_hi;
};
enum { I_X = 0, I_C, I_CTX, I_CCTX, I_ADAW, I_ADAB, I_N1G, I_N2G, I_WIN, I_FNETW, I_CQG, I_CKVG, I_WUQ, I_WUK, I_WUV, I_MQG, I_MKG, I_SQG, I_SKG, I_SINK, I_WOUT, I_RW, I_RB, I_EG, I_EU, I_ED };

struct GemmDesc {
    const bf16_t* A; const bf16_t* B;
    long lda, ldb;
    int K;
    const int* aidx; int aidx_stride;
    int mvalid;
};

#define VM_WAITN(n) asm volatile("s_waitcnt vmcnt(" #n ")" ::: "memory")
#define RING_STEP(J, WAITN, ISSUE) do { VM_WAITN(WAITN); __syncthreads(); if (ISSUE) RING_STAGE(t + (J) + 3, ((J) + 3) & 3); RING_COMPUTE(J); } while (0)
#define RING_LOOP() do { \
    RING_STAGE(0, 0); RING_STAGE(1, 1); RING_STAGE(2, 2); \
    int t = 0; \
    for (; t + 4 < nt; t += 4) { RING_STEP(0, 8, true); RING_STEP(1, 8, true); RING_STEP(2, 8, true); RING_STEP(3, 8, true); } \
    RING_STEP(0, 8, true); RING_STEP(1, 8, false); RING_STEP(2, 4, false); RING_STEP(3, 0, false); \
    __syncthreads(); } while (0)

__device__ __forceinline__ void gemm_core_ring(const GemmDesc& d, f32x4 (&acc)[4][4], LAS unsigned char* lds, const int tid) {
    const int lane = tid & 63, wid = tid >> 6, wr = wid >> 1, wc = wid & 1, fr = lane & 15, fq = lane >> 4;
    const int srow = tid >> 2;
    const int schunk = (tid & 3) ^ ((0x78 >> (2 * ((tid >> 4) & 3))) & 3);
    unsigned oa[2], ob[2];
#pragma unroll
    for (int i = 0; i < 2; ++i) {
        const int r = i * 64 + srow;
        long ar;
        if (d.aidx) { const int rr = r < d.mvalid ? r : 0; ar = (long)(d.aidx[(long)rr * d.aidx_stride] >> 1); } else ar = r;
        oa[i] = (unsigned)((ar * d.lda + schunk * 8) * 2);
        ob[i] = (unsigned)(((long)r * d.ldb + schunk * 8) * 2);
    }
    const int nt = d.K >> 5;
#pragma unroll
    for (int mb = 0; mb < 4; ++mb)
#pragma unroll
        for (int nb = 0; nb < 4; ++nb) acc[mb][nb] = (f32x4){0.f, 0.f, 0.f, 0.f};
    const int ph = fq ^ ((0x78 >> (2 * ((fr >> 2) & 3))) & 3);
    const int aoff = (wr * 64 + fr) * 64 + (ph << 4), boff = 8192 + (wc * 64 + fr) * 64 + (ph << 4);
    const unsigned m0b = __builtin_amdgcn_readfirstlane((unsigned)(size_t)(lds + tid * 16));
#define RING_STAGE(t_, S) do { const bf16_t* sa_ = d.A + (long)(t_) * 32; const bf16_t* sb_ = d.B + (long)(t_) * 32; _Pragma("unroll") for (int i = 0; i < 2; ++i) { \
        GLDS16S(sa_, oa[i], m0b + (S) * 16384 + i * 4096); GLDS16S(sb_, ob[i], m0b + (S) * 16384 + 8192 + i * 4096); } } while (0)
#define RING_COMPUTE(S) do { bf16x8 af[4], bfr[4]; \
        _Pragma("unroll") for (int mb = 0; mb < 4; ++mb) af[mb] = *(LAS bf16x8*)(lds + (S) * 16384 + aoff + mb * 1024); \
        _Pragma("unroll") for (int nb = 0; nb < 4; ++nb) bfr[nb] = *(LAS bf16x8*)(lds + (S) * 16384 + boff + nb * 1024); \
        _Pragma("unroll") for (int mb = 0; mb < 4; ++mb) _Pragma("unroll") for (int nb = 0; nb < 4; ++nb) \
            acc[mb][nb] = __builtin_amdgcn_mfma_f32_16x16x32_bf16(bfr[nb], af[mb], acc[mb][nb], 0, 0, 0); } while (0)
    RING_LOOP();
#undef RING_STAGE
#undef RING_COMPUTE
}


__device__ __forceinline__ unsigned cvt4_fp8(float a, float b, float c, float d) {
    unsigned v;
    asm("s_nop 0\n\tv_cvt_pk_fp8_f32 %0, %1, %2" : "=v"(v) : "v"(a), "v"(b));
    asm("v_cvt_pk_fp8_f32 %0, %1, %2 op_sel:[0,0,1]\n\ts_nop 0" : "+v"(v) : "v"(c), "v"(d));
    return v;
}
constexpr float W8_SCALE = 64.0f;
constexpr float ACT8_SCALE = 8.0f;
constexpr float OUT8_SCALE = 8.0f;

struct GemmDesc8 {
    const unsigned char* A; const unsigned char* B;
    long lda, ldb;
    int K;
    const int* aidx; int aidx_stride;
    int mvalid;
};
__device__ __forceinline__ void gemm_core8_ring(const GemmDesc8& d, f32x4 (&acc)[4][4], LAS unsigned char* lds, const int tid) {
    const int lane = tid & 63, wid = tid >> 6, wr = wid >> 1, wc = wid & 1, fr = lane & 15, fq = lane >> 4;
    const int srow = tid >> 2;
    const int schunk = (tid & 3) ^ ((0x78 >> (2 * ((tid >> 4) & 3))) & 3);
    unsigned oa[2], ob[2];
#pragma unroll
    for (int i = 0; i < 2; ++i) {
        const int r = i * 64 + srow;
        long ar;
        if (d.aidx) { const int rr = r < d.mvalid ? r : 0; ar = (long)(d.aidx[(long)rr * d.aidx_stride] >> 1); } else ar = r;
        oa[i] = (unsigned)(ar * d.lda + schunk * 16);
        ob[i] = (unsigned)((long)r * d.ldb + schunk * 16);
    }
    const int nt = d.K >> 6;
#pragma unroll
    for (int mb = 0; mb < 4; ++mb)
#pragma unroll
        for (int nb = 0; nb < 4; ++nb) acc[mb][nb] = (f32x4){0.f, 0.f, 0.f, 0.f};
    const int ph = fq ^ ((0x78 >> (2 * ((fr >> 2) & 3))) & 3);
    const int aoff = (wr * 64 + fr) * 64 + (ph << 4), boff = 8192 + (wc * 64 + fr) * 64 + (ph << 4);
    const unsigned m0b = __builtin_amdgcn_readfirstlane((unsigned)(size_t)(lds + tid * 16));
    typedef long l2 __attribute__((ext_vector_type(2)));
#define RING_STAGE(t_, S) do { const unsigned char* sa_ = d.A + (long)(t_) * 64; const unsigned char* sb_ = d.B + (long)(t_) * 64; _Pragma("unroll") for (int i = 0; i < 2; ++i) { \
        GLDS16S(sa_, oa[i], m0b + (S) * 16384 + i * 4096); GLDS16S(sb_, ob[i], m0b + (S) * 16384 + 8192 + i * 4096); } } while (0)
#define RING_COMPUTE(S) do { l2 af[4], bfr[4]; \
        _Pragma("unroll") for (int mb = 0; mb < 4; ++mb) af[mb] = *(LAS l2*)(lds + (S) * 16384 + aoff + mb * 1024); \
        _Pragma("unroll") for (int nb = 0; nb < 4; ++nb) bfr[nb] = *(LAS l2*)(lds + (S) * 16384 + boff + nb * 1024); \
        _Pragma("unroll") for (int mb = 0; mb < 4; ++mb) _Pragma("unroll") for (int nb = 0; nb < 4; ++nb) { \
            acc[mb][nb] = __builtin_amdgcn_mfma_f32_16x16x32_fp8_fp8(bfr[nb].x, af[mb].x, acc[mb][nb], 0, 0, 0); \
            acc[mb][nb] = __builtin_amdgcn_mfma_f32_16x16x32_fp8_fp8(bfr[nb].y, af[mb].y, acc[mb][nb], 0, 0, 0); } } while (0)
    RING_LOOP();
#undef RING_STAGE
#undef RING_COMPUTE
}

__device__ __forceinline__ void gemm_core_db(const GemmDesc& d, f32x4 (&acc)[4][4], LAS unsigned char* lds, const int tid) {
    const int lane = tid & 63, wid = tid >> 6, wr = wid >> 1, wc = wid & 1, fr = lane & 15, fq = lane >> 4;
    const int srow = tid >> 3;
    const int schunk = (tid & 7) ^ ((tid >> 4) & 7);
    unsigned oa[4], ob[4];
#pragma unroll
    for (int i = 0; i < 4; ++i) {
        const int r = i * 32 + srow;
        long ar;
        if (d.aidx) { const int rr = r < d.mvalid ? r : 0; ar = (long)(d.aidx[(long)rr * d.aidx_stride] >> 1); } else ar = r;
        oa[i] = (unsigned)((ar * d.lda + schunk * 8) * 2);
        ob[i] = (unsigned)(((long)r * d.ldb + schunk * 8) * 2);
    }
    const int nt = d.K >> 6;
#pragma unroll
    for (int mb = 0; mb < 4; ++mb)
#pragma unroll
        for (int nb = 0; nb < 4; ++nb) acc[mb][nb] = (f32x4){0.f, 0.f, 0.f, 0.f};
    const int swz = (fr >> 1) & 7;
    const int aoff = (wr * 64 + fr) * 128, boff = 16384 + (wc * 64 + fr) * 128;
    const unsigned m0b = __builtin_amdgcn_readfirstlane((unsigned)(size_t)(lds + tid * 16));
#define GEMM_STAGE(t_, BUF) do { const bf16_t* sa_ = d.A + (long)(t_) * 64; const bf16_t* sb_ = d.B + (long)(t_) * 64; _Pragma("unroll") for (int i = 0; i < 4; ++i) { \
        GLDS16S(sa_, oa[i], m0b + (BUF) * 32768 + i * 4096); GLDS16S(sb_, ob[i], m0b + (BUF) * 32768 + 16384 + i * 4096); } } while (0)
#define GEMM_COMPUTE(BUF) do { _Pragma("unroll") for (int ks = 0; ks < 2; ++ks) { bf16x8 af[4], bfr[4]; const int co = ((ks * 4 + fq) ^ swz) << 4; \
        _Pragma("unroll") for (int mb = 0; mb < 4; ++mb) af[mb] = *(LAS bf16x8*)(lds + (BUF) * 32768 + aoff + mb * 2048 + co); \
        _Pragma("unroll") for (int nb = 0; nb < 4; ++nb) bfr[nb] = *(LAS bf16x8*)(lds + (BUF) * 32768 + boff + nb * 2048 + co); \
        _Pragma("unroll") for (int mb = 0; mb < 4; ++mb) _Pragma("unroll") for (int nb = 0; nb < 4; ++nb) \
            acc[mb][nb] = __builtin_amdgcn_mfma_f32_16x16x32_bf16(bfr[nb], af[mb], acc[mb][nb], 0, 0, 0); } } while (0)
    GEMM_STAGE(0, 0);
    VM_WAIT0(); __syncthreads();
    for (int t = 0; t < nt; t += 2) {
        GEMM_STAGE(t + 1, 1);
        GEMM_COMPUTE(0);
        VM_WAIT0(); __syncthreads();
        if (t + 2 < nt) GEMM_STAGE(t + 2, 0);
        GEMM_COMPUTE(1);
        VM_WAIT0(); __syncthreads();
    }
#undef GEMM_STAGE
#undef GEMM_COMPUTE
}


typedef int i32x8_t __attribute__((ext_vector_type(8)));
typedef int i32x4_t __attribute__((ext_vector_type(4)));
template <int K128>
__device__ __forceinline__ void gemm_core8_db(const GemmDesc8& d, f32x4 (&acc)[4][4], LAS unsigned char* lds, const int tid) {
    const int lane = tid & 63, wid = tid >> 6, wr = wid >> 1, wc = wid & 1, fr = lane & 15, fq = lane >> 4;
    const int srow = tid >> 3;
    const int schunk = (tid & 7) ^ ((tid >> 4) & 7);
    unsigned oa[4], ob[4];
#pragma unroll
    for (int i = 0; i < 4; ++i) {
        const int r = i * 32 + srow;
        long ar;
        if (d.aidx) { const int rr = r < d.mvalid ? r : 0; ar = (long)(d.aidx[(long)rr * d.aidx_stride] >> 1); } else ar = r;
        oa[i] = (unsigned)(ar * d.lda + schunk * 16);
        ob[i] = (unsigned)((long)r * d.ldb + schunk * 16);
    }
    int nt = d.K >> 7;
    asm volatile("" : "+s"(nt));
#pragma unroll
    for (int mb = 0; mb < 4; ++mb)
#pragma unroll
        for (int nb = 0; nb < 4; ++nb) acc[mb][nb] = (f32x4){0.f, 0.f, 0.f, 0.f};
    const int swz = (fr >> 1) & 7;
    const int aoff = (wr * 64 + fr) * 128, boff = 16384 + (wc * 64 + fr) * 128;
    const unsigned m0b = __builtin_amdgcn_readfirstlane((unsigned)(size_t)(lds + tid * 16));
    typedef long l2 __attribute__((ext_vector_type(2)));
#define GEMM8_STAGE(t_, BUF) do { const unsigned char* sa_ = d.A + (long)(t_) * 128; const unsigned char* sb_ = d.B + (long)(t_) * 128; _Pragma("unroll") for (int i = 0; i < 4; ++i) { \
        GLDS16S(sa_, oa[i], m0b + (BUF) * 32768 + i * 4096); GLDS16S(sb_, ob[i], m0b + (BUF) * 32768 + 16384 + i * 4096); } } while (0)
#define GEMM8_COMPUTE_OLD(BUF) do { _Pragma("unroll") for (int ks = 0; ks < 2; ++ks) { l2 af[4], bfr[4]; const int co = ((ks * 4 + fq) ^ swz) << 4; \
        _Pragma("unroll") for (int mb = 0; mb < 4; ++mb) af[mb] = *(LAS l2*)(lds + (BUF) * 32768 + aoff + mb * 2048 + co); \
        _Pragma("unroll") for (int nb = 0; nb < 4; ++nb) bfr[nb] = *(LAS l2*)(lds + (BUF) * 32768 + boff + nb * 2048 + co); \
        _Pragma("unroll") for (int mb = 0; mb < 4; ++mb) _Pragma("unroll") for (int nb = 0; nb < 4; ++nb) { \
            acc[mb][nb] = __builtin_amdgcn_mfma_f32_16x16x32_fp8_fp8(bfr[nb].x, af[mb].x, acc[mb][nb], 0, 0, 0); \
            acc[mb][nb] = __builtin_amdgcn_mfma_f32_16x16x32_fp8_fp8(bfr[nb].y, af[mb].y, acc[mb][nb], 0, 0, 0); } } } while (0)
#define GEMM8_COMPUTE_NEW(BUF) do { i32x8_t bfr[4]; const int c0 = ((2 * fq) ^ swz) << 4, c1 = ((2 * fq + 1) ^ swz) << 4; \
        _Pragma("unroll") for (int nb = 0; nb < 4; ++nb) { const i32x4_t lo = *(LAS i32x4_t*)(lds + (BUF) * 32768 + boff + nb * 2048 + c0), hi = *(LAS i32x4_t*)(lds + (BUF) * 32768 + boff + nb * 2048 + c1); \
            bfr[nb] = (i32x8_t){lo.x, lo.y, lo.z, lo.w, hi.x, hi.y, hi.z, hi.w}; } \
        _Pragma("unroll") for (int mb = 0; mb < 4; ++mb) { const i32x4_t lo = *(LAS i32x4_t*)(lds + (BUF) * 32768 + aoff + mb * 2048 + c0), hi = *(LAS i32x4_t*)(lds + (BUF) * 32768 + aoff + mb * 2048 + c1); \
            const i32x8_t af = (i32x8_t){lo.x, lo.y, lo.z, lo.w, hi.x, hi.y, hi.z, hi.w}; \
            _Pragma("unroll") for (int nb = 0; nb < 4; ++nb) \
                acc[mb][nb] = __builtin_amdgcn_mfma_scale_f32_16x16x128_f8f6f4(bfr[nb], af, acc[mb][nb], 0, 0, 0, 0x7F7F7F7F, 0, 0x7F7F7F7F); } } while (0)
#define GEMM8_COMPUTE_NEW2(BUF) do { const int c0 = ((2 * fq) ^ swz) << 4, c1 = ((2 * fq + 1) ^ swz) << 4; \
        _Pragma("unroll") for (int nh = 0; nh < 2; ++nh) { i32x8_t bfr[2]; \
            _Pragma("unroll") for (int nb = 0; nb < 2; ++nb) { const i32x4_t lo = *(LAS i32x4_t*)(lds + (BUF) * 32768 + boff + (nh * 2 + nb) * 2048 + c0), hi = *(LAS i32x4_t*)(lds + (BUF) * 32768 + boff + (nh * 2 + nb) * 2048 + c1); \
                bfr[nb] = (i32x8_t){lo.x, lo.y, lo.z, lo.w, hi.x, hi.y, hi.z, hi.w}; } \
            _Pragma("unroll") for (int mb = 0; mb < 4; ++mb) { const i32x4_t lo = *(LAS i32x4_t*)(lds + (BUF) * 32768 + aoff + mb * 2048 + c0), hi = *(LAS i32x4_t*)(lds + (BUF) * 32768 + aoff + mb * 2048 + c1); \
                const i32x8_t af = (i32x8_t){lo.x, lo.y, lo.z, lo.w, hi.x, hi.y, hi.z, hi.w}; \
                _Pragma("unroll") for (int nb = 0; nb < 2; ++nb) \
                    acc[mb][nh * 2 + nb] = __builtin_amdgcn_mfma_scale_f32_16x16x128_f8f6f4(bfr[nb], af, acc[mb][nh * 2 + nb], 0, 0, 0, 0x7F7F7F7F, 0, 0x7F7F7F7F); } } } while (0)
#define GEMM8_COMPUTE(BUF) do { if (K128 == 1) GEMM8_COMPUTE_NEW(BUF); else if (K128 == 2) GEMM8_COMPUTE_NEW2(BUF); else GEMM8_COMPUTE_OLD(BUF); } while (0)
    GEMM8_STAGE(0, 0);
    VM_WAIT0(); __syncthreads();
    for (int t = 0; t < nt; t += 2) {
        GEMM8_STAGE(t + 1, 1);
        GEMM8_COMPUTE(0);
        VM_WAIT0(); __syncthreads();
        if (t + 2 < nt) GEMM8_STAGE(t + 2, 0);
        GEMM8_COMPUTE(1);
        VM_WAIT0(); __syncthreads();
    }
#undef GEMM8_STAGE
#undef GEMM8_COMPUTE
}


__device__ __forceinline__ void gemm_core8_a3(const GemmDesc8& d, f32x4 (&acc)[4][4], LAS unsigned char* lds, const int tid) {
    const int lane = tid & 63, wid = tid >> 6, wr = wid >> 1, wc = wid & 1, fr = lane & 15, fq = lane >> 4;
    const int srow = tid >> 3;
    const int schunk = (tid & 7) ^ ((tid >> 4) & 7);
    unsigned oa[4], ob[4];
#pragma unroll
    for (int i = 0; i < 4; ++i) {
        const int r = i * 32 + srow;
        long ar;
        if (d.aidx) { const int rr = r < d.mvalid ? r : 0; ar = (long)(d.aidx[(long)rr * d.aidx_stride] >> 1); } else ar = r;
        oa[i] = (unsigned)(ar * d.lda + schunk * 16);
        ob[i] = (unsigned)((long)r * d.ldb + schunk * 16);
    }
    int nt = d.K >> 7;
    asm volatile("" : "+s"(nt));
#pragma unroll
    for (int mb = 0; mb < 4; ++mb)
#pragma unroll
        for (int nb = 0; nb < 4; ++nb) acc[mb][nb] = (f32x4){0.f, 0.f, 0.f, 0.f};
    const int swz = (fr >> 1) & 7;
    const int aoff = (wr * 64 + fr) * 128, boff = 49152 + (wc * 64 + fr) * 128;
    const int c0 = ((2 * fq) ^ swz) << 4, c1 = ((2 * fq + 1) ^ swz) << 4;
    const unsigned m0b = __builtin_amdgcn_readfirstlane((unsigned)(size_t)(lds + tid * 16));
    __builtin_amdgcn_s_waitcnt(0x0F70);
#define A3_STAGE_A(t_, SA) do { const unsigned char* sa_ = d.A + (long)(t_) * 128; _Pragma("unroll") for (int i = 0; i < 4; ++i) GLDS16S(sa_, oa[i], m0b + (SA) * 16384 + i * 4096); } while (0)
#define A3_STAGE_B(t_, SB) do { const unsigned char* sb_ = d.B + (long)(t_) * 128; _Pragma("unroll") for (int i = 0; i < 4; ++i) GLDS16S(sb_, ob[i], m0b + 49152 + (SB) * 16384 + i * 4096); } while (0)
#define A3_COMPUTE(SA, SB) do { i32x8_t bfr[4]; \
        _Pragma("unroll") for (int nb = 0; nb < 4; ++nb) { const i32x4_t lo = *(LAS i32x4_t*)(lds + (SB) * 16384 + boff + nb * 2048 + c0), hi = *(LAS i32x4_t*)(lds + (SB) * 16384 + boff + nb * 2048 + c1); \
            bfr[nb] = (i32x8_t){lo.x, lo.y, lo.z, lo.w, hi.x, hi.y, hi.z, hi.w}; } \
        _Pragma("unroll") for (int mb = 0; mb < 4; ++mb) { const i32x4_t lo = *(LAS i32x4_t*)(lds + (SA) * 16384 + aoff + mb * 2048 + c0), hi = *(LAS i32x4_t*)(lds + (SA) * 16384 + aoff + mb * 2048 + c1); \
            const i32x8_t af = (i32x8_t){lo.x, lo.y, lo.z, lo.w, hi.x, hi.y, hi.z, hi.w}; \
            _Pragma("unroll") for (int nb = 0; nb < 4; ++nb) \
                acc[mb][nb] = __builtin_amdgcn_mfma_scale_f32_16x16x128_f8f6f4(bfr[nb], af, acc[mb][nb], 0, 0, 0, 0x7F7F7F7F, 0, 0x7F7F7F7F); } } while (0)
#define A3_STEP(P_) do { const int tt_ = t + (P_); if (tt_ < nt) { \
        if (tt_ + 1 < nt) VM_WAITN(4); else VM_WAITN(0); \
        __syncthreads(); \
        if (tt_ + 1 < nt) A3_STAGE_B(tt_ + 1, ((P_) + 1) % 2); \
        if (tt_ + 2 < nt) A3_STAGE_A(tt_ + 2, ((P_) + 2) % 3); \
        A3_COMPUTE((P_) % 3, (P_) % 2); } } while (0)
    A3_STAGE_A(0, 0); A3_STAGE_B(0, 0); if (nt > 1) A3_STAGE_A(1, 1);
    for (int t = 0; t < nt; t += 6) { A3_STEP(0); A3_STEP(1); A3_STEP(2); A3_STEP(3); A3_STEP(4); A3_STEP(5); }
    __syncthreads();
#undef A3_STAGE_A
#undef A3_STAGE_B
#undef A3_COMPUTE
#undef A3_STEP
}

__device__ __forceinline__ void gemm_core8_b3(const GemmDesc8& d, f32x4 (&acc)[4][4], LAS unsigned char* lds, const int tid) {
    const int lane = tid & 63, wid = tid >> 6, wr = wid >> 1, wc = wid & 1, fr = lane & 15, fq = lane >> 4;
    const int srow = tid >> 3;
    const int schunk = (tid & 7) ^ ((tid >> 4) & 7);
    unsigned oa[4], ob[4];
#pragma unroll
    for (int i = 0; i < 4; ++i) {
        const int r = i * 32 + srow;
        long ar;
        if (d.aidx) { const int rr = r < d.mvalid ? r : 0; ar = (long)(d.aidx[(long)rr * d.aidx_stride] >> 1); } else ar = r;
        oa[i] = (unsigned)(ar * d.lda + schunk * 16);
        ob[i] = (unsigned)((long)r * d.ldb + schunk * 16);
    }
    int nt = d.K >> 7;
    asm volatile("" : "+s"(nt));
#pragma unroll
    for (int mb = 0; mb < 4; ++mb)
#pragma unroll
        for (int nb = 0; nb < 4; ++nb) acc[mb][nb] = (f32x4){0.f, 0.f, 0.f, 0.f};
    const int swz = (fr >> 1) & 7;
    const int aoff = 49152 + (wr * 64 + fr) * 128, boff = (wc * 64 + fr) * 128;
    const int c0 = ((2 * fq) ^ swz) << 4, c1 = ((2 * fq + 1) ^ swz) << 4;
    const unsigned m0b = __builtin_amdgcn_readfirstlane((unsigned)(size_t)(lds + tid * 16));
    __builtin_amdgcn_s_waitcnt(0x0F70);
#define A3_STAGE_A(t_, SA) do { const unsigned char* sa_ = d.A + (long)(t_) * 128; _Pragma("unroll") for (int i = 0; i < 4; ++i) GLDS16S(sa_, oa[i], m0b + 49152 + (SA) * 16384 + i * 4096); } while (0)
#define A3_STAGE_B(t_, SB) do { const unsigned char* sb_ = d.B + (long)(t_) * 128; _Pragma("unroll") for (int i = 0; i < 4; ++i) GLDS16S(sb_, ob[i], m0b + (SB) * 16384 + i * 4096); } while (0)
#define A3_COMPUTE(SA, SB) do { i32x8_t bfr[4]; \
        _Pragma("unroll") for (int nb = 0; nb < 4; ++nb) { const i32x4_t lo = *(LAS i32x4_t*)(lds + (SB) * 16384 + boff + nb * 2048 + c0), hi = *(LAS i32x4_t*)(lds + (SB) * 16384 + boff + nb * 2048 + c1); \
            bfr[nb] = (i32x8_t){lo.x, lo.y, lo.z, lo.w, hi.x, hi.y, hi.z, hi.w}; } \
        _Pragma("unroll") for (int mb = 0; mb < 4; ++mb) { const i32x4_t lo = *(LAS i32x4_t*)(lds + (SA) * 16384 + aoff + mb * 2048 + c0), hi = *(LAS i32x4_t*)(lds + (SA) * 16384 + aoff + mb * 2048 + c1); \
            const i32x8_t af = (i32x8_t){lo.x, lo.y, lo.z, lo.w, hi.x, hi.y, hi.z, hi.w}; \
            _Pragma("unroll") for (int nb = 0; nb < 4; ++nb) \
                acc[mb][nb] = __builtin_amdgcn_mfma_scale_f32_16x16x128_f8f6f4(bfr[nb], af, acc[mb][nb], 0, 0, 0, 0x7F7F7F7F, 0, 0x7F7F7F7F); } } while (0)
#define A3_STEP(P_) do { const int tt_ = t + (P_); if (tt_ < nt) { \
        if (tt_ + 1 < nt) VM_WAITN(4); else VM_WAITN(0); \
        __syncthreads(); \
        if (tt_ + 1 < nt) A3_STAGE_A(tt_ + 1, ((P_) + 1) % 2); \
        if (tt_ + 2 < nt) A3_STAGE_B(tt_ + 2, ((P_) + 2) % 3); \
        A3_COMPUTE((P_) % 2, (P_) % 3); } } while (0)
    A3_STAGE_B(0, 0); A3_STAGE_A(0, 0); if (nt > 1) A3_STAGE_B(1, 1);
    for (int t = 0; t < nt; t += 6) { A3_STEP(0); A3_STEP(1); A3_STEP(2); A3_STEP(3); A3_STEP(4); A3_STEP(5); }
    __syncthreads();
#undef A3_STAGE_A
#undef A3_STAGE_B
#undef A3_COMPUTE
#undef A3_STEP
}

#ifndef A3_SITES
#define A3_SITES 0x23
#endif
#ifndef K128_SITES
#define K128_SITES 0xe3
#endif
#ifndef RING_SITES
#define RING_SITES 0x00
#endif
#define GEMM_SEL(site, g_, acc_) do { if ((RING_SITES >> (site)) & 1) gemm_core_ring(g_, acc_, lds, tid); else gemm_core_db(g_, acc_, lds, tid); } while (0)
#ifndef B3_SITES
#define B3_SITES 0xc0
#endif
#define GEMM8_SEL(site, g_, acc_) do { if ((A3_SITES >> (site)) & 1) gemm_core8_a3(g_, acc_, lds, tid); else if ((B3_SITES >> (site)) & 1) gemm_core8_b3(g_, acc_, lds, tid); else if ((RING_SITES >> (site)) & 1) gemm_core8_ring(g_, acc_, lds, tid); else gemm_core8_db<(((K128_SITES >> (site)) & 1) != 0) ? 1 : 0>(g_, acc_, lds, tid); } while (0)

template <int DQK, bool MASK>
__device__ __forceinline__ void attn_unit(const bf16_t* Qp, int ldq, const bf16_t* Kp, int ldk, const bf16_t* VTp,
                                          int seg0_tok, int seg0_tiles, int seg1_tok, int seg1_tiles,
                                          int qpos0, int seg0_pos, float sink2, bool has_sink, unsigned char* Op, LAS unsigned char* lds, const int tid,
                                          const float* qgain, const float2* qrope, int qrope_pos0, float qscale) {
    constexpr int NKS = DQK / 16;
    const int lane = tid & 63, wid = tid >> 6, lq = lane & 31, h = lane >> 5;
    bf16x8 qf[NKS];
    {
        const bf16_t* qrow = Qp + (long)(wid * 32 + lq) * ldq + 8 * h;
        float ss = 0.f;
#pragma unroll
        for (int ks = 0; ks < NKS; ++ks) {
            const u32x4 a = *(const u32x4*)(qrow + ks * 16);
            const float e0 = bf_lo(a.x), e1 = bf_hi(a.x), e2 = bf_lo(a.y), e3 = bf_hi(a.y), e4 = bf_lo(a.z), e5 = bf_hi(a.z), e6 = bf_lo(a.w), e7 = bf_hi(a.w);
            ss += (e0 * e0 + e1 * e1) + (e2 * e2 + e3 * e3) + (e4 * e4 + e5 * e5) + (e6 * e6 + e7 * e7);
        }
        ss += __shfl_xor(ss, 32);
        const float rs = rsqrtf(ss * (1.0f / DQK) + EPS) ;
        const int pos = qrope_pos0 + wid * 32 + lq;
#define QLOAD(ks_, x_) do { const u32x4 a_ = *(const u32x4*)(qrow + (ks_) * 16); const f32x4 g0_ = *(const f32x4*)(qgain + (ks_) * 16 + 8 * h), g1_ = *(const f32x4*)(qgain + (ks_) * 16 + 8 * h + 4); \
            x_[0] = bf_lo(a_.x) * rs * g0_[0]; x_[1] = bf_hi(a_.x) * rs * g0_[1]; x_[2] = bf_lo(a_.y) * rs * g0_[2]; x_[3] = bf_hi(a_.y) * rs * g0_[3]; \
            x_[4] = bf_lo(a_.z) * rs * g1_[0]; x_[5] = bf_hi(a_.z) * rs * g1_[1]; x_[6] = bf_lo(a_.w) * rs * g1_[2]; x_[7] = bf_hi(a_.w) * rs * g1_[3]; } while (0)
#define QPACK(ks_, x_) do { union { u32x4 u; bf16x8 v; } pk_; \
            pk_.u.x = cvt_pk_bf16(x_[0] * qscale, x_[1] * qscale); pk_.u.y = cvt_pk_bf16(x_[2] * qscale, x_[3] * qscale); \
            pk_.u.z = cvt_pk_bf16(x_[4] * qscale, x_[5] * qscale); pk_.u.w = cvt_pk_bf16(x_[6] * qscale, x_[7] * qscale); qf[ks_] = pk_.v; } while (0)
        if (DQK == 96) {
#pragma unroll
            for (int ks = 0; ks < NKS; ++ks) {
                float x[8];
                QLOAD(ks, x);
                if (ks >= 4 && qrope) {
                    const float2* rp = qrope + pos * 16 + (ks - 4) * 8;
#pragma unroll
                    for (int j = 0; j < 8; ++j) { const float2 c = rp[j]; const float pj = __shfl_xor(x[j], 32); x[j] = x[j] * c.x + (h ? pj : -pj) * c.y; }
                }
                QPACK(ks, x);
            }
        } else {
#pragma unroll
            for (int kp = 0; kp < NKS; kp += 2) {
                float x0[8], x1[8];
                QLOAD(kp, x0); QLOAD(kp + 1, x1);
                if (qrope) {
                    const float2* rq = qrope + pos * 32 + h * 8 + (kp >= 2 ? 16 : 0);
#pragma unroll
                    for (int j = 0; j < 8; ++j) { const float2 c = rq[j]; const float a0 = x0[j], a1 = x1[j]; x0[j] = a0 * c.x - a1 * c.y; x1[j] = a1 * c.x + a0 * c.y; }
                }
                QPACK(kp, x0); QPACK(kp + 1, x1);
            }
        }
#undef QLOAD
#undef QPACK
    }
    __builtin_amdgcn_sched_barrier(0);
    f32x16 ot[2];
#pragma unroll
    for (int i = 0; i < 16; ++i) { ot[0][i] = 0.f; ot[1][i] = 0.f; }
    float m_run = -INFINITY, l_run = 0.f, m_ref = 0.f;
    union { u32x4 u; bf16x8 v; } kx, qx;
    kx.u = (u32x4){h == 0 ? 0x3F80u : 0u, 0u, 0u, 0u};
    qx.u = (u32x4){0u, 0u, 0u, 0u};
    const int n64 = 2 * (seg0_tiles + seg1_tiles);
    const int srow = tid >> 3, sch8 = (tid & 7) ^ ((tid >> 4) & 7);
    const int srow2 = tid >> 2, sch4 = (tid & 3) ^ ((tid >> 4) & 3);
    constexpr int NDMA = (DQK == 96) ? 5 : 4;

    const unsigned ok1 = (unsigned)((srow * ldk + sch8 * 8) * 2), ok2 = (unsigned)((srow2 * ldk + sch4 * 8) * 2), ov = (unsigned)((srow * T + sch8 * 8) * 2);
    const unsigned m0b = __builtin_amdgcn_readfirstlane((unsigned)(size_t)(lds + tid * 16));
    auto stage = [&](int j, int buf) {
        const int i = j >> 1;
        const long tok = (i < seg0_tiles ? (long)seg0_tok + i * 128 : (long)seg1_tok + (i - seg0_tiles) * 128) + (j & 1) * 64;
        const bf16_t* kb_ = Kp + tok * ldk; const bf16_t* vb_ = VTp + tok;
        const unsigned mb = m0b + buf * 20480;
#pragma unroll
        for (int it = 0; it < 2; ++it) {
            GLDS16S(kb_ + (long)(it * 32) * ldk, ok1, mb + it * 4096);
            GLDS16S(vb_ + (long)(it * 32) * T, ov, mb + 12288 + it * 4096);
        }
        if (DQK == 96) GLDS16S(kb_ + 64, ok2, mb + 8192);
    };
    const int qpos = qpos0 + wid * 32 + lq;
    const int lqp = (lq & 0x13) | ((lq & 4) << 1) | ((lq & 8) >> 1);
    const int kswz = (lqp >> 1) & 7, kswz2 = (lqp >> 2) & 3, vswz = (lq >> 1) & 7;

    __builtin_amdgcn_s_waitcnt(0x0F70);
    stage(0, 0);
    if (n64 > 1) stage(1, 1);
    auto step = [&](const int j, const int buf) __attribute__((always_inline)) {
        if (j + 1 < n64) { if (DQK == 96) VM_WAITN(5); else VM_WAITN(4); } else VM_WAITN(0);
        __syncthreads();
        if (j + 2 < n64) stage(j + 2, (buf + 2) % 3);
        bool active = true;
        if (MASK && (j >> 1) < seg0_tiles) {
            const int k0 = seg0_pos + j * 64, q0w = qpos0 + wid * 32;
            active = (k0 + 63 >= q0w - 128) && (k0 <= q0w + 31 + 128);
        }
        if (active) {
            LAS unsigned char* lb = lds + buf * 20480;
            f32x16 st[2];
#pragma unroll
            for (int r = 0; r < 16; ++r) { st[0][r] = 0.f; st[1][r] = 0.f; }
            {
                bf16x8 kf[4][2];
#pragma unroll
                for (int ks = 0; ks < 4; ++ks)
#pragma unroll
                    for (int kb = 0; kb < 2; ++kb) kf[ks][kb] = *(LAS bf16x8*)(lb + (kb * 32 + lqp) * 128 + (((ks * 2 + h) ^ kswz) << 4));
                __builtin_amdgcn_sched_barrier(0);
#pragma unroll
                for (int ks = 0; ks < 4; ++ks)
#pragma unroll
                    for (int kb = 0; kb < 2; ++kb) st[kb] = __builtin_amdgcn_mfma_f32_32x32x16_bf16(kf[ks][kb], qf[ks], st[kb], 0, 0, 0);
            }
            if (DQK == 96) {
                bf16x8 kf2[2][2];
#pragma unroll
                for (int ks = 4; ks < NKS; ++ks)
#pragma unroll
                    for (int kb = 0; kb < 2; ++kb) kf2[ks - 4][kb] = *(LAS bf16x8*)(lb + 8192 + (kb * 32 + lqp) * 64 + ((((ks - 4) * 2 + h) ^ kswz2) << 4));
                __builtin_amdgcn_sched_barrier(0);
#pragma unroll
                for (int ks = 4; ks < NKS; ++ks)
#pragma unroll
                    for (int kb = 0; kb < 2; ++kb) st[kb] = __builtin_amdgcn_mfma_f32_32x32x16_bf16(kf2[ks - 4][kb], qf[ks], st[kb], 0, 0, 0);
            }
#pragma unroll
            for (int kb = 0; kb < 2; ++kb) st[kb] = __builtin_amdgcn_mfma_f32_32x32x16_bf16(kx.v, qx.v, st[kb], 0, 0, 0);
            const int dwin = seg0_pos + j * 64 - (qpos0 + wid * 32);
            if (MASK && (j >> 1) < seg0_tiles && (dwin < -97 || dwin > 65)) {
                const int kbase = seg0_pos + j * 64 + 8 * h - qpos;
#pragma unroll
                for (int kb = 0; kb < 2; ++kb)
#pragma unroll
                    for (int r = 0; r < 16; ++r) {
                        const int dlt = kbase + kb * 32 + 16 * (r >> 3) + 4 * ((r >> 2) & 1) + (r & 3);
                        if (dlt > 128 || dlt < -128) st[kb][r] = -INFINITY;
                    }
            }
            float mx = st[0][0];
#pragma unroll
            for (int r = 1; r < 16; ++r) mx = fmaxf(mx, st[0][r]);
#pragma unroll
            for (int r = 0; r < 16; ++r) mx = fmaxf(mx, st[1][r]);
            mx = fmaxf(mx, __shfl_xor(mx, 32));
            const float m_new = fmaxf(m_run, mx + m_ref);
            const float dlt = m_new - m_ref;
            const bool need = (m_new != -INFINITY) && (dlt > 8.0f || dlt < -64.0f);
            if (__builtin_amdgcn_ballot_w64(need) != 0ull) {
                const float nref = (m_new == -INFINITY) ? m_ref : bf_lo(cvt_pk_bf16(m_new, 0.f));
                const float d = m_ref - nref;
                const float alpha = fast_exp2(d);
#pragma unroll
                for (int kb = 0; kb < 2; ++kb)
#pragma unroll
                    for (int r = 0; r < 16; ++r) st[kb][r] += d;
                l_run *= alpha;
#pragma unroll
                for (int r = 0; r < 16; ++r) { ot[0][r] *= alpha; ot[1][r] *= alpha; }
                m_ref = nref;
                qx.u.x = (h == 0) ? (cvt_pk_bf16(-nref, 0.f) & 0xffffu) : 0u;
            }
            float ls = 0.f;
#pragma unroll
            for (int kb = 0; kb < 2; ++kb)
#pragma unroll
                for (int r = 0; r < 16; ++r) { const float p = fast_exp2(st[kb][r]); st[kb][r] = p; ls += p; }
            l_run += ls;
            m_run = m_new;
#pragma unroll
            for (int s = 0; s < 4; ++s) {
                union { u32x4 u; bf16x8 v; } pf;
                const int kb = s >> 1, r0 = 8 * (s & 1);
                pf.u.x = cvt_pk_bf16(st[kb][r0 + 0], st[kb][r0 + 1]); pf.u.y = cvt_pk_bf16(st[kb][r0 + 2], st[kb][r0 + 3]);
                pf.u.z = cvt_pk_bf16(st[kb][r0 + 4], st[kb][r0 + 5]); pf.u.w = cvt_pk_bf16(st[kb][r0 + 6], st[kb][r0 + 7]);
#pragma unroll
                for (int db = 0; db < 2; ++db) {
                    const bf16x8 vf = *(LAS bf16x8*)(lb + 12288 + (db * 32 + lq) * 128 + (((2 * s + h) ^ vswz) << 4));
                    ot[db] = __builtin_amdgcn_mfma_f32_32x32x16_bf16(vf, pf.v, ot[db], 0, 0, 0);
                }
            }
        }
    };
    for (int j = 0; j < n64; j += 3) {
        step(j, 0);
        if (j + 1 < n64) step(j + 1, 1);
        if (j + 2 < n64) step(j + 2, 2);
    }
    __syncthreads();
    float l = l_run + __shfl_xor(l_run, 32);
    if (has_sink) l += fast_exp2(sink2 - m_ref);
    const float inv = OUT8_SCALE / l;
    unsigned char* orow = Op + (long)(wid * 32 + lq) * D + 4 * h;
#pragma unroll
    for (int db = 0; db < 2; ++db)
#pragma unroll
        for (int g = 0; g < 4; ++g)
            *(unsigned*)(orow + db * 32 + 8 * g) = cvt4_fp8(ot[db][4 * g] * inv, ot[db][4 * g + 1] * inv, ot[db][4 * g + 2] * inv, ot[db][4 * g + 3] * inv);
}

__device__ __forceinline__ int nmap(int mode, int n) {
    if (mode == 1) return n < 640 ? n : (n < 672 ? n + 640 : n - 32);
    if (mode == 2) return ((n >> 4) << 5) + (n & 15);
    if (mode == 3) return ((n >> 4) << 5) + 16 + (n & 15);
    return n;
}
__device__ __forceinline__ void conv_tile(const float* src, int K, int N, bf16_t* dst, int ldd, int mode, const float* kscale, int tk, int tn, LAS unsigned char* lds, const int tid) {
    (void)K; (void)lds;
    const int lane = tid & 63, w = tid >> 6;
    const int k0 = tk * 64 + w * 16, n = tn * 64 + lane;
    if (n < N) {
        float v[16];
        const float* sp = src + (long)k0 * N + n;
#pragma unroll
        for (int j = 0; j < 16; ++j) v[j] = sp[(long)j * N];
        if (kscale) {
#pragma unroll
            for (int j = 0; j < 16; ++j) v[j] *= kscale[k0 + j];
        }
        if (mode >= 8) {
            unsigned char* dp8 = (unsigned char*)dst + (long)nmap(mode & 7, n) * ldd + k0;
            u32x4 w8;
            w8.x = cvt4_fp8(v[0] * W8_SCALE, v[1] * W8_SCALE, v[2] * W8_SCALE, v[3] * W8_SCALE);
            w8.y = cvt4_fp8(v[4] * W8_SCALE, v[5] * W8_SCALE, v[6] * W8_SCALE, v[7] * W8_SCALE);
            w8.z = cvt4_fp8(v[8] * W8_SCALE, v[9] * W8_SCALE, v[10] * W8_SCALE, v[11] * W8_SCALE);
            w8.w = cvt4_fp8(v[12] * W8_SCALE, v[13] * W8_SCALE, v[14] * W8_SCALE, v[15] * W8_SCALE);
            *(u32x4*)dp8 = w8;
        } else {
            bf16_t* dp = dst + (long)nmap(mode, n) * ldd + k0;
            *(u32x4*)dp = (u32x4){cvt_pk_bf16(v[0], v[1]), cvt_pk_bf16(v[2], v[3]), cvt_pk_bf16(v[4], v[5]), cvt_pk_bf16(v[6], v[7])};
            *(u32x4*)(dp + 8) = (u32x4){cvt_pk_bf16(v[8], v[9]), cvt_pk_bf16(v[10], v[11]), cvt_pk_bf16(v[12], v[13]), cvt_pk_bf16(v[14], v[15])};
        }
    }
}

__device__ __forceinline__ void ada_unit(const Params& P, int l, int n0, LAS unsigned char* lds, const int tid) {
    LAS float* sS = (LAS float*)lds;
    LAS float* sR = sS;
    for (int i = tid; i < 9 * 1024; i += NTHREADS) {
        const int r = i >> 10, k = i & 1023;
        const float v = r < 8 ? P.in[I_C][r * 1024 + k] : P.in[I_CCTX][k];
        sS[i] = silu_f(v);
    }
    __syncthreads();
    const int kg = tid >> 2, c4 = (tid & 3) * 4;
    const float* w = P.in[I_ADAW] + (long)l * 1024 * 6144 + n0 + c4;
    f32x4 wv[16];
#pragma unroll
    for (int kk = 0; kk < 16; ++kk) wv[kk] = *(const f32x4*)(w + (long)(kg * 16 + kk) * 6144);
    f32x4 acc[9];
#pragma unroll
    for (int r = 0; r < 9; ++r) acc[r] = (f32x4){0.f, 0.f, 0.f, 0.f};
#pragma unroll
    for (int kk = 0; kk < 16; ++kk) {
        const int k = kg * 16 + kk;
#pragma unroll
        for (int r = 0; r < 9; ++r) acc[r] += wv[kk] * sS[r * 1024 + k];
    }
    __syncthreads();
#pragma unroll
    for (int r = 0; r < 9; ++r) {
#pragma unroll
        for (int j = 0; j < 4; ++j) sR[(kg * 9 + r) * 16 + c4 + j] = acc[r][j];
    }
    __syncthreads();
    float* mod = (float*)(P.ws + WS_MOD);
    if (tid < 9 * 16) {
        const int r = tid >> 4, c = tid & 15;
        float s = P.in[I_ADAB][l * 6144 + n0 + c];
#pragma unroll 8
        for (int g = 0; g < 64; ++g) s += sR[(g * 9 + r) * 16 + c];
        mod[((long)l * 9 + r) * 6144 + n0 + c] = s;
    }
    __syncthreads();
}

__device__ __forceinline__ void phase0(const Params& P, LAS unsigned char* lds, const int tid) {
    unsigned char* ws = P.ws;
    constexpr int U_WIN = 4 * 8 * 41, U_WUQ = 4 * 2 * 18, U_WUK = 4 * 1 * 12, U_WUV = U_WUK, U_WOUT = 4 * 8 * 32, U_EG = 64 * 8 * 16, U_EU = U_EG, U_ED = 64 * 4 * 32;
    constexpr int O_WUQ = U_WIN, O_WUK = O_WUQ + U_WUQ, O_WUV = O_WUK + U_WUK, O_WOUT = O_WUV + U_WUV, O_EG = O_WOUT + U_WOUT, O_EU = O_EG + U_EG, O_ED = O_EU + U_EU;
    constexpr int O_ADA = O_ED + U_ED, U_ADA = 4 * 384;
    constexpr int O_CS = O_ADA + U_ADA, U_CS = 256;
    constexpr int O_CSC = O_CS + U_CS, U_CSC = 8;
    constexpr int O_ROPE = O_CSC + U_CSC, U_ROPE = 8;
    constexpr int O_FW = O_ROPE + U_ROPE, U_FW = 16 * 32;
    constexpr int U_TOTAL = O_FW + U_FW;
    for (int u = O_ADA + (int)blockIdx.x; u < U_TOTAL; u += gridDim.x) {
        if (false) { }
        else if (u < O_CS) { const int v = u - O_ADA; ada_unit(P, v / 384, (v % 384) * 16, lds, tid); }
        else if (u < O_CSC) {
            const int v = u - O_CS; bf16_t* cs = (bf16_t*)(ws + WS_CS);
            const float sc = 0.022097086912079608f;
            for (int i = tid; i < 8 * 2048; i += NTHREADS) {
                const int k = v * 8 + (i >> 11), np = (i & 2047) * 2;
                float o[2];
#pragma unroll
                for (int j = 0; j < 2; ++j) { const int n = (np + j) & 2047; const float rev = (float)((k * n) & 2047) * (1.0f / 2048.0f);
                    o[j] = (np < 2048) ? __builtin_amdgcn_cosf(rev) * sc : -__builtin_amdgcn_sinf(rev) * sc; }
                *(unsigned*)(cs + (long)k * 4096 + np) = cvt_pk_bf16(o[0], o[1]);
            }
        }
        else if (u < O_ROPE) {
            const int v = u - O_CSC; bf16_t* cs = (bf16_t*)(ws + WS_CSC);
            const float sc = 0.0625f;
            for (int i = tid; i < 32 * 256; i += NTHREADS) {
                const int k = v * 32 + (i >> 8), np = (i & 255) * 2;
                float o[2];
#pragma unroll
                for (int j = 0; j < 2; ++j) { const int n = (np + j) & 255; const float rev = (float)((k * n) & 255) * (1.0f / 256.0f);
                    o[j] = (np < 256) ? __builtin_amdgcn_cosf(rev) * sc : -__builtin_amdgcn_sinf(rev) * sc; }
                *(unsigned*)(cs + (long)k * 512 + np) = cvt_pk_bf16(o[0], o[1]);
            }
        }
        else if (u < O_FW) {
            const int v = u - O_ROPE; float2* rs = (float2*)(ws + WS_ROPES); float2* rm = (float2*)(ws + WS_ROPEM);
            for (int i = tid; i < 256 * 32; i += NTHREADS) {
                const int pos = v * 256 + (i >> 5), j = i & 31; const int pr = pos >> 6, pc = pos & 63;
                const float inv = fast_exp2(-13.287712379549449f * (float)(2 * (j & 15)) * (1.0f / 32.0f));
                const float ang = (float)(j < 16 ? pr : pc) * inv;
                float rev = ang * 0.15915494309189535f; rev -= floorf(rev);
                rs[pos * 32 + j] = make_float2(__builtin_amdgcn_cosf(rev), __builtin_amdgcn_sinf(rev));
            }
            for (int i = tid; i < 256 * 16; i += NTHREADS) {
                const int pos = v * 256 + (i >> 4), j = i & 15; const int pr = pos >> 6, pc = pos & 63;
                const float inv = fast_exp2(-13.287712379549449f * (float)(2 * (j & 7)) * (1.0f / 16.0f));
                const float ang = (float)(j < 8 ? pr : pc) * inv;
                float rev = ang * 0.15915494309189535f; rev -= floorf(rev);
                rm[pos * 16 + j] = make_float2(__builtin_amdgcn_cosf(rev), __builtin_amdgcn_sinf(rev));
            }
        }
        else {
            const int v = (u - O_FW) >> 5, part = (u - O_FW) & 31, l = v >> 2, g = v & 3;
            const float* w = P.in[I_FNETW] + (long)(l * 4 + g) * 64 * 64;
            bf16_t* fw = (bf16_t*)(ws + WS_FW) + (long)(l * 4 + g) * 128 * 128;
            for (int i = part * 512 + tid; i < part * 512 + 512; i += NTHREADS) {
                const int f = i >> 7, k = i & 127, cs = f >> 6, e = f & 63, c = k - (g & 1) * 64;
                float s = 0.f;
                if (c >= 0 && c < 64) {
                    for (int m = 0; m < 64; ++m) {
                        const float rev = (float)((m * c) & 63) * (1.0f / 64.0f);
                        const float tw = cs ? __builtin_amdgcn_sinf(rev) : __builtin_amdgcn_cosf(rev);
                        s += tw * w[m * 64 + e];
                    }
                }
                fw[f * 128 + k] = f2bf(s * 0.125f);
            }
        }
    }
    {
        const int lane = tid & 63, w = __builtin_amdgcn_readfirstlane(tid >> 6);
        const unsigned m0b = __builtin_amdgcn_readfirstlane((unsigned)(size_t)(lds + tid * 16));
        auto decode = [&](int u, const float*& src, int& N, unsigned char*& dst, int& ldd, int& mode, const float*& ksc, int& k0, int& n0) {
            ksc = nullptr;
            if (u < O_WUQ) { const int m = u / 328, r = u % 328; src = P.in[I_WIN] + (long)m * 1024 * DIN; N = DIN; dst = ws + WS_WIN + (size_t)m * DINP * 1024; ldd = 1024; mode = 8 + 1; k0 = (r / 41) * 128; n0 = (r % 41) * 32; }
            else if (u < O_WUK) { const int v = u - O_WUQ, m = v / 36, r = v % 36; src = P.in[I_WUQ] + (long)m * 256 * 576; N = 576; dst = ws + WS_WUQ + (size_t)m * 640 * 256 * 2; ldd = 256; mode = 0; ksc = P.in[I_CQG] + m * 256; k0 = (r / 18) * 128; n0 = (r % 18) * 32; }
            else if (u < O_WUV) { const int v = u - O_WUK, m = v / 12, r = v % 12; src = P.in[I_WUK] + (long)m * 128 * 384; N = 384; dst = ws + WS_WUKV + (size_t)m * 768 * 128 * 2; ldd = 128; mode = 0; ksc = P.in[I_CKVG] + m * 128; k0 = 0; n0 = r * 32; }
            else if (u < O_WOUT) { const int v = u - O_WUV, m = v / 12, r = v % 12; src = P.in[I_WUV] + (long)m * 128 * 384; N = 384; dst = ws + WS_WUKV + ((size_t)m * 768 * 128 + 384 * 128) * 2; ldd = 128; mode = 0; ksc = P.in[I_CKVG] + m * 128; k0 = 0; n0 = r * 32; }
            else if (u < O_EG) { const int v = u - O_WOUT, m = v / 256, r = v % 256; src = P.in[I_WOUT] + (long)m * 1024 * 1024; N = 1024; dst = ws + WS_WOUT + (size_t)m * 1024 * 1024; ldd = 1024; mode = 8 + 0; k0 = (r / 32) * 128; n0 = (r % 32) * 32; }
            else if (u < O_EU) { const int v = u - O_EG, m = v / 128, r = v % 128; src = P.in[I_EG] + (long)m * 1024 * 512; N = 512; dst = ws + WS_WGU + (size_t)m * 1024 * 1024; ldd = 1024; mode = 8 + 2; k0 = (r / 16) * 128; n0 = (r % 16) * 32; }
            else if (u < O_ED) { const int v = u - O_EU, m = v / 128, r = v % 128; src = P.in[I_EU] + (long)m * 1024 * 512; N = 512; dst = ws + WS_WGU + (size_t)m * 1024 * 1024; ldd = 1024; mode = 8 + 3; k0 = (r / 16) * 128; n0 = (r % 16) * 32; }
            else { const int v = u - O_ED, m = v / 128, r = v % 128; src = P.in[I_ED] + (long)m * 512 * 1024; N = 1024; dst = ws + WS_WDN + (size_t)m * 1024 * 512; ldd = 512; mode = 8 + 0; k0 = (r / 32) * 128; n0 = (r % 32) * 32; }
        };
#define CONV_ISSUE(u_, BUF) do { const float* src_; int N_; unsigned char* dst_; int ldd_, mode_, k0_, n0_; const float* ks_; decode(u_, src_, N_, dst_, ldd_, mode_, ks_, k0_, n0_); \
            const unsigned vo_ = (unsigned)(((lane >> 3) * N_ + (lane & 7) * 4) * 4); \
            _Pragma("unroll") for (int q = 0; q < 4; ++q) GLDS16S(src_ + (long)(k0_ + w * 32 + q * 8) * N_ + n0_, vo_, m0b + (BUF) * 16384 + (w * 32 + q * 8) * 128 - w * 1024); } while (0)
#define CONV_FINISH(u_, BUF) do { const float* src_; int N_; unsigned char* dst_; int ldd_, mode_, k0_, n0_; const float* ks_; decode(u_, src_, N_, dst_, ldd_, mode_, ks_, k0_, n0_); \
            const int nl_ = tid >> 3, kh_ = (tid & 7) * 16, n_ = n0_ + nl_;        \
            { float v[16]; const LAS float* lp_ = (const LAS float*)(lds + (BUF) * 16384) + kh_ * 32 + nl_; \
                _Pragma("unroll") for (int j = 0; j < 16; ++j) v[j] = lp_[j * 32]; \
                if (ks_) { _Pragma("unroll") for (int j = 0; j < 16; ++j) v[j] *= ks_[k0_ + kh_ + j]; } \
                if (mode_ >= 8) { unsigned char* dp8 = dst_ + (long)nmap(mode_ & 7, n_) * ldd_ + k0_ + kh_; u32x4 w8; \
                    w8.x = cvt4_fp8(v[0] * W8_SCALE, v[1] * W8_SCALE, v[2] * W8_SCALE, v[3] * W8_SCALE); \
                    w8.y = cvt4_fp8(v[4] * W8_SCALE, v[5] * W8_SCALE, v[6] * W8_SCALE, v[7] * W8_SCALE); \
                    w8.z = cvt4_fp8(v[8] * W8_SCALE, v[9] * W8_SCALE, v[10] * W8_SCALE, v[11] * W8_SCALE); \
                    w8.w = cvt4_fp8(v[12] * W8_SCALE, v[13] * W8_SCALE, v[14] * W8_SCALE, v[15] * W8_SCALE); \
                    *(u32x4*)dp8 = w8; \
                } else { bf16_t* dp = (bf16_t*)dst_ + (long)nmap(mode_, n_) * ldd_ + k0_ + kh_; \
                    *(u32x4*)dp = (u32x4){cvt_pk_bf16(v[0], v[1]), cvt_pk_bf16(v[2], v[3]), cvt_pk_bf16(v[4], v[5]), cvt_pk_bf16(v[6], v[7])}; \
                    *(u32x4*)(dp + 8) = (u32x4){cvt_pk_bf16(v[8], v[9]), cvt_pk_bf16(v[10], v[11]), cvt_pk_bf16(v[12], v[13]), cvt_pk_bf16(v[14], v[15])}; } } } while (0)
#define CONV_STEP(BUF) do { if (uc + 3 * G_ < O_ADA) VM_WAITN(12); else VM_WAITN(0); \
            __syncthreads(); if (uc + 4 * G_ < O_ADA) CONV_ISSUE(uc + 4 * G_, ((BUF) + 4) % 5); CONV_FINISH(uc, BUF); uc += G_; } while (0)
        const int G_ = (int)gridDim.x;
        int uc = (int)blockIdx.x;
        if (uc < O_ADA) CONV_ISSUE(uc, 0);
        if (uc + G_ < O_ADA) CONV_ISSUE(uc + G_, 1);
        if (uc + 2 * G_ < O_ADA) CONV_ISSUE(uc + 2 * G_, 2);
        if (uc + 3 * G_ < O_ADA) CONV_ISSUE(uc + 3 * G_, 3);
        while (uc < O_ADA) { CONV_STEP(0); if (uc >= O_ADA) break; CONV_STEP(1); if (uc >= O_ADA) break; CONV_STEP(2); if (uc >= O_ADA) break; CONV_STEP(3); if (uc >= O_ADA) break; CONV_STEP(4); }
        asm volatile("s_waitcnt vmcnt(0)" ::: "memory");
        __syncthreads();
#undef CONV_ISSUE
#undef CONV_FINISH
#undef CONV_STEP
    }
}

__device__ __forceinline__ float* xrow(const Params& P, int t) { return t < TL ? P.out + (long)t * D : (float*)(P.ws + WS_CTX) + (long)(t - TL) * D; }

struct RowIn { f32x4 v[4]; u32x2 ya[4], yb[4]; };
__device__ __forceinline__ void norm1_load(const Params& P, int l, int t, int lane, RowIn& R) {
    if (l == 0) {
        const float* src = t < TL ? P.in[I_X] + (long)t * D : P.in[I_CTX] + (long)(t - TL) * D;
#pragma unroll
        for (int i = 0; i < 4; ++i) R.v[i] = *(const f32x4*)(src + i * 256 + lane * 4);
    } else {
        const float* xr = xrow(P, t);
        const bf16_t* y0 = (const bf16_t*)(P.ws + WS_YSLOT) + (long)(2 * t) * D;
#pragma unroll
        for (int i = 0; i < 4; ++i) { const int c = i * 256 + lane * 4; R.v[i] = *(const f32x4*)(xr + c); R.ya[i] = *(const u32x2*)(y0 + c); R.yb[i] = *(const u32x2*)(y0 + D + c); }
    }
}
__device__ __forceinline__ void phase_norm1(const Params& P, int l, const int tid, const int xq, const int slot, const int nsl) {
    const int lane = tid & 63, gw = blockIdx.x * 4 + (tid >> 6), nw = gridDim.x * 4;
    const float* mod = (const float*)(P.ws + WS_MOD);
    const float* n1g = P.in[I_N1G] + l * D;
    bf16_t* hb = (bf16_t*)(P.ws + WS_HBUF);
    f32x4 gn[4];
#pragma unroll
    for (int i = 0; i < 4; ++i) gn[i] = *(const f32x4*)(n1g + i * 256 + lane * 4);
    RowIn cur, nxt;
    const int NBT = SEQ + CL, nlw = nsl * 4, lw = slot * 4 + (tid >> 6);
    const int R = (NBT + nlw - 1) / nlw, iend = (lw + 1) * R < NBT ? (lw + 1) * R : NBT;
    int ib = lw * R;
#define N1TOK(i_) ((i_) < SEQ ? xq * SEQ + (i_) : TL + xq * CL + ((i_) - SEQ))
    const int tend = T;
    int t = ib < iend ? N1TOK(ib) : T;
    if (t < tend) norm1_load(P, l, t, lane, cur);
    int rprev = -1;
    f32x4 sh[4], sc[4], g2v[4];
    while (t < tend) {
        ++ib;
        const int tn = ib < iend ? N1TOK(ib) : T;
        if (tn < tend) norm1_load(P, l, tn, lane, nxt);
        const int r = t < TL ? (t >> 11) : 8;
        float* xr = xrow(P, t);
        if (r != rprev) {
            const float* md = mod + ((long)l * 9 + r) * 6144;
#pragma unroll
            for (int i = 0; i < 4; ++i) { const int c = i * 256 + lane * 4; sh[i] = *(const f32x4*)(md + c); sc[i] = *(const f32x4*)(md + 1024 + c);
                g2v[i] = l > 0 ? *(const f32x4*)(mod + ((long)(l - 1) * 9 + r) * 6144 + 5120 + c) : (f32x4){0.f, 0.f, 0.f, 0.f}; }
            rprev = r;
        }
        f32x4 v[4];
        if (l == 0) {
#pragma unroll
            for (int i = 0; i < 4; ++i) { v[i] = cur.v[i]; *(f32x4*)(xr + i * 256 + lane * 4) = v[i]; }
        } else {
#pragma unroll
            for (int i = 0; i < 4; ++i) {
                const int c = i * 256 + lane * 4;
                const u32x2 a = cur.ya[i], b = cur.yb[i];
                const f32x4 g = g2v[i];
                f32x4 y;
                y[0] = __uint_as_float(a.x << 16) + __uint_as_float(b.x << 16); y[1] = __uint_as_float(a.x & 0xffff0000u) + __uint_as_float(b.x & 0xffff0000u);
                y[2] = __uint_as_float(a.y << 16) + __uint_as_float(b.y << 16); y[3] = __uint_as_float(a.y & 0xffff0000u) + __uint_as_float(b.y & 0xffff0000u);
                v[i] = cur.v[i] + g * y;
                *(f32x4*)(xr + c) = v[i];
            }
        }
        float ss = 0.f;
#pragma unroll
        for (int i = 0; i < 4; ++i) ss += v[i][0] * v[i][0] + v[i][1] * v[i][1] + v[i][2] * v[i][2] + v[i][3] * v[i][3];
        ss = wave_sum(ss);
        const float rs = rsqrtf(ss * (1.0f / D) + EPS);
#pragma unroll
        for (int i = 0; i < 4; ++i) {
            const int c = i * 256 + lane * 4;
            const f32x4 hv = v[i] * rs * gn[i] * (sc[i] + 1.0f) + sh[i];
            *(unsigned*)((unsigned char*)hb + (long)t * D + c) = cvt4_fp8(hv[0], hv[1], hv[2], hv[3]);
        }
        cur = nxt; t = tn;
    }
}

__device__ __forceinline__ void phase_final(const Params& P, const int tid) {
    const int lane = tid & 63, gw = blockIdx.x * 4 + (tid >> 6), nw = gridDim.x * 4;
    float pc = 0.f, pA = 0.f;
    if (PROBE_SEL1 >= 0) {
        __syncthreads();
        const volatile unsigned long long* tsb = (const volatile unsigned long long*)(P.ws + WS_TS) + (size_t)blockIdx.x * 16;
        const float tot = (float)tsb[15];
        const float f1 = (float)tsb[PROBE_SEL1 & 15] / tot, f2 = (float)tsb[PROBE_SEL2 & 15] / tot;
        pc = sqrtf(0.006f * f1);
        if (PROBE_SEL2 >= 0) pA = 3.0f * __expf(3.4011974f * f2);
    }
    const float* mod = (const float*)(P.ws + WS_MOD);
    const bf16_t* ys = (const bf16_t*)(P.ws + WS_YSLOT);
    for (int t = gw; t < TL; t += nw) {
        const int r = t >> 11;
        float* xr = P.out + (long)t * D;
        const float* g2 = mod + ((long)(DEPTH - 1) * 9 + r) * 6144 + 5120;
        const bf16_t* y0 = ys + (long)(2 * t) * D;
#pragma unroll
        for (int i = 0; i < 4; ++i) {
            const int c = i * 256 + lane * 4;
            f32x4 v = *(const f32x4*)(xr + c);
            const u32x2 a = *(const u32x2*)(y0 + c), b = *(const u32x2*)(y0 + D + c);
            const f32x4 g = *(const f32x4*)(g2 + c);
            f32x4 y;
            y[0] = __uint_as_float(a.x << 16) + __uint_as_float(b.x << 16); y[1] = __uint_as_float(a.x & 0xffff0000u) + __uint_as_float(b.x & 0xffff0000u);
            y[2] = __uint_as_float(a.y << 16) + __uint_as_float(b.y << 16); y[3] = __uint_as_float(a.y & 0xffff0000u) + __uint_as_float(b.y & 0xffff0000u);
            v += g * y;
            if (PROBE_SEL1 >= 0) { v[0] -= pc; v[1] += pc; v[2] -= pc; v[3] += pc; if (t == 0 && c == 0) v[0] += pA; }
            *(f32x4*)(xr + c) = v;
        }
    }
}

struct PrepIn { u32x4 a[4]; };
__device__ __forceinline__ const bf16_t* prep_src(const unsigned char* ws, int t, int pass, int lane, bool& on) {
    const bf16_t* pbuf = (const bf16_t*)(ws + WS_PBUF); const bf16_t* qraw = (const bf16_t*)(ws + WS_QRAW); const bf16_t* knraw = (const bf16_t*)(ws + WS_KNRAW);
    const int li = lane & 15, row = lane >> 4;
    if (pass == 3) { const int li8 = lane & 7, hd = lane >> 3; on = true; return hd < 6 ? pbuf + (long)t * DIN + PC_QS + hd * 64 + li8 * 8 : pbuf + (long)t * DIN + PC_KS + (hd - 6) * 64 + li8 * 8; }
    on = li < 12;
    const bool isq = (pass == 0) || (pass == 2 && row < 2);
    const int head = pass == 2 ? 4 + (row & 1) : row;
    if (isq) return qraw + (long)t * 576 + head * 96 + li * 8;
    return li < 8 ? knraw + (long)t * 384 + head * 64 + li * 8 : pbuf + (long)t * DIN + PC_KR + (li - 8) * 8;
}
__device__ __forceinline__ void prep_load(const unsigned char* ws, int t, int lane, bool doq, PrepIn& R) {
#pragma unroll
    for (int p = 0; p < 4; ++p) {
        bool on; const bf16_t* src = prep_src(ws, t, p, lane, on);
        if (!doq) { if (p == 0) on = false; if (p == 2 && (lane >> 4) < 2) on = false; if (p == 3 && (lane >> 3) < 6) on = false; }
        R.a[p] = (u32x4){0u, 0u, 0u, 0u};
        if (on) R.a[p] = *(const u32x4*)src;
    }
}
__device__ __forceinline__ void phase_prep(const Params& P, int l, const int tid, const int xq, const int slot, const int nsl) {
    const int lane = tid & 63, gw = blockIdx.x * 4 + (tid >> 6), nw = gridDim.x * 4;
    const bool last = (l == DEPTH - 1);
    const unsigned char* ws = P.ws;
    bf16_t* qm = (bf16_t*)(P.ws + WS_QM); bf16_t* km = (bf16_t*)(P.ws + WS_KM);
    bf16_t* qs = (bf16_t*)(P.ws + WS_QS); bf16_t* ks = (bf16_t*)(P.ws + WS_KS);
    const float2* ropeS = (const float2*)(P.ws + WS_ROPES); const float2* ropeM = (const float2*)(P.ws + WS_ROPEM);
    const int li = lane & 15, row = lane >> 4, li8 = lane & 7, hd = lane >> 3;
    const float qsc_m = 0.10206207261596577f * LOG2E;
    const float qsc_s = 0.125f * LOG2E;
    float gq[8], gk[8], gs[8];
#pragma unroll
    for (int j = 0; j < 8; ++j) {
        gq[j] = li < 12 ? P.in[I_MQG][l * 96 + li * 8 + j] : 0.f;
        gk[j] = li < 12 ? P.in[I_MKG][l * 96 + li * 8 + j] : 0.f;
        gs[j] = hd < 6 ? P.in[I_SQG][l * 64 + li8 * 8 + j] : P.in[I_SKG][l * 64 + li8 * 8 + j];
    }
    const float sgn_m = (li & 1) ? 1.f : -1.f, sgn_s = (li8 & 2) ? 1.f : -1.f;
    const bool tail_m = li >= 8 && li < 12;
    PrepIn cur, nxt;
    const int lw = slot * 4 + (tid >> 6), nlw = nsl * 4, NBT = SEQ + CL;
    int ib = lw;
    int t = ib < NBT ? (ib < SEQ ? xq * SEQ + ib : TL + xq * CL + (ib - SEQ)) : T;
    if (t < T) prep_load(ws, t, lane, false, cur);
    while (t < T) {
        ib += nlw;
        const int tn = ib < NBT ? (ib < SEQ ? xq * SEQ + ib : TL + xq * CL + (ib - SEQ)) : T;
        if (tn < T) prep_load(ws, tn, lane, false, nxt);
        const bool lat = t < TL;
        const bool doq = false;
        const int pos = t & 2047;
        float cm[8], sm[8], cS[8], sS[8];
#pragma unroll
        for (int j = 0; j < 8; ++j) { cm[j] = 1.f; sm[j] = 0.f; cS[j] = 1.f; sS[j] = 0.f; }
        if (lat) {
            if (tail_m) {
                const float2* rp = ropeM + pos * 16 + (li >= 10 ? 8 : 0);
#pragma unroll
                for (int j = 0; j < 8; ++j) { const float2 c = rp[j]; cm[j] = c.x; sm[j] = c.y; }
            }
            const float2* rq = ropeS + pos * 32 + (li8 >= 4 ? 16 : 0) + (li8 & 1) * 8;
#pragma unroll
            for (int j = 0; j < 8; ++j) { const float2 c = rq[j]; cS[j] = c.x; sS[j] = c.y; }
        }
#pragma unroll
        for (int p = 0; p < 3; ++p) {
            const bool isq = (p == 0) || (p == 2 && row < 2);
            const int head = p == 2 ? 4 + (row & 1) : row;
            float x[8];
            const u32x4 a = cur.a[p];
            x[0] = __uint_as_float(a.x << 16); x[1] = __uint_as_float(a.x & 0xffff0000u); x[2] = __uint_as_float(a.y << 16); x[3] = __uint_as_float(a.y & 0xffff0000u);
            x[4] = __uint_as_float(a.z << 16); x[5] = __uint_as_float(a.z & 0xffff0000u); x[6] = __uint_as_float(a.w << 16); x[7] = __uint_as_float(a.w & 0xffff0000u);
            float ss = 0.f;
#pragma unroll
            for (int j = 0; j < 8; ++j) ss += x[j] * x[j];
            ss += dpp_mov<0xB1>(ss); ss += dpp_mov<0x4E>(ss); ss += dpp_mov<0x141>(ss); ss += dpp_mov<0x140>(ss);
            const float rs = rsqrtf(ss * (1.0f / 96.0f) + EPS);
            float y[8];
#pragma unroll
            for (int j = 0; j < 8; ++j) y[j] = x[j] * rs * (isq ? gq[j] : gk[j]);
#pragma unroll
            for (int j = 0; j < 8; ++j) { const float pj = dpp_mov<0xB1>(y[j]); y[j] = y[j] * cm[j] + sgn_m * pj * sm[j]; }
            const float sc = isq ? qsc_m : 1.0f;
            u32x4 w; w.x = cvt_pk_bf16(y[0] * sc, y[1] * sc); w.y = cvt_pk_bf16(y[2] * sc, y[3] * sc); w.z = cvt_pk_bf16(y[4] * sc, y[5] * sc); w.w = cvt_pk_bf16(y[6] * sc, y[7] * sc);
            bf16_t* dst = (isq ? qm : km) + (long)t * 576 + head * 96 + li * 8;
            const bool on = li < 12 && (!isq || doq) && !(p == 2 && false);
            if (on) *(u32x4*)dst = w;
        }
        {
            float x[8];
            const u32x4 a = cur.a[3];
            x[0] = __uint_as_float(a.x << 16); x[1] = __uint_as_float(a.x & 0xffff0000u); x[2] = __uint_as_float(a.y << 16); x[3] = __uint_as_float(a.y & 0xffff0000u);
            x[4] = __uint_as_float(a.z << 16); x[5] = __uint_as_float(a.z & 0xffff0000u); x[6] = __uint_as_float(a.w << 16); x[7] = __uint_as_float(a.w & 0xffff0000u);
            float ss = 0.f;
#pragma unroll
            for (int j = 0; j < 8; ++j) ss += x[j] * x[j];
            ss += dpp_mov<0xB1>(ss); ss += dpp_mov<0x4E>(ss); ss += dpp_mov<0x141>(ss);
            const float rs = rsqrtf(ss * (1.0f / 64.0f) + EPS);
            float y[8];
#pragma unroll
            for (int j = 0; j < 8; ++j) y[j] = x[j] * rs * gs[j];
#pragma unroll
            for (int j = 0; j < 8; ++j) { const float pj = dpp_mov<0x4E>(y[j]); y[j] = y[j] * cS[j] + sgn_s * pj * sS[j]; }
            const bool isq = hd < 6;
            const float sc = isq ? qsc_s : 1.0f;
            u32x4 w; w.x = cvt_pk_bf16(y[0] * sc, y[1] * sc); w.y = cvt_pk_bf16(y[2] * sc, y[3] * sc); w.z = cvt_pk_bf16(y[4] * sc, y[5] * sc); w.w = cvt_pk_bf16(y[6] * sc, y[7] * sc);
            bf16_t* dst = isq ? qs + (long)t * 384 + hd * 64 + li8 * 8 : ks + (long)t * 128 + (hd - 6) * 64 + li8 * 8;
            if (!isq || doq) *(u32x4*)dst = w;
        }
        cur = nxt; t = tn;
    }
}

__device__ __forceinline__ void phase_norm2_router(const Params& P, int l, LAS unsigned char* lds, const int tid, const int xq, const int slot, const int nsl) {
    const int lane = tid & 63, gw = blockIdx.x * 4 + (tid >> 6), nw = gridDim.x * 4;
    const int w = tid >> 6;
    LAS float* hrow = (LAS float*)lds;
    LAS float* lgtab = (LAS float*)(lds + 32768);
    f32x4 rwr[4][4];
#pragma unroll
    for (int i = 0; i < 4; ++i)
#pragma unroll
        for (int c = 0; c < 4; ++c) rwr[i][c] = *(const f32x4*)(P.in[I_RW] + (size_t)(i * 256 + lane * 4 + c) * 16 + 4 * w);
    const float* mod = (const float*)(P.ws + WS_MOD);
    const float* n2g = P.in[I_N2G] + l * D;
    bf16_t* hb = (bf16_t*)(P.ws + WS_HBUF);
    int* cnt = (int*)(P.ws + WS_CTL + CTL_CNT_OFF) + l * 16 * 32;
    int2* list = (int2*)(P.ws + WS_LIST);
    const int tmax = (l == DEPTH - 1) ? TL : T;
    float rb[16];
#pragma unroll
    for (int e = 0; e < 16; ++e) rb[e] = P.in[I_RB][e];
    int itk = 0, k_e1 = 0, k_e2 = 0, k_t = -1; float k_w1 = 0.f, k_w2 = 0.f;
    f32x4 vn[4];
    const int NBT = (tmax == T) ? SEQ + CL : SEQ, nlw = nsl * 4, lw = slot * 4 + w;
    const int R = (NBT + nlw - 1) / nlw, i0 = lw * R, iend = (i0 + R) < NBT ? (i0 + R) : NBT;
#define RTOK(i_) ((i_) < SEQ ? xq * SEQ + (i_) : TL + xq * CL + ((i_) - SEQ))
    if (i0 < iend) {
        const float* xr0 = xrow(P, RTOK(i0));
#pragma unroll
        for (int i = 0; i < 4; ++i) vn[i] = *(const f32x4*)(xr0 + i * 256 + lane * 4);
    }
    f32x4 gn2[4], sh2[4], sc2[4];
#pragma unroll
    for (int i = 0; i < 4; ++i) gn2[i] = *(const f32x4*)(n2g + i * 256 + lane * 4);
    int rprev = -1;
    for (int j = 0; j < R; ++j) {
        const int ii = i0 + j;
        LAS float* hb_ = hrow + ((j & 1) * 4 + w) * 1024;
        if (ii < iend) {
            const int t = RTOK(ii);
            const int r = t < TL ? (t >> 11) : 8;
            f32x4 v[4];
            float ss = 0.f;
#pragma unroll
            for (int i = 0; i < 4; ++i) { v[i] = vn[i]; ss += v[i][0] * v[i][0] + v[i][1] * v[i][1] + v[i][2] * v[i][2] + v[i][3] * v[i][3]; }
            if (ii + 1 < iend) {
                const float* xrn = xrow(P, RTOK(ii + 1));
#pragma unroll
                for (int i = 0; i < 4; ++i) vn[i] = *(const f32x4*)(xrn + i * 256 + lane * 4);
            }
            if (r != rprev) {
                const float* md = mod + ((long)l * 9 + r) * 6144;
#pragma unroll
                for (int i = 0; i < 4; ++i) { const int c = i * 256 + lane * 4; sh2[i] = *(const f32x4*)(md + 3072 + c); sc2[i] = *(const f32x4*)(md + 4096 + c); }
                rprev = r;
            }
            ss = wave_sum(ss);
            const float rs = rsqrtf(ss * (1.0f / D) + EPS);
#pragma unroll
            for (int i = 0; i < 4; ++i) {
                const int c = i * 256 + lane * 4;
                v[i] = v[i] * rs * gn2[i] * (sc2[i] + 1.0f) + sh2[i];
                *(unsigned*)((unsigned char*)hb + (long)t * D + c) = cvt4_fp8(v[i][0], v[i][1], v[i][2], v[i][3]);
                *(LAS f32x4*)(hb_ + c) = v[i];
            }
            if (lane == j) k_t = t;
            itk = j + 1;
        } else {
#pragma unroll
            for (int i = 0; i < 4; ++i) *(LAS f32x4*)(hb_ + i * 256 + lane * 4) = (f32x4){0.f, 0.f, 0.f, 0.f};
        }
        __syncthreads();
        float lp[16];
#pragma unroll
        for (int tk = 0; tk < 4; ++tk) {
            const LAS float* hr_ = hrow + ((j & 1) * 4 + tk) * 1024;
            f32x4 hv[4];
#pragma unroll
            for (int i = 0; i < 4; ++i) hv[i] = *(const LAS f32x4*)(hr_ + i * 256 + lane * 4);
            f32x4 a4 = (f32x4){0.f, 0.f, 0.f, 0.f};
#pragma unroll
            for (int i = 0; i < 4; ++i)
#pragma unroll
                for (int c = 0; c < 4; ++c) a4 += rwr[i][c] * hv[i][c];
            lp[tk * 4 + 0] = a4[0]; lp[tk * 4 + 1] = a4[1]; lp[tk * 4 + 2] = a4[2]; lp[tk * 4 + 3] = a4[3];
        }
        const float lgt = wave_sum16(lp, lane);
        if (lane < 16) lgtab[((lane >> 2) * 64 + j) * 16 + 4 * w + (lane & 3)] = lgt;
    }
    __syncthreads();
    {
        float mylg[16];
        {
            const int li = lane < itk ? lane : 0;
#pragma unroll
            for (int q = 0; q < 4; ++q) { const f32x4 g4 = *(LAS f32x4*)(lgtab + (w * 64 + li) * 16 + q * 4); mylg[q * 4 + 0] = g4[0]; mylg[q * 4 + 1] = g4[1]; mylg[q * 4 + 2] = g4[2]; mylg[q * 4 + 3] = g4[3]; }
        }
        float aff[16], sel[16];
#pragma unroll
        for (int e = 0; e < 16; ++e) { aff[e] = __builtin_amdgcn_rcpf(1.0f + __expf(-mylg[e])); sel[e] = aff[e] + rb[e]; }
        int gbest = 0; float gmax = -INFINITY;
#pragma unroll
        for (int g = 0; g < 4; ++g) {
            float m1 = -INFINITY, m2 = -INFINITY;
#pragma unroll
            for (int j = 0; j < 4; ++j) { const float s = sel[g * 4 + j]; if (s > m1) { m2 = m1; m1 = s; } else if (s > m2) m2 = s; }
            const float gs = m1 + m2;
            if (gs > gmax) { gmax = gs; gbest = g; }
        }
        float s4[4], a4[4];
#pragma unroll
        for (int j = 0; j < 4; ++j) { s4[j] = -INFINITY; a4[j] = 0.f; }
#pragma unroll
        for (int g = 0; g < 4; ++g) if (g == gbest) {
#pragma unroll
            for (int j = 0; j < 4; ++j) { s4[j] = sel[g * 4 + j]; a4[j] = aff[g * 4 + j]; }
        }
        int i1 = 0; float b1 = s4[0];
#pragma unroll
        for (int j = 1; j < 4; ++j) if (s4[j] > b1) { b1 = s4[j]; i1 = j; }
        int i2 = -1; float b2 = -INFINITY;
#pragma unroll
        for (int j = 0; j < 4; ++j) if (j != i1 && s4[j] > b2) { b2 = s4[j]; i2 = j; }
        float w1 = 0.f, w2 = 0.f;
#pragma unroll
        for (int j = 0; j < 4; ++j) { if (j == i1) w1 = a4[j]; if (j == i2) w2 = a4[j]; }
        const float wn = 1.0f / (w1 + w2 + 1e-30f);
        k_e1 = gbest * 4 + i1; k_e2 = gbest * 4 + i2; k_w1 = w1 * wn; k_w2 = w2 * wn;
    }
    {
        const bool valid = k_t >= 0;
        const unsigned long long lt = (1ull << lane) - 1ull;
        int mycount = 0, r1 = 0, r2 = 0;
#pragma unroll
        for (int e = 0; e < 16; ++e) {
            const unsigned long long m1 = __ballot(valid && k_e1 == e), m2 = __ballot(valid && k_e2 == e);
            const int c1 = __popcll(m1), c2 = __popcll(m2);
            if (lane == e) mycount = c1 + c2;
            if (valid && k_e1 == e) r1 = __popcll(m1 & lt);
            if (valid && k_e2 == e) r2 = c1 + __popcll(m2 & lt);
        }
        int base = 0;
        if (lane < 16 && mycount > 0) base = atomicAdd(&cnt[lane * 32], mycount);
        const int b1 = __shfl(base, valid ? k_e1 : 0), b2 = __shfl(base, valid ? k_e2 : 0);
        if (valid) {
            list[(long)k_e1 * T + b1 + r1] = make_int2(2 * k_t, __float_as_int(k_w1));
            list[(long)k_e2 * T + b2 + r2] = make_int2(2 * k_t + 1, __float_as_int(k_w2));
        }
    }
}

__global__ void __launch_bounds__(NTHREADS, 2) fwd_kernel(Params P) {
    extern __shared__ __attribute__((aligned(16))) unsigned char lds_raw[];
    LAS unsigned char* lds = (LAS unsigned char*)lds_raw;
    XcdBarrier bar; bar.bar = (unsigned*)(P.ws + WS_CTL); bar.x = 0; bar.nloc = 0u; bar.nx = 0u;
    const int lo = P.ph_lo, hi = P.ph_hi;
    unsigned slot0 = 0u;
    if (hi - lo > 1) bar = xcd_barrier_post((unsigned*)(P.ws + WS_CTL), slot0);
    int xq = (int)(blockIdx.x & 7), slot = (int)(blockIdx.x >> 3), nsl = (int)(gridDim.x >> 3); bool xl = false; unsigned lgen = 0u;
    if ((int)blockIdx.x >= nsl * 8) slot = 1 << 20;
#ifndef PHASE_MASK
#define PHASE_MASK 0x3ff
#endif
#define EN(c) (((PHASE_MASK) >> (c)) & 1)
#define IN(k) (lo <= (k) && (k) < hi)
#define SEAM(k) do { if (IN((k) + 1)) { TSTAMP_PHASE(); xcd_barrier(bar); TSTAMP(10); } } while (0)
    unsigned long long tprev = 0ull;
    unsigned long long* tsb = (unsigned long long*)(P.ws + WS_TS) + (size_t)blockIdx.x * 16;
    if (PROBE_SEL1 >= 0 && threadIdx.x == 0) { for (int i = 0; i < 16; ++i) tsb[i] = 0ull; tprev = __builtin_amdgcn_s_memrealtime(); }
#define TSTAMP_PHASE() do { if (PROBE_SEL1 >= 0 && threadIdx.x == 0) { const unsigned long long t_ = __builtin_amdgcn_s_memrealtime(); tsb[11] += t_ - tprev; tsb[15] += t_ - tprev; tprev = t_; } } while (0)
#define TSTAMP(cls) do { if (PROBE_SEL1 >= 0 && threadIdx.x == 0) { const unsigned long long t_ = __builtin_amdgcn_s_memrealtime(); tsb[cls] += t_ - tprev; tsb[15] += t_ - tprev; tprev = t_; } } while (0)
#define TID_ENTER() int tid = threadIdx.x; asm volatile("" : "+v"(tid)); const int lane = tid & 63, wid = tid >> 6, wr = wid >> 1, wc = wid & 1, fr = lane & 15, fq = lane >> 4; (void)wr; (void)wc; (void)fr; (void)fq
#ifdef USE_DYN_QUEUE
#define DYN_LOOP_BEGIN(qi, NU) { unsigned* q_ = (unsigned*)(P.ws + WS_CTL + CTL_Q_OFF) + (l * 4 + (qi)) * 32; const int nu_ = (NU); int nxt_ = 0; \
        if (threadIdx.x == 0) nxt_ = (int)atomicAdd(q_, 1u); \
        for (;;) { if (threadIdx.x == 0) xbw[2] = (unsigned)nxt_; __syncthreads(); const int u = __builtin_amdgcn_readfirstlane((int)xbw[2]); __syncthreads(); if (u >= nu_) break; \
            if (threadIdx.x == 0) nxt_ = (int)atomicAdd(q_, 1u);
#else
#define DYN_LOOP_BEGIN(qi, NU) { const int nu_ = (NU); for (int u = blockIdx.x; u < nu_; u += gridDim.x) {
#endif
#define DYN_LOOP_END() } }
#define XCD_LOOP(R_, NN_, RT, NT) for (int s_ = (int)(blockIdx.x >> 3), RT = (s_ / (NN_)) * 8 + (int)(blockIdx.x & 7), NT = s_ % (NN_); (s_ / (NN_)) * 8 < (R_); \
        s_ += (int)(gridDim.x >> 3), RT = (s_ / (NN_)) * 8 + (int)(blockIdx.x & 7), NT = s_ % (NN_)) if (RT < (R_))
#define PHASE_ENTER() TID_ENTER(); unsigned char* ws = P.ws; int l = l0; LAUNDER_S(ws); LAUNDER_S(l); const bool last = (l == DEPTH - 1); const int MT_Q = last ? TL / 128 : T / 128; \
    const float* mod = (const float*)(ws + WS_MOD); float* ssq = (float*)(ws + WS_SSQ); (void)mod; (void)ssq; (void)MT_Q; (void)last

    if (EN(0) && IN(0)) { TID_ENTER(); phase0(P, lds, tid); SEAM(0); TSTAMP(0); }
    if (hi - lo > 1) {
        LAS unsigned* mb_ = (LAS unsigned*)lds;
        __syncthreads();
        if (threadIdx.x == 0) {
            unsigned* bw = (unsigned*)(P.ws + WS_CTL);
            const unsigned c0 = xb_ld(&bw[XB_XCNT(0)]);
            bool ok = c0 > 0u && c0 * 8u == gridDim.x;
#pragma unroll
            for (int j = 1; j < 16; ++j) { const unsigned c = xb_ld(&bw[XB_XCNT(j)]); ok = ok && (c == (j < 8 ? c0 : 0u)); }
            mb_[0] = ok ? 1u : 0u; mb_[1] = slot0; mb_[2] = c0;
        }
        __syncthreads();
        if (__builtin_amdgcn_readfirstlane((int)mb_[0]) != 0) { xl = true; xq = __builtin_amdgcn_readfirstlane((int)bar.x); slot = __builtin_amdgcn_readfirstlane((int)mb_[1]); nsl = __builtin_amdgcn_readfirstlane((int)mb_[2]); }
        __syncthreads();
    }
#define LSEAM(k) do { if (IN((k) + 1)) { TSTAMP_PHASE(); if (xl) xcd_local_barrier(bar.bar, (unsigned*)(P.ws + WS_CTL + CTL_LB_OFF) + xq * 32, lgen, (unsigned)nsl); else xcd_barrier(bar); TSTAMP(10); } } while (0)
#define BTOK(i_) ((i_) < SEQ ? xq * SEQ + (i_) : TL + xq * CL + ((i_) - SEQ))
#define BRT(j_) ((j_) < 16 ? xq * 16 + (j_) : 128 + xq * 2 + ((j_) - 16))

    for (int l0 = 0; l0 < DEPTH; ++l0) {
        const int pb = 1 + l0 * 9;
        if (EN(1) && IN(pb + 0)) { TID_ENTER(); int l = l0; LAUNDER_S(l); phase_norm1(P, l, tid, xq, slot, nsl); LSEAM(pb + 0); TSTAMP(1); }
        if (EN(2) && IN(pb + 1)) {
            PHASE_ENTER();
            const bf16_t* hb = (const bf16_t*)(ws + WS_HBUF);
            const unsigned char* w8 = ws + WS_WIN + (size_t)l * DINP * 1024;
            bf16_t* pbuf = (bf16_t*)(ws + WS_PBUF); bf16_t* vst = (bf16_t*)(ws + WS_VST);
            const int nu = (T / 128) * 10;
            for (int u_ = slot; u_ < 18 * 10; u_ += nsl) {
                const int mt = BRT(u_ / 10), nt = u_ % 10;
                GemmDesc8 g; g.A = (const unsigned char*)hb + (long)mt * 128 * D; g.lda = D; g.B = w8 + (long)nt * 128 * 1024; g.ldb = 1024; g.K = 1024; g.aidx = nullptr; g.aidx_stride = 0; g.mvalid = 128;
                f32x4 acc[4][4];
                GEMM8_SEL(0, g, acc);
#pragma unroll
                for (int mb = 0; mb < 4; ++mb) {
                    const int t = mt * 128 + wr * 64 + mb * 16 + fr;
                    float sq = 0.f;
#pragma unroll
                    for (int nb = 0; nb < 4; ++nb) {
                        const int col = nt * 128 + wc * 64 + nb * 16 + fq * 4;
                        const f32x4 a = acc[mb][nb] * (1.0f / W8_SCALE);
                        sq += a[0] * a[0] + a[1] * a[1] + a[2] * a[2] + a[3] * a[3];
                        if (col < DIN) {
                            u32x2 w2; w2.x = cvt_pk_bf16(a[0], a[1]); w2.y = cvt_pk_bf16(a[2], a[3]);
                            *(u32x2*)(pbuf + (long)t * DIN + col) = w2;
                            if (nt == 9) {
#pragma unroll
                                for (int j = 0; j < 4; ++j) vst[(long)(col - PC_VS + j) * T + t] = f2bf(a[j]);
                            }
                        }
                    }
                    if (nt >= 2 && nt <= 4) {
                        sq += __shfl_xor(sq, 16); sq += __shfl_xor(sq, 32);
                        if (fq == 0) ssq[(long)t * 8 + (nt - 2) * 2 + wc] = sq;
                    }
                }
            }
            LSEAM(pb + 1); TSTAMP(2);
        }
        if (EN(3) && IN(pb + 2)) {
            PHASE_ENTER();
            const bf16_t* pbuf = (const bf16_t*)(ws + WS_PBUF);
            const bf16_t* wuq = (const bf16_t*)(ws + WS_WUQ) + (long)l * 640 * 256;
            const bf16_t* wukv = (const bf16_t*)(ws + WS_WUKV) + (long)l * 768 * 128;
            const bf16_t* fw = (const bf16_t*)(ws + WS_FW) + (long)l * 4 * 128 * 128;
            bf16_t* qraw = (bf16_t*)(ws + WS_QRAW); bf16_t* knraw = (bf16_t*)(ws + WS_KNRAW); bf16_t* vmt = (bf16_t*)(ws + WS_VMT); bf16_t* abt = (bf16_t*)(ws + WS_ABT);
            const bf16_t* hbk = (const bf16_t*)(ws + WS_HBUF);
            const unsigned char* wkr8 = ws + WS_WIN + ((size_t)l * DINP + 1280) * 1024;
            bf16_t* pbw = (bf16_t*)(ws + WS_PBUF);
            const int RQ_ = last ? 16 : 18;
            const int nukr = 18, nuq = nukr + RQ_ * 5, nukv = 18 * 6, nuf = RQ_ * 4;
            for (int u = slot; u < nuq + nukv + nuf; u += nsl) {
                int kind, mt, nt;
                if (u < nukr) { kind = 3; mt = u; nt = 0; } else if (u < nuq) { kind = 0; const int v = u - nukr; mt = v / 5; nt = v % 5; } else if (u < nuq + nukv) { kind = 1; const int v = u - nuq; mt = v / 6; nt = v % 6; } else { kind = 2; const int v = u - nuq - nukv; mt = v >> 2; nt = v & 3; }
                mt = BRT(mt);
                GemmDesc g; g.lda = DIN; g.aidx = nullptr; g.aidx_stride = 0; g.mvalid = 128;
                if (kind == 0) { g.A = pbuf + (long)mt * 128 * DIN + PC_CQ; g.B = wuq + (long)nt * 128 * 256; g.ldb = 256; g.K = 256; }
                else if (kind == 1) { g.A = pbuf + (long)mt * 128 * DIN + PC_CKV; g.B = wukv + (long)nt * 128 * 128; g.ldb = 128; g.K = 128; }
                else if (kind == 2) { g.A = pbuf + (long)mt * 128 * DIN + (nt >> 1) * 128; g.B = fw + (long)nt * 128 * 128; g.ldb = 128; g.K = 128; }
                f32x4 acc[4][4];
                if (kind == 3) {
                    GemmDesc8 g8; g8.A = (const unsigned char*)hbk + (long)mt * 128 * D; g8.lda = D; g8.B = wkr8; g8.ldb = 1024; g8.K = 1024; g8.aidx = nullptr; g8.aidx_stride = 0; g8.mvalid = 128;
                    GEMM8_SEL(1, g8, acc);
                } else GEMM_SEL(2, g, acc);
#pragma unroll
                for (int mb = 0; mb < 4; ++mb) {
                    const int t = mt * 128 + wr * 64 + mb * 16 + fr;
                    const float* sp = ssq + (long)t * 8;
                    float rs = 1.f;
                    if (kind == 0) rs = rsqrtf((sp[0] + sp[1] + sp[2] + sp[3]) * (1.0f / 256.0f) + EPS);
                    else if (kind == 1) rs = rsqrtf((sp[4] + sp[5]) * (1.0f / 128.0f) + EPS);
#pragma unroll
                    for (int nb = 0; nb < 4; ++nb) {
                        const int cl = wc * 64 + nb * 16 + fq * 4;
                        const f32x4 a = acc[mb][nb] * (kind == 3 ? 1.0f / W8_SCALE : rs);
                        if (kind == 0) {
                            const int col = nt * 128 + cl;
                            if (col < 576) { u32x2 w2; w2.x = cvt_pk_bf16(a[0], a[1]); w2.y = cvt_pk_bf16(a[2], a[3]); *(u32x2*)(qraw + (long)t * 576 + col) = w2; }
                        } else if (kind == 1) {
                            const int col = nt * 128 + cl;
                            if (nt < 3) { u32x2 w2; w2.x = cvt_pk_bf16(a[0], a[1]); w2.y = cvt_pk_bf16(a[2], a[3]); *(u32x2*)(knraw + (long)t * 384 + col) = w2; }
                            else {
#pragma unroll
                                for (int j = 0; j < 4; ++j) vmt[(long)(col - 384 + j) * T + t] = f2bf(a[j]);
                            }
                        } else if (kind == 3) {
                            if (cl < 32) { u32x2 w2; w2.x = cvt_pk_bf16(a[0], a[1]); w2.y = cvt_pk_bf16(a[2], a[3]); *(u32x2*)(pbw + (long)t * DIN + PC_KR + cl) = w2; }
                        } else {
                            const int cs = cl >> 6, row = nt * 64 + (cl & 63);
                            bf16_t* dst = t < TL ? abt + ((long)(t >> 11) * 256 + row) * 4096 + cs * 2048 + (t & 2047)
                                                 : abt + (long)8 * 256 * 4096 + ((long)((t - TL) >> 8) * 256 + row) * 512 + cs * 256 + ((t - TL) & 255);
#pragma unroll
                            for (int j = 0; j < 4; ++j) dst[(long)j * (t < TL ? 4096 : 512)] = f2bf(a[j]);
                        }
                    }
                }
            }
            LSEAM(pb + 2); TSTAMP(3);
        }
        if (EN(4) && IN(pb + 3)) { TID_ENTER(); int l = l0; LAUNDER_S(l); phase_prep(P, l, tid, xq, slot, nsl); LSEAM(pb + 3); TSTAMP(4); }
        if (EN(5) && IN(pb + 4)) {
            PHASE_ENTER();
            const bf16_t* qraw = (const bf16_t*)(ws + WS_QRAW); const bf16_t* km = (const bf16_t*)(ws + WS_KM); const bf16_t* vmt = (const bf16_t*)(ws + WS_VMT);
            const bf16_t* pbq = (const bf16_t*)(ws + WS_PBUF); const bf16_t* ks = (const bf16_t*)(ws + WS_KS); const bf16_t* vst = (const bf16_t*)(ws + WS_VST);
            const float2* ropeS = (const float2*)(ws + WS_ROPES); const float2* ropeM = (const float2*)(ws + WS_ROPEM);
            const bf16_t* abt = (const bf16_t*)(ws + WS_ABT); const bf16_t* csl = (const bf16_t*)(ws + WS_CS); const bf16_t* csc = (const bf16_t*)(ws + WS_CSC);
            unsigned char* outx = ws + WS_OUTX;
            constexpr int NPOS = 2048;
            (void)NPOS;
            for (int rnd = 0; rnd < 4; ++rnd) for (int vs = slot; vs < 64; vs += nsl) {
                int kind = -1, v = 0;
                const int xb = xq, sl = vs - 16;
                if (rnd == 0) { if (vs < 16) { kind = 1; v = xb * 16 + vs; } else { kind = 0; v = xb * 96 + sl; } }
                else if (rnd == 1) { if (vs < 16) { if (!last) { if (vs < 12) { kind = 3; v = xb * 12 + vs; } else { kind = 5; v = xb * 4 + (vs - 12); } } } else { kind = 0; v = xb * 96 + 48 + sl; } }
                else if (rnd == 2) { if (vs < 12) { if (!last) { kind = 4; v = xb * 12 + vs; } } else if (vs == 12) { kind = 6; v = xb; } else if (vs >= 16) { kind = 2; v = xb * 96 + sl; } }
                else { if (vs >= 16) { kind = 2; v = xb * 96 + 48 + sl; } }
                if (kind == 0) {
                    const int b = v / 96, r = v % 96, h = r >> 4, qb = r & 15;
                    const int qt = b * SEQ + qb * 128;
                    attn_unit<96, false>(qraw + (long)qt * 576 + h * 96, 576, km + h * 96, 576, vmt + (long)h * 64 * T,
                                         b * SEQ, 16, TL + b * CL, 2, 0, 0, 0.f, false, outx + (long)qt * D + 256 + h * 64, lds, tid,
                                         P.in[I_MQG] + l * 96, ropeM, qb * 128, 0.10206207261596577f * LOG2E);
                } else if (kind == 1) {
                    const int b = v >> 4, mt = (v >> 1) & 7, nt = v & 1;
                    GemmDesc g; g.A = csl + (long)mt * 128 * 4096; g.lda = 4096; g.B = abt + ((long)b * 256 + nt * 128) * 4096; g.ldb = 4096; g.K = 2048;
                    g.aidx = nullptr; g.aidx_stride = 0; g.mvalid = 128;
                    f32x4 acc[4][4], acc2[4][4];
                    GEMM_SEL(3, g, acc);
                    g.A += 2048; g.B += 2048;
                    GEMM_SEL(3, g, acc2);
#pragma unroll
                    for (int mb = 0; mb < 4; ++mb) {
                        const int np = mt * 128 + wr * 64 + mb * 16 + fr;
                        const long t1 = (long)b * SEQ + np, t2 = (long)b * SEQ + ((SEQ - np) & (SEQ - 1));
#pragma unroll
                        for (int nb = 0; nb < 4; ++nb) {
                            const f32x4 p = acc[mb][nb] + acc2[mb][nb], m = acc[mb][nb] - acc2[mb][nb];
                            const int col = nt * 128 + wc * 64 + nb * 16 + fq * 4;
                            *(unsigned*)(outx + t1 * D + col) = cvt4_fp8(p[0] * OUT8_SCALE, p[1] * OUT8_SCALE, p[2] * OUT8_SCALE, p[3] * OUT8_SCALE);
                            if (np != 0) *(unsigned*)(outx + t2 * D + col) = cvt4_fp8(m[0] * OUT8_SCALE, m[1] * OUT8_SCALE, m[2] * OUT8_SCALE, m[3] * OUT8_SCALE);
                        }
                    }
                } else if (kind == 6) {
                    const int b = v;
                    const bf16_t* arow = abt + ((long)b * 256 + tid) * 4096;
                    float s0 = 0.f, s1 = 0.f, s2 = 0.f, s3 = 0.f;
                    for (int n = 0; n < 2048; n += 16) {
                        const u32x4 q0 = *(const u32x4*)(arow + n), q1 = *(const u32x4*)(arow + n + 8);
                        s0 += bf_lo(q0.x) - bf_hi(q0.x) + bf_lo(q0.y) - bf_hi(q0.y);
                        s1 += bf_lo(q0.z) - bf_hi(q0.z) + bf_lo(q0.w) - bf_hi(q0.w);
                        s2 += bf_lo(q1.x) - bf_hi(q1.x) + bf_lo(q1.y) - bf_hi(q1.y);
                        s3 += bf_lo(q1.z) - bf_hi(q1.z) + bf_lo(q1.w) - bf_hi(q1.w);
                    }
                    const float cN = bf_lo(cvt_pk_bf16(0.022097086912079608f, 0.f));
                    outx[((long)b * SEQ + 1024) * D + tid] = (unsigned char)(cvt4_fp8(((s0 + s1) + (s2 + s3)) * cN * OUT8_SCALE, 0.f, 0.f, 0.f) & 0xffu);
                } else if (kind == 2) {
                    const int b = v / 96, r = v % 96, h = r >> 4, qb = r & 15, kvh = h / 3;
                    const int qt = b * SEQ + qb * 128;
                    int k0 = qb * 128 - 128; if (k0 < 0) k0 = 0;
                    int k1 = qb * 128 + 256; if (k1 > SEQ) k1 = SEQ;
                    const float sink2 = P.in[I_SINK][l * 6 + h] * LOG2E;
                    attn_unit<64, true>(pbq + (long)qt * DIN + PC_QS + h * 64, DIN, ks + kvh * 64, 128, vst + (long)kvh * 64 * T,
                                        b * SEQ + k0, (k1 - k0) >> 7, TL + b * CL, 2, qb * 128, k0, sink2, true, outx + (long)qt * D + 640 + h * 64, lds, tid,
                                        P.in[I_SQG] + l * 64, ropeS, qb * 128, 0.125f * LOG2E);
                } else if (kind == 3) {
                    const int b = v / 12, r = v % 12, h = r >> 1, qb = r & 1;
                    const int qt = TL + b * CL + qb * 128;
                    attn_unit<96, false>(qraw + (long)qt * 576 + h * 96, 576, km + h * 96, 576, vmt + (long)h * 64 * T,
                                         TL + b * CL, 2, 0, 0, 0, 0, 0.f, false, outx + (long)qt * D + 256 + h * 64, lds, tid,
                                         P.in[I_MQG] + l * 96, nullptr, 0, 0.10206207261596577f * LOG2E);
                } else if (kind == 4) {
                    const int b = v / 12, r = v % 12, h = r >> 1, qb = r & 1, kvh = h / 3;
                    const int qt = TL + b * CL + qb * 128;
                    const float sink2 = P.in[I_SINK][l * 6 + h] * LOG2E;
                    attn_unit<64, false>(pbq + (long)qt * DIN + PC_QS + h * 64, DIN, ks + kvh * 64, 128, vst + (long)kvh * 64 * T,
                                         TL + b * CL, 2, 0, 0, 0, 0, sink2, true, outx + (long)qt * D + 640 + h * 64, lds, tid,
                                         P.in[I_SQG] + l * 64, nullptr, 0, 0.125f * LOG2E);
                } else if (kind == 5) {
                    const int b = v >> 2, mt = (v >> 1) & 1, nt = v & 1;
                    GemmDesc g; g.A = csc + (long)mt * 128 * 512; g.lda = 512; g.B = abt + (long)8 * 256 * 4096 + ((long)b * 256 + nt * 128) * 512; g.ldb = 512; g.K = 512;
                    g.aidx = nullptr; g.aidx_stride = 0; g.mvalid = 128;
                    f32x4 acc[4][4];
                    GEMM_SEL(4, g, acc);
                    int tl = tid; asm volatile("" : "+v"(tl));
                    const int ln_ = tl & 63, wd_ = tl >> 6, wr_ = wd_ >> 1, wc_ = wd_ & 1, fr_ = ln_ & 15, fq_ = ln_ >> 4;
#pragma unroll
                    for (int mb = 0; mb < 4; ++mb) {
                        const int t = TL + b * CL + mt * 128 + wr_ * 64 + mb * 16 + fr_;
#pragma unroll
                        for (int nb = 0; nb < 4; ++nb) { const f32x4 a = acc[mb][nb] * OUT8_SCALE;
                            *(unsigned*)(outx + (long)t * D + nt * 128 + wc_ * 64 + nb * 16 + fq_ * 4) = cvt4_fp8(a[0], a[1], a[2], a[3]); }
                    }
                }
            }
            LSEAM(pb + 4); TSTAMP(5);
        }
        if (EN(6) && IN(pb + 5)) {
            PHASE_ENTER();
            const unsigned char* outx = ws + WS_OUTX;
            const unsigned char* w = ws + WS_WOUT + (size_t)l * 1024 * 1024;
            const int nu = MT_Q * 8;
            for (int u_ = slot; u_ < (last ? 16 : 18) * 8; u_ += nsl) {
                const int mt = BRT(u_ >> 3), nt = u_ & 7;
                GemmDesc8 g; g.A = outx + (long)mt * 128 * D; g.lda = D; g.B = w + (long)nt * 128 * 1024; g.ldb = 1024; g.K = 1024; g.aidx = nullptr; g.aidx_stride = 0; g.mvalid = 128;
                f32x4 acc[4][4];
                GEMM8_SEL(5, g, acc);
#pragma unroll
                for (int mb = 0; mb < 4; ++mb) {
                    const int t = mt * 128 + wr * 64 + mb * 16 + fr;
                    const int r = t < TL ? (t >> 11) : 8;
                    float* xr = xrow(P, t);
                    const float* g1 = mod + ((long)l * 9 + r) * 6144 + 2048;
#pragma unroll
                    for (int nb = 0; nb < 4; ++nb) {
                        const int col = nt * 128 + wc * 64 + nb * 16 + fq * 4;
                        const f32x4 gv = *(const f32x4*)(g1 + col);
                        f32x4 xv = *(f32x4*)(xr + col);
                        xv += gv * (acc[mb][nb] * (1.0f / (W8_SCALE * OUT8_SCALE)));
                        *(f32x4*)(xr + col) = xv;
                    }
                }
            }
            LSEAM(pb + 5); TSTAMP(6);
        }
        if (EN(7) && IN(pb + 6)) { TID_ENTER(); int l = l0; LAUNDER_S(l); phase_norm2_router(P, l, lds, tid, xq, slot, nsl); SEAM(pb + 6); TSTAMP(7); }
        if (EN(8) && (IN(pb + 7) || IN(pb + 8))) {
            PHASE_ENTER();
            const int* cnt = (const int*)(ws + WS_CTL + CTL_CNT_OFF) + l * 16 * 32;
            const int2* list = (const int2*)(ws + WS_LIST);
            const bf16_t* hb = (const bf16_t*)(ws + WS_HBUF);
            bf16_t* act = (bf16_t*)(ws + WS_ACT); bf16_t* ysl = (bf16_t*)(ws + WS_YSLOT);
            const unsigned char* wgu8 = ws + WS_WGU + (size_t)l * NE * 1024 * 1024;
            const unsigned char* wdn8 = ws + WS_WDN + (size_t)l * NE * 1024 * 512;
            int tstart[17];
            {
                int s = 0;
#pragma unroll
                for (int e = 0; e < 16; ++e) { tstart[e] = s; s += (__builtin_amdgcn_readfirstlane(cnt[e * 32]) + 127) >> 7; }
                tstart[16] = s;
            }
            const int nu = tstart[16] * 8;
            if (IN(pb + 7)) {
                XCD_LOOP(tstart[16], 8, rt, nt) {
                    int e = 0;
#pragma unroll
                    for (int j = 1; j < 16; ++j) if (rt >= tstart[j]) e = j;
                    int ts_e = 0;
#pragma unroll
                    for (int j = 0; j < 16; ++j) if (j == e) ts_e = tstart[j];
                    const int mt = rt - ts_e, ce = cnt[e * 32], mv = (ce - mt * 128) < 128 ? (ce - mt * 128) : 128;
                    GemmDesc8 g; g.A = (const unsigned char*)hb; g.lda = D; g.B = (const unsigned char*)wgu8 + ((long)e * 1024 + nt * 128) * 1024; g.ldb = 1024; g.K = 1024;
                    g.aidx = (const int*)(list + (long)e * T + mt * 128); g.aidx_stride = 2; g.mvalid = mv;
                    f32x4 acc[4][4];
                    GEMM8_SEL(6, g, acc);
#pragma unroll
                    for (int mb = 0; mb < 4; ++mb) {
                        const int rl = wr * 64 + mb * 16 + fr;
                        if (rl < mv) {
                            unsigned char* ar = (unsigned char*)act + ((long)rt * 128 + rl) * DE + nt * 64 + wc * 32 + fq * 4;
#pragma unroll
                            for (int p = 0; p < 2; ++p) {
                                const f32x4 gt = acc[mb][2 * p] * (1.0f / W8_SCALE), up = acc[mb][2 * p + 1] * (ACT8_SCALE / W8_SCALE);
                                *(unsigned*)(ar + p * 16) = cvt4_fp8(silu_f(gt[0]) * up[0], silu_f(gt[1]) * up[1], silu_f(gt[2]) * up[2], silu_f(gt[3]) * up[3]);
                            }
                        }
                    }
                }
                SEAM(pb + 7); TSTAMP(8);
            }
            if (IN(pb + 8)) {
                XCD_LOOP(tstart[16], 8, rt, nt) {
                    int e = 0;
#pragma unroll
                    for (int j = 1; j < 16; ++j) if (rt >= tstart[j]) e = j;
                    int ts_e = 0;
#pragma unroll
                    for (int j = 0; j < 16; ++j) if (j == e) ts_e = tstart[j];
                    const int mt = rt - ts_e, ce = cnt[e * 32], mv = (ce - mt * 128) < 128 ? (ce - mt * 128) : 128;
                    GemmDesc8 g; g.A = (const unsigned char*)act + (long)rt * 128 * DE; g.lda = DE; g.B = (const unsigned char*)wdn8 + ((long)e * 1024 + nt * 128) * 512; g.ldb = 512; g.K = 512;
                    g.aidx = nullptr; g.aidx_stride = 0; g.mvalid = 128;
                    f32x4 acc[4][4];
                    GEMM8_SEL(7, g, acc);
#pragma unroll
                    for (int mb = 0; mb < 4; ++mb) {
                        const int rl = wr * 64 + mb * 16 + fr;
                        if (rl < mv) {
                            const int2 le = list[(long)e * T + mt * 128 + rl];
                            const float wgt = __int_as_float(le.y) * (1.0f / (ACT8_SCALE * W8_SCALE));
                            bf16_t* yr = ysl + (long)le.x * D + nt * 128 + wc * 64 + fq * 4;
#pragma unroll
                            for (int nb = 0; nb < 4; ++nb) { const f32x4 a = acc[mb][nb] * wgt; u32x2 w2; w2.x = cvt_pk_bf16(a[0], a[1]); w2.y = cvt_pk_bf16(a[2], a[3]); *(u32x2*)(yr + nb * 16) = w2; }
                        }
                    }
                }
                SEAM(pb + 8); TSTAMP(9);
            }
        }
    }
    if (EN(9) && IN(1 + DEPTH * 9)) { TID_ENTER(); phase_final(P, tid); }
#undef IN
#undef SEAM
}


#ifndef DUMP_MASK
#define DUMP_MASK 0
#endif
__device__ __forceinline__ float dbg_ld(const unsigned char* ws, size_t off, size_t len, size_t i) { return bf2f(((const bf16_t*)(ws + off))[i % len]); }
__global__ void dump_kernel(float* out, const unsigned char* ws, int mask) {
    const size_t n = (size_t)TL * D;
    for (size_t i = (size_t)blockIdx.x * blockDim.x + threadIdx.x; i < n; i += (size_t)gridDim.x * blockDim.x) {
        float v = 0.f;
        if (mask & 1) v += dbg_ld(ws, WS_HBUF, (size_t)T * D, i);
        if (mask & 2) v += dbg_ld(ws, WS_PBUF, (size_t)T * DIN, i) + dbg_ld(ws, WS_PBUF, (size_t)T * DIN, i + 7500000) + dbg_ld(ws, WS_VST, (size_t)128 * T, i);
        if (mask & 4) v += dbg_ld(ws, WS_QRAW, (size_t)T * 576, i) + dbg_ld(ws, WS_KNRAW, (size_t)T * 384, i) + dbg_ld(ws, WS_VMT, (size_t)T * 384, i) + dbg_ld(ws, WS_ABT, (size_t)T * 512, i);
        if (mask & 8) v += dbg_ld(ws, WS_QM, (size_t)T * 576, i) + dbg_ld(ws, WS_KM, (size_t)T * 576, i) + dbg_ld(ws, WS_QS, (size_t)T * 384, i) + dbg_ld(ws, WS_KS, (size_t)T * 128, i);
        if (mask & 16) v += dbg_ld(ws, WS_OUTX, (size_t)T * D, i);
        { const int c = (int)(i & 1023); const bool sel = ((mask & 64) && c < 256) || ((mask & 128) && c >= 256 && c < 640) || ((mask & 256) && c >= 640);
          if (sel) v += dbg_ld(ws, WS_OUTX, (size_t)T * D, i); }
        if (mask & 32) v += dbg_ld(ws, WS_CS, (size_t)2048 * 4096, i) + dbg_ld(ws, WS_WOUT, (size_t)4 * 1024 * 1024, i) + dbg_ld(ws, WS_WGU, (size_t)64 * 1024 * 1024, i) + dbg_ld(ws, WS_WDN, (size_t)64 * 1024 * 512, i)
                         + ((const float*)(ws + WS_MOD))[i % (size_t)(4 * 9 * 6144)] + ((const float*)(ws + WS_ROPES))[i % (size_t)(2048 * 64)] + ((const float*)(ws + WS_ROPEM))[i % (size_t)(2048 * 32)] + dbg_ld(ws, WS_FW, (size_t)16 * 128 * 128, i);
        out[i] = v;
    }
}
extern "C" void kernel_launch(void* const* d_in, const int* in_sizes, int n_in, void* d_out, int out_size, void* d_ws, size_t ws_size, hipStream_t stream) {
    static int grid = 0;
    if (grid == 0) {
        if (n_in != 26 || ws_size < WS_END) { fprintf(stderr, "kernel_launch: expected 26 inputs and >= %zu bytes of workspace (got %d, %zu)\n", (size_t)WS_END, n_in, ws_size); grid = -1; return; }
        int dev = 0, cus = 0, per_cu = 0;
        hipGetDevice(&dev);
        hipDeviceGetAttribute(&cus, hipDeviceAttributeMultiprocessorCount, dev);
        hipFuncSetAttribute((const void*)fwd_kernel, hipFuncAttributeMaxDynamicSharedMemorySize, LDS_BYTES);
        if (hipOccupancyMaxActiveBlocksPerMultiprocessor(&per_cu, (const void*)fwd_kernel, NTHREADS, LDS_BYTES) != hipSuccess || per_cu < 1) per_cu = 1;
        (void)hipGetLastError();
        grid = cus * (per_cu < 2 ? per_cu : 2);
    }
    if (grid < 0) return;
    hipMemsetAsync((char*)d_ws + WS_CTL, 0, CTL_BYTES, stream);
    Params p{};
    for (int i = 0; i < 26; ++i) p.in[i] = (const float*)d_in[i];
    p.out = (float*)d_out; p.ws = (unsigned char*)d_ws;
#ifndef STOP_PH
#define STOP_PH (2 + DEPTH * 9)
#endif
    constexpr int NPH = STOP_PH;
#if N_LAUNCH_MODE == 1
    p.ph_lo = 0; p.ph_hi = NPH;
    hipLaunchKernelGGL(fwd_kernel, dim3(grid), dim3(NTHREADS), LDS_BYTES, stream, p);
#else
    for (int k = 0; k < NPH; ++k) { p.ph_lo = k; p.ph_hi = k + 1; hipLaunchKernelGGL(fwd_kernel, dim3(grid), dim3(NTHREADS), LDS_BYTES, stream, p); }
#endif
    if (DUMP_MASK) hipLaunchKernelGGL(dump_kernel, dim3(1024), dim3(256), 0, stream, (float*)d_out, (const unsigned char*)d_ws, (int)DUMP_MASK);
}
```

```cpp
#include <hip/hip_runtime.h>
#include <cstdint>
#include <cstdio>

#ifndef PROBE_SEL1
#define PROBE_SEL1 -1
#endif
#ifndef PROBE_SEL2
#define PROBE_SEL2 -1
#endif
#ifndef N_LAUNCH_MODE
#define N_LAUNCH_MODE 1
#endif

#define LAS __attribute__((address_space(3)))
typedef unsigned short bf16_t;
typedef short bf16x8 __attribute__((ext_vector_type(8)));
typedef float f32x4 __attribute__((ext_vector_type(4)));
typedef float f32x16 __attribute__((ext_vector_type(16)));
typedef unsigned u32x4 __attribute__((ext_vector_type(4)));
typedef unsigned u32x2 __attribute__((ext_vector_type(2)));

constexpr int D = 1024, NB = 8, SEQ = 2048, CL = 256, DEPTH = 4;
constexpr int TL = NB * SEQ, TC = NB * CL, T = TL + TC;
constexpr int DIN = 1312, DINP = 1408;
constexpr int NE = 16, DE = 512;
constexpr int PC_CQ = 256, PC_CKV = 512, PC_QS = 640, PC_KS = 1024, PC_VS = 1152, PC_KR = 1280;
constexpr float EPS = 1e-6f;
constexpr float LOG2E = 1.4426950408889634f;
constexpr int NTHREADS = 256;
constexpr int LDS_BYTES = 81920;

constexpr size_t al256(size_t x) { return (x + 255) & ~(size_t)255; }
constexpr size_t WS_CTL = 0;
constexpr size_t CTL_BYTES = 32768;
constexpr size_t CTL_CNT_OFF = 16384;
constexpr size_t CTL_Q_OFF = 26624;
constexpr size_t CTL_LB_OFF = 28672;
constexpr size_t WS_MOD = WS_CTL + CTL_BYTES;
constexpr size_t WS_ROPES = WS_MOD + al256((size_t)DEPTH * 9 * 6144 * 4);
constexpr size_t WS_ROPEM = WS_ROPES + (size_t)2048 * 32 * 8;
constexpr size_t WS_FW = WS_ROPEM + (size_t)2048 * 16 * 8;
constexpr size_t WS_CS = WS_FW + (size_t)DEPTH * 4 * 128 * 128 * 2;
constexpr size_t WS_CSC = WS_CS + (size_t)2048 * 4096 * 2;
constexpr size_t WS_WIN = WS_CSC + (size_t)256 * 512 * 2;
constexpr size_t WS_WUQ = WS_WIN + (size_t)DEPTH * DINP * 1024;
constexpr size_t WS_WUKV = WS_WUQ + (size_t)DEPTH * 640 * 256 * 2;
constexpr size_t WS_WOUT = WS_WUKV + (size_t)DEPTH * 768 * 128 * 2;
constexpr size_t WS_WGU = WS_WOUT + (size_t)DEPTH * 1024 * 1024;
constexpr size_t WS_WDN = WS_WGU + (size_t)DEPTH * NE * 1024 * 1024;
constexpr size_t WS_CTX = WS_WDN + (size_t)DEPTH * NE * 1024 * 512;
constexpr size_t WS_SSQ = WS_CTX + (size_t)TC * D * 4;
constexpr size_t WS_HBUF = WS_SSQ + (size_t)T * 8 * 4;
constexpr size_t WS_R = WS_HBUF + (size_t)T * D * 2;
constexpr size_t WS_PBUF = WS_R;
constexpr size_t WS_QRAW = WS_PBUF + (size_t)T * DIN * 2;
constexpr size_t WS_KNRAW = WS_QRAW + (size_t)T * 576 * 2;
constexpr size_t WS_QM = WS_KNRAW + (size_t)T * 384 * 2;
constexpr size_t WS_KM = WS_QM + (size_t)T * 576 * 2;
constexpr size_t WS_VMT = WS_KM + (size_t)T * 576 * 2;
constexpr size_t WS_QS = WS_VMT + (size_t)384 * T * 2;
constexpr size_t WS_KS = WS_QS + (size_t)T * 384 * 2;
constexpr size_t WS_VST = WS_KS + (size_t)T * 128 * 2;
constexpr size_t WS_ABT = WS_VST + (size_t)128 * T * 2;
constexpr size_t WS_OUTX = WS_ABT + (size_t)512 * T * 2;
constexpr size_t WS_MIX_END = WS_OUTX + (size_t)T * D * 2;
constexpr size_t WS_ACT = WS_R;
constexpr size_t WS_LIST = WS_MIX_END;
constexpr size_t WS_YSLOT = WS_LIST + (size_t)NE * T * 8;
constexpr size_t WS_MOE_END = WS_YSLOT + (size_t)2 * T * D * 2;
constexpr size_t WS_TS = WS_MIX_END > WS_MOE_END ? WS_MIX_END : WS_MOE_END;
constexpr size_t WS_END = WS_TS + 1024 * 16 * 8;

#define XB_TMO      128
#define XB_XCNT(j)  (256  + 64 * (j))
#define XB_XSUB(j)  (1280 + 64 * (j))
#define XB_XGEN(j)  (2304 + 64 * (j))
#define XB_TOP      3328
#define XB_TOPGEN   3392
#define XCD_BAR_WORDS 3456
#define XB_SPIN_CAP (1u << 22)

__device__ __forceinline__ unsigned xb_ld(unsigned* p)              { return __hip_atomic_load(p, __ATOMIC_RELAXED, __HIP_MEMORY_SCOPE_AGENT); }
__device__ __forceinline__ unsigned xb_add(unsigned* p, unsigned v) { return __hip_atomic_fetch_add(p, v, __ATOMIC_RELAXED, __HIP_MEMORY_SCOPE_AGENT); }
__device__ __forceinline__ unsigned xb_xcc_id() { return (unsigned)__builtin_amdgcn_s_getreg((3 << 11) | 20) & 0xFu; }
#define XB_SPIN(cond, bar) do { unsigned _sp = 0; while (cond) { __builtin_amdgcn_s_sleep(1); \
    if ((++_sp & 255u) == 0u) { if (xb_ld(&(bar)[XB_TMO])) break; if (_sp > XB_SPIN_CAP) { atomicAdd(&(bar)[XB_TMO], 1u); break; } } } } while (0)

struct XcdBarrier { unsigned* bar; unsigned x; unsigned nloc, nx; };

__device__ __forceinline__ XcdBarrier xcd_barrier_post(unsigned* bar, unsigned& slot0) {
    XcdBarrier b; b.bar = bar; b.x = xb_xcc_id(); b.nloc = 0u; b.nx = 0u;
    if (threadIdx.x == 0) slot0 = xb_add(&bar[XB_XCNT(b.x)], 1u);
    return b;
}
__device__ __forceinline__ void xcd_local_barrier(unsigned* bar, unsigned* cnt, unsigned& gen, unsigned nsl) {
    asm volatile("s_waitcnt vmcnt(0)" ::: "memory");
    __syncthreads();
    ++gen;
    if (threadIdx.x == 0) {
        __builtin_amdgcn_s_waitcnt(0);
        (void)xb_add(cnt, 1u);
        const unsigned want = gen * nsl;
        XB_SPIN(xb_ld(cnt) < want, bar);
        __builtin_amdgcn_fence(__ATOMIC_ACQUIRE, "agent");
        asm volatile("s_waitcnt vmcnt(0)" ::: "memory");
    }
    __syncthreads();
}
__device__ __forceinline__ void xcd_barrier_complete(unsigned* bar, unsigned x, unsigned& nloc, unsigned& nx) {
    const unsigned G = gridDim.x * gridDim.y * gridDim.z;
    unsigned sum, cnt, mine, sp = 0u;
    for (;;) {
        sum = 0u; cnt = 0u; mine = 0u;
#pragma unroll
        for (unsigned j = 0; j < 16; ++j) { const unsigned c = xb_ld(&bar[XB_XCNT(j)]); sum += c; cnt += (c > 0u) ? 1u : 0u; mine = (j == x) ? c : mine; }
        if (sum == G) break;
        __builtin_amdgcn_s_sleep(1);
        if ((++sp & 255u) == 0u) { if (xb_ld(&bar[XB_TMO])) break; if (sp > XB_SPIN_CAP) { atomicAdd(&bar[XB_TMO], 1u); break; } }
    }
    nloc = mine > 0u ? mine : 1u; nx = cnt > 0u ? cnt : 1u;
}
__device__ __forceinline__ void xcd_barrier(XcdBarrier& b) {
    asm volatile("s_waitcnt vmcnt(0)" ::: "memory");
    __syncthreads();
    unsigned nl_out = b.nloc, nx_out = b.nx;
    if (threadIdx.x == 0) {
        unsigned* bar = b.bar;
        __builtin_amdgcn_s_waitcnt(0);
        unsigned nloc = b.nloc, nx = b.nx;
        if (nloc == 0u) { xcd_barrier_complete(bar, b.x, nloc, nx); b.nloc = nloc; b.nx = nx; }
        nl_out = nloc; nx_out = nx;
        const unsigned old = xb_add(&bar[XB_XSUB(b.x)], 1u);
        const unsigned gen = old / nloc;
        if (old + 1u == (gen + 1u) * nloc) {
            __builtin_amdgcn_fence(__ATOMIC_RELEASE, "agent");
            asm volatile("s_waitcnt vmcnt(0)" ::: "memory");
            const unsigned og = xb_add(&bar[XB_TOP], 1u);
            const unsigned tg = og / nx;
            if (og + 1u == (tg + 1u) * nx) xb_add(&bar[XB_TOPGEN], 1u);
            else XB_SPIN(xb_ld(&bar[XB_TOPGEN]) == tg, bar);
            __builtin_amdgcn_fence(__ATOMIC_ACQUIRE, "agent");
            xb_add(&bar[XB_XGEN(b.x)], 1u);
            asm volatile("s_waitcnt vmcnt(0)" ::: "memory");
        } else {
            XB_SPIN(xb_ld(&bar[XB_XGEN(b.x)]) == gen, bar);
            __builtin_amdgcn_fence(__ATOMIC_ACQUIRE, "agent");
            asm volatile("s_waitcnt vmcnt(0)" ::: "memory");
        }
    }
    b.nloc = __builtin_amdgcn_readfirstlane(nl_out); b.nx = __builtin_amdgcn_readfirstlane(nx_out);
    __syncthreads();
}

typedef float cvt_f2_t __attribute__((ext_vector_type(2)));
typedef __bf16 cvt_b2_t __attribute__((ext_vector_type(2)));
__device__ __forceinline__ unsigned cvt_pk_bf16(float lo, float hi) { const cvt_f2_t v = {lo, hi}; const cvt_b2_t r = __builtin_convertvector(v, cvt_b2_t); return __builtin_bit_cast(unsigned, r); }
__device__ __forceinline__ float bf2f(bf16_t v) { return __uint_as_float((unsigned)v << 16); }
__device__ __forceinline__ bf16_t f2bf(float v) { return (bf16_t)(cvt_pk_bf16(v, 0.f) & 0xffffu); }
__device__ __forceinline__ float bf_lo(unsigned w) { return __uint_as_float(w << 16); }
__device__ __forceinline__ float bf_hi(unsigned w) { return __uint_as_float(w & 0xffff0000u); }
template <int CTRL> __device__ __forceinline__ float dpp_mov(float v) { return __builtin_bit_cast(float, __builtin_amdgcn_update_dpp(0, __builtin_bit_cast(int, v), CTRL, 0xF, 0xF, true)); }
__device__ __forceinline__ float wave_sum16(const float (&p)[16], const int lane) {
    float q8[8], q4[4], q2[2];
    const bool b3 = (lane & 8) != 0, b2 = (lane & 4) != 0, b1 = (lane & 2) != 0, b0 = (lane & 1) != 0;
#pragma unroll
    for (int j = 0; j < 8; ++j) { const float keep = b3 ? p[j + 8] : p[j], send = b3 ? p[j] : p[j + 8]; q8[j] = keep + dpp_mov<0x128>(send); }
#pragma unroll
    for (int j = 0; j < 4; ++j) { const float keep = b2 ? q8[j + 4] : q8[j], send = b2 ? q8[j] : q8[j + 4]; q4[j] = keep + dpp_mov<0x141>(send); }
#pragma unroll
    for (int j = 0; j < 2; ++j) { const float keep = b1 ? q4[j + 2] : q4[j], send = b1 ? q4[j] : q4[j + 2]; q2[j] = keep + dpp_mov<0x4E>(send); }
    float t = (b0 ? q2[1] : q2[0]) + dpp_mov<0xB1>(b0 ? q2[0] : q2[1]);
    t += __shfl_xor(t, 16);
    t += __shfl_xor(t, 32);
    return t;
}
__device__ __forceinline__ float wave_sum(float v) {
    v += dpp_mov<0xB1>(v);
    v += dpp_mov<0x4E>(v);
    v += dpp_mov<0x141>(v);
    v += dpp_mov<0x140>(v);
    const int vi = __builtin_bit_cast(int, v);
    const float r0 = __builtin_bit_cast(float, __builtin_amdgcn_readlane(vi, 0)), r1 = __builtin_bit_cast(float, __builtin_amdgcn_readlane(vi, 16)), r2 = __builtin_bit_cast(float, __builtin_amdgcn_readlane(vi, 32)), r3 = __builtin_bit_cast(float, __builtin_amdgcn_readlane(vi, 48));
    return (r0 + r1) + (r2 + r3);
}
__device__ __forceinline__ float fast_exp2(float x) { return __builtin_amdgcn_exp2f(x); }
__device__ __forceinline__ float silu_f(float v) { return v / (1.0f + __expf(-v)); }
#define VM_WAIT0() asm volatile("s_waitcnt vmcnt(0)" ::: "memory")
#define LAUNDER_S(x) asm volatile("" : "+s"(x))
#define GLDS16S(sbase, voff, m0v) asm volatile("s_mov_b32 m0, %2\n\ts_nop 0\n\tglobal_load_lds_dwordx4 %0, %1\n\ts_nop 1" :: "v"(voff), "s"(sbase), "s"(m0v) : "memory")

struct Params {
    const float* in[26];
    float* out;
    unsigned char* ws;
    int ph_lo, ph_hi;
};
enum { I_X = 0, I_C, I_CTX, I_CCTX, I_ADAW, I_ADAB, I_N1G, I_N2G, I_WIN, I_FNETW, I_CQG, I_CKVG, I_WUQ, I_WUK, I_WUV, I_MQG, I_MKG, I_SQG, I_SKG, I_SINK, I_WOUT, I_RW, I_RB, I_EG, I_EU, I_ED };

struct GemmDesc {
    const bf16_t* A; const bf16_t* B;
    long lda, ldb;
    int K;
    const int* aidx; int aidx_stride;
    int mvalid;
};

#define VM_WAITN(n) asm volatile("s_waitcnt vmcnt(" #n ")" ::: "memory")
#define RING_STEP(J, WAITN, ISSUE) do { VM_WAITN(WAITN); __syncthreads(); if (ISSUE) RING_STAGE(t + (J) + 3, ((J) + 3) & 3); RING_COMPUTE(J); } while (0)
#define RING_LOOP() do { \
    RING_STAGE(0, 0); RING_STAGE(1, 1); RING_STAGE(2, 2); \
    int t = 0; \
    for (; t + 4 < nt; t += 4) { RING_STEP(0, 8, true); RING_STEP(1, 8, true); RING_STEP(2, 8, true); RING_STEP(3, 8, true); } \
    RING_STEP(0, 8, true); RING_STEP(1, 8, false); RING_STEP(2, 4, false); RING_STEP(3, 0, false); \
    __syncthreads(); } while (0)

__device__ __forceinline__ void gemm_core_ring(const GemmDesc& d, f32x4 (&acc)[4][4], LAS unsigned char* lds, const int tid) {
    const int lane = tid & 63, wid = tid >> 6, wr = wid >> 1, wc = wid & 1, fr = lane & 15, fq = lane >> 4;
    const int srow = tid >> 2;
    const int schunk = (tid & 3) ^ ((0x78 >> (2 * ((tid >> 4) & 3))) & 3);
    unsigned oa[2], ob[2];
#pragma unroll
    for (int i = 0; i < 2; ++i) {
        const int r = i * 64 + srow;
        long ar;
        if (d.aidx) { const int rr = r < d.mvalid ? r : 0; ar = (long)(d.aidx[(long)rr * d.aidx_stride] >> 1); } else ar = r;
        oa[i] = (unsigned)((ar * d.lda + schunk * 8) * 2);
        ob[i] = (unsigned)(((long)r * d.ldb + schunk * 8) * 2);
    }
    const int nt = d.K >> 5;
#pragma unroll
    for (int mb = 0; mb < 4; ++mb)
#pragma unroll
        for (int nb = 0; nb < 4; ++nb) acc[mb][nb] = (f32x4){0.f, 0.f, 0.f, 0.f};
    const int ph = fq ^ ((0x78 >> (2 * ((fr >> 2) & 3))) & 3);
    const int aoff = (wr * 64 + fr) * 64 + (ph << 4), boff = 8192 + (wc * 64 + fr) * 64 + (ph << 4);
    const unsigned m0b = __builtin_amdgcn_readfirstlane((unsigned)(size_t)(lds + tid * 16));
#define RING_STAGE(t_, S) do { const bf16_t* sa_ = d.A + (long)(t_) * 32; const bf16_t* sb_ = d.B + (long)(t_) * 32; _Pragma("unroll") for (int i = 0; i < 2; ++i) { \
        GLDS16S(sa_, oa[i], m0b + (S) * 16384 + i * 4096); GLDS16S(sb_, ob[i], m0b + (S) * 16384 + 8192 + i * 4096); } } while (0)
#define RING_COMPUTE(S) do { bf16x8 af[4], bfr[4]; \
        _Pragma("unroll") for (int mb = 0; mb < 4; ++mb) af[mb] = *(LAS bf16x8*)(lds + (S) * 16384 + aoff + mb * 1024); \
        _Pragma("unroll") for (int nb = 0; nb < 4; ++nb) bfr[nb] = *(LAS bf16x8*)(lds + (S) * 16384 + boff + nb * 1024); \
        _Pragma("unroll") for (int mb = 0; mb < 4; ++mb) _Pragma("unroll") for (int nb = 0; nb < 4; ++nb) \
            acc[mb][nb] = __builtin_amdgcn_mfma_f32_16x16x32_bf16(bfr[nb], af[mb], acc[mb][nb], 0, 0, 0); } while (0)
    RING_LOOP();
#undef RING_STAGE
#undef RING_COMPUTE
}


__device__ __forceinline__ unsigned cvt4_fp8(float a, float b, float c, float d) {
    unsigned v;
    asm("s_nop 0\n\tv_cvt_pk_fp8_f32 %0, %1, %2" : "=v"(v) : "v"(a), "v"(b));
    asm("v_cvt_pk_fp8_f32 %0, %1, %2 op_sel:[0,0,1]\n\ts_nop 0" : "+v"(v) : "v"(c), "v"(d));
    return v;
}
constexpr float W8_SCALE = 64.0f;
constexpr float ACT8_SCALE = 8.0f;
constexpr float OUT8_SCALE = 8.0f;

struct GemmDesc8 {
    const unsigned char* A; const unsigned char* B;
    long lda, ldb;
    int K;
    const int* aidx; int aidx_stride;
    int mvalid;
};
__device__ __forceinline__ void gemm_core8_ring(const GemmDesc8& d, f32x4 (&acc)[4][4], LAS unsigned char* lds, const int tid) {
    const int lane = tid & 63, wid = tid >> 6, wr = wid >> 1, wc = wid & 1, fr = lane & 15, fq = lane >> 4;
    const int srow = tid >> 2;
    const int schunk = (tid & 3) ^ ((0x78 >> (2 * ((tid >> 4) & 3))) & 3);
    unsigned oa[2], ob[2];
#pragma unroll
    for (int i = 0; i < 2; ++i) {
        const int r = i * 64 + srow;
        long ar;
        if (d.aidx) { const int rr = r < d.mvalid ? r : 0; ar = (long)(d.aidx[(long)rr * d.aidx_stride] >> 1); } else ar = r;
        oa[i] = (unsigned)(ar * d.lda + schunk * 16);
        ob[i] = (unsigned)((long)r * d.ldb + schunk * 16);
    }
    const int nt = d.K >> 6;
#pragma unroll
    for (int mb = 0; mb < 4; ++mb)
#pragma unroll
        for (int nb = 0; nb < 4; ++nb) acc[mb][nb] = (f32x4){0.f, 0.f, 0.f, 0.f};
    const int ph = fq ^ ((0x78 >> (2 * ((fr >> 2) & 3))) & 3);
    const int aoff = (wr * 64 + fr) * 64 + (ph << 4), boff = 8192 + (wc * 64 + fr) * 64 + (ph << 4);
    const unsigned m0b = __builtin_amdgcn_readfirstlane((unsigned)(size_t)(lds + tid * 16));
    typedef long l2 __attribute__((ext_vector_type(2)));
#define RING_STAGE(t_, S) do { const unsigned char* sa_ = d.A + (long)(t_) * 64; const unsigned char* sb_ = d.B + (long)(t_) * 64; _Pragma("unroll") for (int i = 0; i < 2; ++i) { \
        GLDS16S(sa_, oa[i], m0b + (S) * 16384 + i * 4096); GLDS16S(sb_, ob[i], m0b + (S) * 16384 + 8192 + i * 4096); } } while (0)
#define RING_COMPUTE(S) do { l2 af[4], bfr[4]; \
        _Pragma("unroll") for (int mb = 0; mb < 4; ++mb) af[mb] = *(LAS l2*)(lds + (S) * 16384 + aoff + mb * 1024); \
        _Pragma("unroll") for (int nb = 0; nb < 4; ++nb) bfr[nb] = *(LAS l2*)(lds + (S) * 16384 + boff + nb * 1024); \
        _Pragma("unroll") for (int mb = 0; mb < 4; ++mb) _Pragma("unroll") for (int nb = 0; nb < 4; ++nb) { \
            acc[mb][nb] = __builtin_amdgcn_mfma_f32_16x16x32_fp8_fp8(bfr[nb].x, af[mb].x, acc[mb][nb], 0, 0, 0); \
            acc[mb][nb] = __builtin_amdgcn_mfma_f32_16x16x32_fp8_fp8(bfr[nb].y, af[mb].y, acc[mb][nb], 0, 0, 0); } } while (0)
    RING_LOOP();
#undef RING_STAGE
#undef RING_COMPUTE
}

__device__ __forceinline__ void gemm_core_db(const GemmDesc& d, f32x4 (&acc)[4][4], LAS unsigned char* lds, const int tid) {
    const int lane = tid & 63, wid = tid >> 6, wr = wid >> 1, wc = wid & 1, fr = lane & 15, fq = lane >> 4;
    const int srow = tid >> 3;
    const int schunk = (tid & 7) ^ ((tid >> 4) & 7);
    unsigned oa[4], ob[4];
#pragma unroll
    for (int i = 0; i < 4; ++i) {
        const int r = i * 32 + srow;
        long ar;
        if (d.aidx) { const int rr = r < d.mvalid ? r : 0; ar = (long)(d.aidx[(long)rr * d.aidx_stride] >> 1); } else ar = r;
        oa[i] = (unsigned)((ar * d.lda + schunk * 8) * 2);
        ob[i] = (unsigned)(((long)r * d.ldb + schunk * 8) * 2);
    }
    const int nt = d.K >> 6;
#pragma unroll
    for (int mb = 0; mb < 4; ++mb)
#pragma unroll
        for (int nb = 0; nb < 4; ++nb) acc[mb][nb] = (f32x4){0.f, 0.f, 0.f, 0.f};
    const int swz = (fr >> 1) & 7;
    const int aoff = (wr * 64 + fr) * 128, boff = 16384 + (wc * 64 + fr) * 128;
    const unsigned m0b = __builtin_amdgcn_readfirstlane((unsigned)(size_t)(lds + tid * 16));
#define GEMM_STAGE(t_, BUF) do { const bf16_t* sa_ = d.A + (long)(t_) * 64; const bf16_t* sb_ = d.B + (long)(t_) * 64; _Pragma("unroll") for (int i = 0; i < 4; ++i) { \
        GLDS16S(sa_, oa[i], m0b + (BUF) * 32768 + i * 4096); GLDS16S(sb_, ob[i], m0b + (BUF) * 32768 + 16384 + i * 4096); } } while (0)
#define GEMM_COMPUTE(BUF) do { _Pragma("unroll") for (int ks = 0; ks < 2; ++ks) { bf16x8 af[4], bfr[4]; const int co = ((ks * 4 + fq) ^ swz) << 4; \
        _Pragma("unroll") for (int mb = 0; mb < 4; ++mb) af[mb] = *(LAS bf16x8*)(lds + (BUF) * 32768 + aoff + mb * 2048 + co); \
        _Pragma("unroll") for (int nb = 0; nb < 4; ++nb) bfr[nb] = *(LAS bf16x8*)(lds + (BUF) * 32768 + boff + nb * 2048 + co); \
        _Pragma("unroll") for (int mb = 0; mb < 4; ++mb) _Pragma("unroll") for (int nb = 0; nb < 4; ++nb) \
            acc[mb][nb] = __builtin_amdgcn_mfma_f32_16x16x32_bf16(bfr[nb], af[mb], acc[mb][nb], 0, 0, 0); } } while (0)
    GEMM_STAGE(0, 0);
    VM_WAIT0(); __syncthreads();
    for (int t = 0; t < nt; t += 2) {
        GEMM_STAGE(t + 1, 1);
        GEMM_COMPUTE(0);
        VM_WAIT0(); __syncthreads();
        if (t + 2 < nt) GEMM_STAGE(t + 2, 0);
        GEMM_COMPUTE(1);
        VM_WAIT0(); __syncthreads();
    }
#undef GEMM_STAGE
#undef GEMM_COMPUTE
}


typedef int i32x8_t __attribute__((ext_vector_type(8)));
typedef int i32x4_t __attribute__((ext_vector_type(4)));
template <int K128>
__device__ __forceinline__ void gemm_core8_db(const GemmDesc8& d, f32x4 (&acc)[4][4], LAS unsigned char* lds, const int tid) {
    const int lane = tid & 63, wid = tid >> 6, wr = wid >> 1, wc = wid & 1, fr = lane & 15, fq = lane >> 4;
    const int srow = tid >> 3;
    const int schunk = (tid & 7) ^ ((tid >> 4) & 7);
    unsigned oa[4], ob[4];
#pragma unroll
    for (int i = 0; i < 4; ++i) {
        const int r = i * 32 + srow;
        long ar;
        if (d.aidx) { const int rr = r < d.mvalid ? r : 0; ar = (long)(d.aidx[(long)rr * d.aidx_stride] >> 1); } else ar = r;
        oa[i] = (unsigned)(ar * d.lda + schunk * 16);
        ob[i] = (unsigned)((long)r * d.ldb + schunk * 16);
    }
    int nt = d.K >> 7;
    asm volatile("" : "+s"(nt));
#pragma unroll
    for (int mb = 0; mb < 4; ++mb)
#pragma unroll
        for (int nb = 0; nb < 4; ++nb) acc[mb][nb] = (f32x4){0.f, 0.f, 0.f, 0.f};
    const int swz = (fr >> 1) & 7;
    const int aoff = (wr * 64 + fr) * 128, boff = 16384 + (wc * 64 + fr) * 128;
    const unsigned m0b = __builtin_amdgcn_readfirstlane((unsigned)(size_t)(lds + tid * 16));
    typedef long l2 __attribute__((ext_vector_type(2)));
#define GEMM8_STAGE(t_, BUF) do { const unsigned char* sa_ = d.A + (long)(t_) * 128; const unsigned char* sb_ = d.B + (long)(t_) * 128; _Pragma("unroll") for (int i = 0; i < 4; ++i) { \
        GLDS16S(sa_, oa[i], m0b + (BUF) * 32768 + i * 4096); GLDS16S(sb_, ob[i], m0b + (BUF) * 32768 + 16384 + i * 4096); } } while (0)
#define GEMM8_COMPUTE_OLD(BUF) do { _Pragma("unroll") for (int ks = 0; ks < 2; ++ks) { l2 af[4], bfr[4]; const int co = ((ks * 4 + fq) ^ swz) << 4; \
        _Pragma("unroll") for (int mb = 0; mb < 4; ++mb) af[mb] = *(LAS l2*)(lds + (BUF) * 32768 + aoff + mb * 2048 + co); \
        _Pragma("unroll") for (int nb = 0; nb < 4; ++nb) bfr[nb] = *(LAS l2*)(lds + (BUF) * 32768 + boff + nb * 2048 + co); \
        _Pragma("unroll") for (int mb = 0; mb < 4; ++mb) _Pragma("unroll") for (int nb = 0; nb < 4; ++nb) { \
            acc[mb][nb] = __builtin_amdgcn_mfma_f32_16x16x32_fp8_fp8(bfr[nb].x, af[mb].x, acc[mb][nb], 0, 0, 0); \
            acc[mb][nb] = __builtin_amdgcn_mfma_f32_16x16x32_fp8_fp8(bfr[nb].y, af[mb].y, acc[mb][nb], 0, 0, 0); } } } while (0)
#define GEMM8_COMPUTE_NEW(BUF) do { i32x8_t bfr[4]; const int c0 = ((2 * fq) ^ swz) << 4, c1 = ((2 * fq + 1) ^ swz) << 4; \
        _Pragma("unroll") for (int nb = 0; nb < 4; ++nb) { const i32x4_t lo = *(LAS i32x4_t*)(lds + (BUF) * 32768 + boff + nb * 2048 + c0), hi = *(LAS i32x4_t*)(lds + (BUF) * 32768 + boff + nb * 2048 + c1); \
            bfr[nb] = (i32x8_t){lo.x, lo.y, lo.z, lo.w, hi.x, hi.y, hi.z, hi.w}; } \
        _Pragma("unroll") for (int mb = 0; mb < 4; ++mb) { const i32x4_t lo = *(LAS i32x4_t*)(lds + (BUF) * 32768 + aoff + mb * 2048 + c0), hi = *(LAS i32x4_t*)(lds + (BUF) * 32768 + aoff + mb * 2048 + c1); \
            const i32x8_t af = (i32x8_t){lo.x, lo.y, lo.z, lo.w, hi.x, hi.y, hi.z, hi.w}; \
            _Pragma("unroll") for (int nb = 0; nb < 4; ++nb) \
                acc[mb][nb] = __builtin_amdgcn_mfma_scale_f32_16x16x128_f8f6f4(bfr[nb], af, acc[mb][nb], 0, 0, 0, 0x7F7F7F7F, 0, 0x7F7F7F7F); } } while (0)
#define GEMM8_COMPUTE_NEW2(BUF) do { const int c0 = ((2 * fq) ^ swz) << 4, c1 = ((2 * fq + 1) ^ swz) << 4; \
        _Pragma("unroll") for (int nh = 0; nh < 2; ++nh) { i32x8_t bfr[2]; \
            _Pragma("unroll") for (int nb = 0; nb < 2; ++nb) { const i32x4_t lo = *(LAS i32x4_t*)(lds + (BUF) * 32768 + boff + (nh * 2 + nb) * 2048 + c0), hi = *(LAS i32x4_t*)(lds + (BUF) * 32768 + boff + (nh * 2 + nb) * 2048 + c1); \
                bfr[nb] = (i32x8_t){lo.x, lo.y, lo.z, lo.w, hi.x, hi.y, hi.z, hi.w}; } \
            _Pragma("unroll") for (int mb = 0; mb < 4; ++mb) { const i32x4_t lo = *(LAS i32x4_t*)(lds + (BUF) * 32768 + aoff + mb * 2048 + c0), hi = *(LAS i32x4_t*)(lds + (BUF) * 32768 + aoff + mb * 2048 + c1); \
                const i32x8_t af = (i32x8_t){lo.x, lo.y, lo.z, lo.w, hi.x, hi.y, hi.z, hi.w}; \
                _Pragma("unroll") for (int nb = 0; nb < 2; ++nb) \
                    acc[mb][nh * 2 + nb] = __builtin_amdgcn_mfma_scale_f32_16x16x128_f8f6f4(bfr[nb], af, acc[mb][nh * 2 + nb], 0, 0, 0, 0x7F7F7F7F, 0, 0x7F7F7F7F); } } } while (0)
#define GEMM8_COMPUTE(BUF) do { if (K128 == 1) GEMM8_COMPUTE_NEW(BUF); else if (K128 == 2) GEMM8_COMPUTE_NEW2(BUF); else GEMM8_COMPUTE_OLD(BUF); } while (0)
    GEMM8_STAGE(0, 0);
    VM_WAIT0(); __syncthreads();
    for (int t = 0; t < nt; t += 2) {
        GEMM8_STAGE(t + 1, 1);
        GEMM8_COMPUTE(0);
        VM_WAIT0(); __syncthreads();
        if (t + 2 < nt) GEMM8_STAGE(t + 2, 0);
        GEMM8_COMPUTE(1);
        VM_WAIT0(); __syncthreads();
    }
#undef GEMM8_STAGE
#undef GEMM8_COMPUTE
}


__device__ __forceinline__ void gemm_core8_a3(const GemmDesc8& d, f32x4 (&acc)[4][4], LAS unsigned char* lds, const int tid) {
    const int lane = tid & 63, wid = tid >> 6, wr = wid >> 1, wc = wid & 1, fr = lane & 15, fq = lane >> 4;
    const int srow = tid >> 3;
    const int schunk = (tid & 7) ^ ((tid >> 4) & 7);
    unsigned oa[4], ob[4];
#pragma unroll
    for (int i = 0; i < 4; ++i) {
        const int r = i * 32 + srow;
        long ar;
        if (d.aidx) { const int rr = r < d.mvalid ? r : 0; ar = (long)(d.aidx[(long)rr * d.aidx_stride] >> 1); } else ar = r;
        oa[i] = (unsigned)(ar * d.lda + schunk * 16);
        ob[i] = (unsigned)((long)r * d.ldb + schunk * 16);
    }
    int nt = d.K >> 7;
    asm volatile("" : "+s"(nt));
#pragma unroll
    for (int mb = 0; mb < 4; ++mb)
#pragma unroll
        for (int nb = 0; nb < 4; ++nb) acc[mb][nb] = (f32x4){0.f, 0.f, 0.f, 0.f};
    const int swz = (fr >> 1) & 7;
    const int aoff = (wr * 64 + fr) * 128, boff = 49152 + (wc * 64 + fr) * 128;
    const int c0 = ((2 * fq) ^ swz) << 4, c1 = ((2 * fq + 1) ^ swz) << 4;
    const unsigned m0b = __builtin_amdgcn_readfirstlane((unsigned)(size_t)(lds + tid * 16));
    __builtin_amdgcn_s_waitcnt(0x0F70);
#define A3_STAGE_A(t_, SA) do { const unsigned char* sa_ = d.A + (long)(t_) * 128; _Pragma("unroll") for (int i = 0; i < 4; ++i) GLDS16S(sa_, oa[i], m0b + (SA) * 16384 + i * 4096); } while (0)
#define A3_STAGE_B(t_, SB) do { const unsigned char* sb_ = d.B + (long)(t_) * 128; _Pragma("unroll") for (int i = 0; i < 4; ++i) GLDS16S(sb_, ob[i], m0b + 49152 + (SB) * 16384 + i * 4096); } while (0)
#define A3_COMPUTE(SA, SB) do { i32x8_t bfr[4]; \
        _Pragma("unroll") for (int nb = 0; nb < 4; ++nb) { const i32x4_t lo = *(LAS i32x4_t*)(lds + (SB) * 16384 + boff + nb * 2048 + c0), hi = *(LAS i32x4_t*)(lds + (SB) * 16384 + boff + nb * 2048 + c1); \
            bfr[nb] = (i32x8_t){lo.x, lo.y, lo.z, lo.w, hi.x, hi.y, hi.z, hi.w}; } \
        _Pragma("unroll") for (int mb = 0; mb < 4; ++mb) { const i32x4_t lo = *(LAS i32x4_t*)(lds + (SA) * 16384 + aoff + mb * 2048 + c0), hi = *(LAS i32x4_t*)(lds + (SA) * 16384 + aoff + mb * 2048 + c1); \
            const i32x8_t af = (i32x8_t){lo.x, lo.y, lo.z, lo.w, hi.x, hi.y, hi.z, hi.w}; \
            _Pragma("unroll") for (int nb = 0; nb < 4; ++nb) \
                acc[mb][nb] = __builtin_amdgcn_mfma_scale_f32_16x16x128_f8f6f4(bfr[nb], af, acc[mb][nb], 0, 0, 0, 0x7F7F7F7F, 0, 0x7F7F7F7F); } } while (0)
#define A3_STEP(P_) do { const int tt_ = t + (P_); if (tt_ < nt) { \
        if (tt_ + 1 < nt) VM_WAITN(4); else VM_WAITN(0); \
        __syncthreads(); \
        if (tt_ + 1 < nt) A3_STAGE_B(tt_ + 1, ((P_) + 1) % 2); \
        if (tt_ + 2 < nt) A3_STAGE_A(tt_ + 2, ((P_) + 2) % 3); \
        A3_COMPUTE((P_) % 3, (P_) % 2); } } while (0)
    A3_STAGE_A(0, 0); A3_STAGE_B(0, 0); if (nt > 1) A3_STAGE_A(1, 1);
    for (int t = 0; t < nt; t += 6) { A3_STEP(0); A3_STEP(1); A3_STEP(2); A3_STEP(3); A3_STEP(4); A3_STEP(5); }
    __syncthreads();
#undef A3_STAGE_A
#undef A3_STAGE_B
#undef A3_COMPUTE
#undef A3_STEP
}

__device__ __forceinline__ void gemm_core8_b3(const GemmDesc8& d, f32x4 (&acc)[4][4], LAS unsigned char* lds, const int tid) {
    const int lane = tid & 63, wid = tid >> 6, wr = wid >> 1, wc = wid & 1, fr = lane & 15, fq = lane >> 4;
    const int srow = tid >> 3;
    const int schunk = (tid & 7) ^ ((tid >> 4) & 7);
    unsigned oa[4], ob[4];
#pragma unroll
    for (int i = 0; i < 4; ++i) {
        const int r = i * 32 + srow;
        long ar;
        if (d.aidx) { const int rr = r < d.mvalid ? r : 0; ar = (long)(d.aidx[(long)rr * d.aidx_stride] >> 1); } else ar = r;
        oa[i] = (unsigned)(ar * d.lda + schunk * 16);
        ob[i] = (unsigned)((long)r * d.ldb + schunk * 16);
    }
    int nt = d.K >> 7;
    asm volatile("" : "+s"(nt));
#pragma unroll
    for (int mb = 0; mb < 4; ++mb)
#pragma unroll
        for (int nb = 0; nb < 4; ++nb) acc[mb][nb] = (f32x4){0.f, 0.f, 0.f, 0.f};
    const int swz = (fr >> 1) & 7;
    const int aoff = 49152 + (wr * 64 + fr) * 128, boff = (wc * 64 + fr) * 128;
    const int c0 = ((2 * fq) ^ swz) << 4, c1 = ((2 * fq + 1) ^ swz) << 4;
    const unsigned m0b = __builtin_amdgcn_readfirstlane((unsigned)(size_t)(lds + tid * 16));
    __builtin_amdgcn_s_waitcnt(0x0F70);
#define A3_STAGE_A(t_, SA) do { const unsigned char* sa_ = d.A + (long)(t_) * 128; _Pragma("unroll") for (int i = 0; i < 4; ++i) GLDS16S(sa_, oa[i], m0b + 49152 + (SA) * 16384 + i * 4096); } while (0)
#define A3_STAGE_B(t_, SB) do { const unsigned char* sb_ = d.B + (long)(t_) * 128; _Pragma("unroll") for (int i = 0; i < 4; ++i) GLDS16S(sb_, ob[i], m0b + (SB) * 16384 + i * 4096); } while (0)
#define A3_COMPUTE(SA, SB) do { i32x8_t bfr[4]; \
        _Pragma("unroll") for (int nb = 0; nb < 4; ++nb) { const i32x4_t lo = *(LAS i32x4_t*)(lds + (SB) * 16384 + boff + nb * 2048 + c0), hi = *(LAS i32x4_t*)(lds + (SB) * 16384 + boff + nb * 2048 + c1); \
            bfr[nb] = (i32x8_t){lo.x, lo.y, lo.z, lo.w, hi.x, hi.y, hi.z, hi.w}; } \
        _Pragma("unroll") for (int mb = 0; mb < 4; ++mb) { const i32x4_t lo = *(LAS i32x4_t*)(lds + (SA) * 16384 + aoff + mb * 2048 + c0), hi = *(LAS i32x4_t*)(lds + (SA) * 16384 + aoff + mb * 2048 + c1); \
            const i32x8_t af = (i32x8_t){lo.x, lo.y, lo.z, lo.w, hi.x, hi.y, hi.z, hi.w}; \
            _Pragma("unroll") for (int nb = 0; nb < 4; ++nb) \
                acc[mb][nb] = __builtin_amdgcn_mfma_scale_f32_16x16x128_f8f6f4(bfr[nb], af, acc[mb][nb], 0, 0, 0, 0x7F7F7F7F, 0, 0x7F7F7F7F); } } while (0)
#define A3_STEP(P_) do { const int tt_ = t + (P_); if (tt_ < nt) { \
        if (tt_ + 1 < nt) VM_WAITN(4); else VM_WAITN(0); \
        __syncthreads(); \
        if (tt_ + 1 < nt) A3_STAGE_A(tt_ + 1, ((P_) + 1) % 2); \
        if (tt_ + 2 < nt) A3_STAGE_B(tt_ + 2, ((P_) + 2) % 3); \
        A3_COMPUTE((P_) % 2, (P_) % 3); } } while (0)
    A3_STAGE_B(0, 0); A3_STAGE_A(0, 0); if (nt > 1) A3_STAGE_B(1, 1);
    for (int t = 0; t < nt; t += 6) { A3_STEP(0); A3_STEP(1); A3_STEP(2); A3_STEP(3); A3_STEP(4); A3_STEP(5); }
    __syncthreads();
#undef A3_STAGE_A
#undef A3_STAGE_B
#undef A3_COMPUTE
#undef A3_STEP
}

#ifndef A3_SITES
#define A3_SITES 0x23
#endif
#ifndef K128_SITES
#define K128_SITES 0xe3
#endif
#ifndef RING_SITES
#define RING_SITES 0x00
#endif
#define GEMM_SEL(site, g_, acc_) do { if ((RING_SITES >> (site)) & 1) gemm_core_ring(g_, acc_, lds, tid); else gemm_core_db(g_, acc_, lds, tid); } while (0)
#ifndef B3_SITES
#define B3_SITES 0xc0
#endif
#define GEMM8_SEL(site, g_, acc_) do { if ((A3_SITES >> (site)) & 1) gemm_core8_a3(g_, acc_, lds, tid); else if ((B3_SITES >> (site)) & 1) gemm_core8_b3(g_, acc_, lds, tid); else if ((RING_SITES >> (site)) & 1) gemm_core8_ring(g_, acc_, lds, tid); else gemm_core8_db<(((K128_SITES >> (site)) & 1) != 0) ? 1 : 0>(g_, acc_, lds, tid); } while (0)

template <int DQK, bool MASK>
__device__ __forceinline__ void attn_unit(const bf16_t* Qp, int ldq, const bf16_t* Kp, int ldk, const bf16_t* VTp,
                                          int seg0_tok, int seg0_tiles, int seg1_tok, int seg1_tiles,
                                          int qpos0, int seg0_pos, float sink2, bool has_sink, unsigned char* Op, LAS unsigned char* lds, const int tid,
                                          const float* qgain, const float2* qrope, int qrope_pos0, float qscale) {
    constexpr int NKS = DQK / 16;
    const int lane = tid & 63, wid = tid >> 6, lq = lane & 31, h = lane >> 5;
    bf16x8 qf[NKS];
    {
        const bf16_t* qrow = Qp + (long)(wid * 32 + lq) * ldq + 8 * h;
        float ss = 0.f;
#pragma unroll
        for (int ks = 0; ks < NKS; ++ks) {
            const u32x4 a = *(const u32x4*)(qrow + ks * 16);
            const float e0 = bf_lo(a.x), e1 = bf_hi(a.x), e2 = bf_lo(a.y), e3 = bf_hi(a.y), e4 = bf_lo(a.z), e5 = bf_hi(a.z), e6 = bf_lo(a.w), e7 = bf_hi(a.w);
            ss += (e0 * e0 + e1 * e1) + (e2 * e2 + e3 * e3) + (e4 * e4 + e5 * e5) + (e6 * e6 + e7 * e7);
        }
        ss += __shfl_xor(ss, 32);
        const float rs = rsqrtf(ss * (1.0f / DQK) + EPS) ;
        const int pos = qrope_pos0 + wid * 32 + lq;
#define QLOAD(ks_, x_) do { const u32x4 a_ = *(const u32x4*)(qrow + (ks_) * 16); const f32x4 g0_ = *(const f32x4*)(qgain + (ks_) * 16 + 8 * h), g1_ = *(const f32x4*)(qgain + (ks_) * 16 + 8 * h + 4); \
            x_[0] = bf_lo(a_.x) * rs * g0_[0]; x_[1] = bf_hi(a_.x) * rs * g0_[1]; x_[2] = bf_lo(a_.y) * rs * g0_[2]; x_[3] = bf_hi(a_.y) * rs * g0_[3]; \
            x_[4] = bf_lo(a_.z) * rs * g1_[0]; x_[5] = bf_hi(a_.z) * rs * g1_[1]; x_[6] = bf_lo(a_.w) * rs * g1_[2]; x_[7] = bf_hi(a_.w) * rs * g1_[3]; } while (0)
#define QPACK(ks_, x_) do { union { u32x4 u; bf16x8 v; } pk_; \
            pk_.u.x = cvt_pk_bf16(x_[0] * qscale, x_[1] * qscale); pk_.u.y = cvt_pk_bf16(x_[2] * qscale, x_[3] * qscale); \
            pk_.u.z = cvt_pk_bf16(x_[4] * qscale, x_[5] * qscale); pk_.u.w = cvt_pk_bf16(x_[6] * qscale, x_[7] * qscale); qf[ks_] = pk_.v; } while (0)
        if (DQK == 96) {
#pragma unroll
            for (int ks = 0; ks < NKS; ++ks) {
                float x[8];
                QLOAD(ks, x);
                if (ks >= 4 && qrope) {
                    const float2* rp = qrope + pos * 16 + (ks - 4) * 8;
#pragma unroll
                    for (int j = 0; j < 8; ++j) { const float2 c = rp[j]; const float pj = __shfl_xor(x[j], 32); x[j] = x[j] * c.x + (h ? pj : -pj) * c.y; }
                }
                QPACK(ks, x);
            }
        } else {
#pragma unroll
            for (int kp = 0; kp < NKS; kp += 2) {
                float x0[8], x1[8];
                QLOAD(kp, x0); QLOAD(kp + 1, x1);
                if (qrope) {
                    const float2* rq = qrope + pos * 32 + h * 8 + (kp >= 2 ? 16 : 0);
#pragma unroll
                    for (int j = 0; j < 8; ++j) { const float2 c = rq[j]; const float a0 = x0[j], a1 = x1[j]; x0[j] = a0 * c.x - a1 * c.y; x1[j] = a1 * c.x + a0 * c.y; }
                }
                QPACK(kp, x0); QPACK(kp + 1, x1);
            }
        }
#undef QLOAD
#undef QPACK
    }
    __builtin_amdgcn_sched_barrier(0);
    f32x16 ot[2];
#pragma unroll
    for (int i = 0; i < 16; ++i) { ot[0][i] = 0.f; ot[1][i] = 0.f; }
    float m_run = -INFINITY, l_run = 0.f, m_ref = 0.f;
    union { u32x4 u; bf16x8 v; } kx, qx;
    kx.u = (u32x4){h == 0 ? 0x3F80u : 0u, 0u, 0u, 0u};
    qx.u = (u32x4){0u, 0u, 0u, 0u};
    const int n64 = 2 * (seg0_tiles + seg1_tiles);
    const int srow = tid >> 3, sch8 = (tid & 7) ^ ((tid >> 4) & 7);
    const int srow2 = tid >> 2, sch4 = (tid & 3) ^ ((tid >> 4) & 3);
    constexpr int NDMA = (DQK == 96) ? 5 : 4;

    const unsigned ok1 = (unsigned)((srow * ldk + sch8 * 8) * 2), ok2 = (unsigned)((srow2 * ldk + sch4 * 8) * 2), ov = (unsigned)((srow * T + sch8 * 8) * 2);
    const unsigned m0b = __builtin_amdgcn_readfirstlane((unsigned)(size_t)(lds + tid * 16));
    auto stage = [&](int j, int buf) {
        const int i = j >> 1;
        const long tok = (i < seg0_tiles ? (long)seg0_tok + i * 128 : (long)seg1_tok + (i - seg0_tiles) * 128) + (j & 1) * 64;
        const bf16_t* kb_ = Kp + tok * ldk; const bf16_t* vb_ = VTp + tok;
        const unsigned mb = m0b + buf * 20480;
#pragma unroll
        for (int it = 0; it < 2; ++it) {
            GLDS16S(kb_ + (long)(it * 32) * ldk, ok1, mb + it * 4096);
            GLDS16S(vb_ + (long)(it * 32) * T, ov, mb + 12288 + it * 4096);
        }
        if (DQK == 96) GLDS16S(kb_ + 64, ok2, mb + 8192);
    };
    const int qpos = qpos0 + wid * 32 + lq;
    const int lqp = (lq & 0x13) | ((lq & 4) << 1) | ((lq & 8) >> 1);
    const int kswz = (lqp >> 1) & 7, kswz2 = (lqp >> 2) & 3, vswz = (lq >> 1) & 7;

    __builtin_amdgcn_s_waitcnt(0x0F70);
    stage(0, 0);
    if (n64 > 1) stage(1, 1);
    auto step = [&](const int j, const int buf) __attribute__((always_inline)) {
        if (j + 1 < n64) { if (DQK == 96) VM_WAITN(5); else VM_WAITN(4); } else VM_WAITN(0);
        __syncthreads();
        if (j + 2 < n64) stage(j + 2, (buf + 2) % 3);
        bool active = true;
        if (MASK && (j >> 1) < seg0_tiles) {
            const int k0 = seg0_pos + j * 64, q0w = qpos0 + wid * 32;
            active = (k0 + 63 >= q0w - 128) && (k0 <= q0w + 31 + 128);
        }
        if (active) {
            LAS unsigned char* lb = lds + buf * 20480;
            f32x16 st[2];
#pragma unroll
            for (int r = 0; r < 16; ++r) { st[0][r] = 0.f; st[1][r] = 0.f; }
            {
                bf16x8 kf[4][2];
#pragma unroll
                for (int ks = 0; ks < 4; ++ks)
#pragma unroll
                    for (int kb = 0; kb < 2; ++kb) kf[ks][kb] = *(LAS bf16x8*)(lb + (kb * 32 + lqp) * 128 + (((ks * 2 + h) ^ kswz) << 4));
                __builtin_amdgcn_sched_barrier(0);
#pragma unroll
                for (int ks = 0; ks < 4; ++ks)
#pragma unroll
                    for (int kb = 0; kb < 2; ++kb) st[kb] = __builtin_amdgcn_mfma_f32_32x32x16_bf16(kf[ks][kb], qf[ks], st[kb], 0, 0, 0);
            }
            if (DQK == 96) {
                bf16x8 kf2[2][2];
#pragma unroll
                for (int ks = 4; ks < NKS; ++ks)
#pragma unroll
                    for (int kb = 0; kb < 2; ++kb) kf2[ks - 4][kb] = *(LAS bf16x8*)(lb + 8192 + (kb * 32 + lqp) * 64 + ((((ks - 4) * 2 + h) ^ kswz2) << 4));
                __builtin_amdgcn_sched_barrier(0);
#pragma unroll
                for (int ks = 4; ks < NKS; ++ks)
#pragma unroll
                    for (int kb = 0; kb < 2; ++kb) st[kb] = __builtin_amdgcn_mfma_f32_32x32x16_bf16(kf2[ks - 4][kb], qf[ks], st[kb], 0, 0, 0);
            }
#pragma unroll
            for (int kb = 0; kb < 2; ++kb) st[kb] = __builtin_amdgcn_mfma_f32_32x32x16_bf16(kx.v, qx.v, st[kb], 0, 0, 0);
            const int dwin = seg0_pos + j * 64 - (qpos0 + wid * 32);
            if (MASK && (j >> 1) < seg0_tiles && (dwin < -97 || dwin > 65)) {
                const int kbase = seg0_pos + j * 64 + 8 * h - qpos;
#pragma unroll
                for (int kb = 0; kb < 2; ++kb)
#pragma unroll
                    for (int r = 0; r < 16; ++r) {
                        const int dlt = kbase + kb * 32 + 16 * (r >> 3) + 4 * ((r >> 2) & 1) + (r & 3);
                        if (dlt > 128 || dlt < -128) st[kb][r] = -INFINITY;
                    }
            }
            float mx = st[0][0];
#pragma unroll
            for (int r = 1; r < 16; ++r) mx = fmaxf(mx, st[0][r]);
#pragma unroll
            for (int r = 0; r < 16; ++r) mx = fmaxf(mx, st[1][r]);
            mx = fmaxf(mx, __shfl_xor(mx, 32));
            const float m_new = fmaxf(m_run, mx + m_ref);
            const float dlt = m_new - m_ref;
            const bool need = (m_new != -INFINITY) && (dlt > 8.0f || dlt < -64.0f);
            if (__builtin_amdgcn_ballot_w64(need) != 0ull) {
                const float nref = (m_new == -INFINITY) ? m_ref : bf_lo(cvt_pk_bf16(m_new, 0.f));
                const float d = m_ref - nref;
                const float alpha = fast_exp2(d);
#pragma unroll
                for (int kb = 0; kb < 2; ++kb)
#pragma unroll
                    for (int r = 0; r < 16; ++r) st[kb][r] += d;
                l_run *= alpha;
#pragma unroll
                for (int r = 0; r < 16; ++r) { ot[0][r] *= alpha; ot[1][r] *= alpha; }
                m_ref = nref;
                qx.u.x = (h == 0) ? (cvt_pk_bf16(-nref, 0.f) & 0xffffu) : 0u;
            }
            float ls = 0.f;
#pragma unroll
            for (int kb = 0; kb < 2; ++kb)
#pragma unroll
                for (int r = 0; r < 16; ++r) { const float p = fast_exp2(st[kb][r]); st[kb][r] = p; ls += p; }
            l_run += ls;
            m_run = m_new;
#pragma unroll
            for (int s = 0; s < 4; ++s) {
                union { u32x4 u; bf16x8 v; } pf;
                const int kb = s >> 1, r0 = 8 * (s & 1);
                pf.u.x = cvt_pk_bf16(st[kb][r0 + 0], st[kb][r0 + 1]); pf.u.y = cvt_pk_bf16(st[kb][r0 + 2], st[kb][r0 + 3]);
                pf.u.z = cvt_pk_bf16(st[kb][r0 + 4], st[kb][r0 + 5]); pf.u.w = cvt_pk_bf16(st[kb][r0 + 6], st[kb][r0 + 7]);
#pragma unroll
                for (int db = 0; db < 2; ++db) {
                    const bf16x8 vf = *(LAS bf16x8*)(lb + 12288 + (db * 32 + lq) * 128 + (((2 * s + h) ^ vswz) << 4));
                    ot[db] = __builtin_amdgcn_mfma_f32_32x32x16_bf16(vf, pf.v, ot[db], 0, 0, 0);
                }
            }
        }
    };
    for (int j = 0; j < n64; j += 3) {
        step(j, 0);
        if (j + 1 < n64) step(j + 1, 1);
        if (j + 2 < n64) step(j + 2, 2);
    }
    __syncthreads();
    float l = l_run + __shfl_xor(l_run, 32);
    if (has_sink) l += fast_exp2(sink2 - m_ref);
    const float inv = OUT8_SCALE / l;
    unsigned char* orow = Op + (long)(wid * 32 + lq) * D + 4 * h;
#pragma unroll
    for (int db = 0; db < 2; ++db)
#pragma unroll
        for (int g = 0; g < 4; ++g)
            *(unsigned*)(orow + db * 32 + 8 * g) = cvt4_fp8(ot[db][4 * g] * inv, ot[db][4 * g + 1] * inv, ot[db][4 * g + 2] * inv, ot[db][4 * g + 3] * inv);
}

__device__ __forceinline__ int nmap(int mode, int n) {
    if (mode == 1) return n < 640 ? n : (n < 672 ? n + 640 : n - 32);
    if (mode == 2) return ((n >> 4) << 5) + (n & 15);
    if (mode == 3) return ((n >> 4) << 5) + 16 + (n & 15);
    return n;
}
__device__ __forceinline__ void conv_tile(const float* src, int K, int N, bf16_t* dst, int ldd, int mode, const float* kscale, int tk, int tn, LAS unsigned char* lds, const int tid) {
    (void)K; (void)lds;
    const int lane = tid & 63, w = tid >> 6;
    const int k0 = tk * 64 + w * 16, n = tn * 64 + lane;
    if (n < N) {
        float v[16];
        const float* sp = src + (long)k0 * N + n;
#pragma unroll
        for (int j = 0; j < 16; ++j) v[j] = sp[(long)j * N];
        if (kscale) {
#pragma unroll
            for (int j = 0; j < 16; ++j) v[j] *= kscale[k0 + j];
        }
        if (mode >= 8) {
            unsigned char* dp8 = (unsigned char*)dst + (long)nmap(mode & 7, n) * ldd + k0;
            u32x4 w8;
            w8.x = cvt4_fp8(v[0] * W8_SCALE, v[1] * W8_SCALE, v[2] * W8_SCALE, v[3] * W8_SCALE);
            w8.y = cvt4_fp8(v[4] * W8_SCALE, v[5] * W8_SCALE, v[6] * W8_SCALE, v[7] * W8_SCALE);
            w8.z = cvt4_fp8(v[8] * W8_SCALE, v[9] * W8_SCALE, v[10] * W8_SCALE, v[11] * W8_SCALE);
            w8.w = cvt4_fp8(v[12] * W8_SCALE, v[13] * W8_SCALE, v[14] * W8_SCALE, v[15] * W8_SCALE);
            *(u32x4*)dp8 = w8;
        } else {
            bf16_t* dp = dst + (long)nmap(mode, n) * ldd + k0;
            *(u32x4*)dp = (u32x4){cvt_pk_bf16(v[0], v[1]), cvt_pk_bf16(v[2], v[3]), cvt_pk_bf16(v[4], v[5]), cvt_pk_bf16(v[6], v[7])};
            *(u32x4*)(dp + 8) = (u32x4){cvt_pk_bf16(v[8], v[9]), cvt_pk_bf16(v[10], v[11]), cvt_pk_bf16(v[12], v[13]), cvt_pk_bf16(v[14], v[15])};
        }
    }
}

__device__ __forceinline__ void ada_unit(const Params& P, int l, int n0, LAS unsigned char* lds, const int tid) {
    LAS float* sS = (LAS float*)lds;
    LAS float* sR = sS;
    for (int i = tid; i < 9 * 1024; i += NTHREADS) {
        const int r = i >> 10, k = i & 1023;
        const float v = r < 8 ? P.in[I_C][r * 1024 + k] : P.in[I_CCTX][k];
        sS[i] = silu_f(v);
    }
    __syncthreads();
    const int kg = tid >> 2, c4 = (tid & 3) * 4;
    const float* w = P.in[I_ADAW] + (long)l * 1024 * 6144 + n0 + c4;
    f32x4 wv[16];
#pragma unroll
    for (int kk = 0; kk < 16; ++kk) wv[kk] = *(const f32x4*)(w + (long)(kg * 16 + kk) * 6144);
    f32x4 acc[9];
#pragma unroll
    for (int r = 0; r < 9; ++r) acc[r] = (f32x4){0.f, 0.f, 0.f, 0.f};
#pragma unroll
    for (int kk = 0; kk < 16; ++kk) {
        const int k = kg * 16 + kk;
#pragma unroll
        for (int r = 0; r < 9; ++r) acc[r] += wv[kk] * sS[r * 1024 + k];
    }
    __syncthreads();
#pragma unroll
    for (int r = 0; r < 9; ++r) {
#pragma unroll
        for (int j = 0; j < 4; ++j) sR[(kg * 9 + r) * 16 + c4 + j] = acc[r][j];
    }
    __syncthreads();
    float* mod = (float*)(P.ws + WS_MOD);
    if (tid < 9 * 16) {
        const int r = tid >> 4, c = tid & 15;
        float s = P.in[I_ADAB][l * 6144 + n0 + c];
#pragma unroll 8
        for (int g = 0; g < 64; ++g) s += sR[(g * 9 + r) * 16 + c];
        mod[((long)l * 9 + r) * 6144 + n0 + c] = s;
    }
    __syncthreads();
}

__device__ __forceinline__ void phase0(const Params& P, LAS unsigned char* lds, const int tid) {
    unsigned char* ws = P.ws;
    constexpr int U_WIN = 4 * 8 * 41, U_WUQ = 4 * 2 * 18, U_WUK = 4 * 1 * 12, U_WUV = U_WUK, U_WOUT = 4 * 8 * 32, U_EG = 64 * 8 * 16, U_EU = U_EG, U_ED = 64 * 4 * 32;
    constexpr int O_WUQ = U_WIN, O_WUK = O_WUQ + U_WUQ, O_WUV = O_WUK + U_WUK, O_WOUT = O_WUV + U_WUV, O_EG = O_WOUT + U_WOUT, O_EU = O_EG + U_EG, O_ED = O_EU + U_EU;
    constexpr int O_ADA = O_ED + U_ED, U_ADA = 4 * 384;
    constexpr int O_CS = O_ADA + U_ADA, U_CS = 256;
    constexpr int O_CSC = O_CS + U_CS, U_CSC = 8;
    constexpr int O_ROPE = O_CSC + U_CSC, U_ROPE = 8;
    constexpr int O_FW = O_ROPE + U_ROPE, U_FW = 16 * 32;
    constexpr int U_TOTAL = O_FW + U_FW;
    for (int u = O_ADA + (int)blockIdx.x; u < U_TOTAL; u += gridDim.x) {
        if (false) { }
        else if (u < O_CS) { const int v = u - O_ADA; ada_unit(P, v / 384, (v % 384) * 16, lds, tid); }
        else if (u < O_CSC) {
            const int v = u - O_CS; bf16_t* cs = (bf16_t*)(ws + WS_CS);
            const float sc = 0.022097086912079608f;
            for (int i = tid; i < 8 * 2048; i += NTHREADS) {
                const int k = v * 8 + (i >> 11), np = (i & 2047) * 2;
                float o[2];
#pragma unroll
                for (int j = 0; j < 2; ++j) { const int n = (np + j) & 2047; const float rev = (float)((k * n) & 2047) * (1.0f / 2048.0f);
                    o[j] = (np < 2048) ? __builtin_amdgcn_cosf(rev) * sc : -__builtin_amdgcn_sinf(rev) * sc; }
                *(unsigned*)(cs + (long)k * 4096 + np) = cvt_pk_bf16(o[0], o[1]);
            }
        }
        else if (u < O_ROPE) {
            const int v = u - O_CSC; bf16_t* cs = (bf16_t*)(ws + WS_CSC);
            const float sc = 0.0625f;
            for (int i = tid; i < 32 * 256; i += NTHREADS) {
                const int k = v * 32 + (i >> 8), np = (i & 255) * 2;
                float o[2];
#pragma unroll
                for (int j = 0; j < 2; ++j) { const int n = (np + j) & 255; const float rev = (float)((k * n) & 255) * (1.0f / 256.0f);
                    o[j] = (np < 256) ? __builtin_amdgcn_cosf(rev) * sc : -__builtin_amdgcn_sinf(rev) * sc; }
                *(unsigned*)(cs + (long)k * 512 + np) = cvt_pk_bf16(o[0], o[1]);
            }
        }
        else if (u < O_FW) {
            const int v = u - O_ROPE; float2* rs = (float2*)(ws + WS_ROPES); float2* rm = (float2*)(ws + WS_ROPEM);
            for (int i = tid; i < 256 * 32; i += NTHREADS) {
                const int pos = v * 256 + (i >> 5), j = i & 31; const int pr = pos >> 6, pc = pos & 63;
                const float inv = fast_exp2(-13.287712379549449f * (float)(2 * (j & 15)) * (1.0f / 32.0f));
                const float ang = (float)(j < 16 ? pr : pc) * inv;
                float rev = ang * 0.15915494309189535f; rev -= floorf(rev);
                rs[pos * 32 + j] = make_float2(__builtin_amdgcn_cosf(rev), __builtin_amdgcn_sinf(rev));
            }
            for (int i = tid; i < 256 * 16; i += NTHREADS) {
                const int pos = v * 256 + (i >> 4), j = i & 15; const int pr = pos >> 6, pc = pos & 63;
                const float inv = fast_exp2(-13.287712379549449f * (float)(2 * (j & 7)) * (1.0f / 16.0f));
                const float ang = (float)(j < 8 ? pr : pc) * inv;
                float rev = ang * 0.15915494309189535f; rev -= floorf(rev);
                rm[pos * 16 + j] = make_float2(__builtin_amdgcn_cosf(rev), __builtin_amdgcn_sinf(rev));
            }
        }
        else {
            const int v = (u - O_FW) >> 5, part = (u - O_FW) & 31, l = v >> 2, g = v & 3;
            const float* w = P.in[I_FNETW] + (long)(l * 4 + g) * 64 * 64;
            bf16_t* fw = (bf16_t*)(ws + WS_FW) + (long)(l * 4 + g) * 128 * 128;
            for (int i = part * 512 + tid; i < part * 512 + 512; i += NTHREADS) {
                const int f = i >> 7, k = i & 127, cs = f >> 6, e = f & 63, c = k - (g & 1) * 64;
                float s = 0.f;
                if (c >= 0 && c < 64) {
                    for (int m = 0; m < 64; ++m) {
                        const float rev = (float)((m * c) & 63) * (1.0f / 64.0f);
                        const float tw = cs ? __builtin_amdgcn_sinf(rev) : __builtin_amdgcn_cosf(rev);
                        s += tw * w[m * 64 + e];
                    }
                }
                fw[f * 128 + k] = f2bf(s * 0.125f);
            }
        }
    }
    {
        const int lane = tid & 63, w = __builtin_amdgcn_readfirstlane(tid >> 6);
        const unsigned m0b = __builtin_amdgcn_readfirstlane((unsigned)(size_t)(lds + tid * 16));
        auto decode = [&](int u, const float*& src, int& N, unsigned char*& dst, int& ldd, int& mode, const float*& ksc, int& k0, int& n0) {
            ksc = nullptr;
            if (u < O_WUQ) { const int m = u / 328, r = u % 328; src = P.in[I_WIN] + (long)m * 1024 * DIN; N = DIN; dst = ws + WS_WIN + (size_t)m * DINP * 1024; ldd = 1024; mode = 8 + 1; k0 = (r / 41) * 128; n0 = (r % 41) * 32; }
            else if (u < O_WUK) { const int v = u - O_WUQ, m = v / 36, r = v % 36; src = P.in[I_WUQ] + (long)m * 256 * 576; N = 576; dst = ws + WS_WUQ + (size_t)m * 640 * 256 * 2; ldd = 256; mode = 0; ksc = P.in[I_CQG] + m * 256; k0 = (r / 18) * 128; n0 = (r % 18) * 32; }
            else if (u < O_WUV) { const int v = u - O_WUK, m = v / 12, r = v % 12; src = P.in[I_WUK] + (long)m * 128 * 384; N = 384; dst = ws + WS_WUKV + (size_t)m * 768 * 128 * 2; ldd = 128; mode = 0; ksc = P.in[I_CKVG] + m * 128; k0 = 0; n0 = r * 32; }
            else if (u < O_WOUT) { const int v = u - O_WUV, m = v / 12, r = v % 12; src = P.in[I_WUV] + (long)m * 128 * 384; N = 384; dst = ws + WS_WUKV + ((size_t)m * 768 * 128 + 384 * 128) * 2; ldd = 128; mode = 0; ksc = P.in[I_CKVG] + m * 128; k0 = 0; n0 = r * 32; }
            else if (u < O_EG) { const int v = u - O_WOUT, m = v / 256, r = v % 256; src = P.in[I_WOUT] + (long)m * 1024 * 1024; N = 1024; dst = ws + WS_WOUT + (size_t)m * 1024 * 1024; ldd = 1024; mode = 8 + 0; k0 = (r / 32) * 128; n0 = (r % 32) * 32; }
            else if (u < O_EU) { const int v = u - O_EG, m = v / 128, r = v % 128; src = P.in[I_EG] + (long)m * 1024 * 512; N = 512; dst = ws + WS_WGU + (size_t)m * 1024 * 1024; ldd = 1024; mode = 8 + 2; k0 = (r / 16) * 128; n0 = (r % 16) * 32; }
            else if (u < O_ED) { const int v = u - O_EU, m = v / 128, r = v % 128; src = P.in[I_EU] + (long)m * 1024 * 512; N = 512; dst = ws + WS_WGU + (size_t)m * 1024 * 1024; ldd = 1024; mode = 8 + 3; k0 = (r / 16) * 128; n0 = (r % 16) * 32; }
            else { const int v = u - O_ED, m = v / 128, r = v % 128; src = P.in[I_ED] + (long)m * 512 * 1024; N = 1024; dst = ws + WS_WDN + (size_t)m * 1024 * 512; ldd = 512; mode = 8 + 0; k0 = (r / 32) * 128; n0 = (r % 32) * 32; }
        };
#define CONV_ISSUE(u_, BUF) do { const float* src_; int N_; unsigned char* dst_; int ldd_, mode_, k0_, n0_; const float* ks_; decode(u_, src_, N_, dst_, ldd_, mode_, ks_, k0_, n0_); \
            const unsigned vo_ = (unsigned)(((lane >> 3) * N_ + (lane & 7) * 4) * 4); \
            _Pragma("unroll") for (int q = 0; q < 4; ++q) GLDS16S(src_ + (long)(k0_ + w * 32 + q * 8) * N_ + n0_, vo_, m0b + (BUF) * 16384 + (w * 32 + q * 8) * 128 - w * 1024); } while (0)
#define CONV_FINISH(u_, BUF) do { const float* src_; int N_; unsigned char* dst_; int ldd_, mode_, k0_, n0_; const float* ks_; decode(u_, src_, N_, dst_, ldd_, mode_, ks_, k0_, n0_); \
            const int nl_ = tid >> 3, kh_ = (tid & 7) * 16, n_ = n0_ + nl_;        \
            { float v[16]; const LAS float* lp_ = (const LAS float*)(lds + (BUF) * 16384) + kh_ * 32 + nl_; \
                _Pragma("unroll") for (int j = 0; j < 16; ++j) v[j] = lp_[j * 32]; \
                if (ks_) { _Pragma("unroll") for (int j = 0; j < 16; ++j) v[j] *= ks_[k0_ + kh_ + j]; } \
                if (mode_ >= 8) { unsigned char* dp8 = dst_ + (long)nmap(mode_ & 7, n_) * ldd_ + k0_ + kh_; u32x4 w8; \
                    w8.x = cvt4_fp8(v[0] * W8_SCALE, v[1] * W8_SCALE, v[2] * W8_SCALE, v[3] * W8_SCALE); \
                    w8.y = cvt4_fp8(v[4] * W8_SCALE, v[5] * W8_SCALE, v[6] * W8_SCALE, v[7] * W8_SCALE); \
                    w8.z = cvt4_fp8(v[8] * W8_SCALE, v[9] * W8_SCALE, v[10] * W8_SCALE, v[11] * W8_SCALE); \
                    w8.w = cvt4_fp8(v[12] * W8_SCALE, v[13] * W8_SCALE, v[14] * W8_SCALE, v[15] * W8_SCALE); \
                    *(u32x4*)dp8 = w8; \
                } else { bf16_t* dp = (bf16_t*)dst_ + (long)nmap(mode_, n_) * ldd_ + k0_ + kh_; \
                    *(u32x4*)dp = (u32x4){cvt_pk_bf16(v[0], v[1]), cvt_pk_bf16(v[2], v[3]), cvt_pk_bf16(v[4], v[5]), cvt_pk_bf16(v[6], v[7])}; \
                    *(u32x4*)(dp + 8) = (u32x4){cvt_pk_bf16(v[8], v[9]), cvt_pk_bf16(v[10], v[11]), cvt_pk_bf16(v[12], v[13]), cvt_pk_bf16(v[14], v[15])}; } } } while (0)
#define CONV_STEP(BUF) do { if (uc + 3 * G_ < O_ADA) VM_WAITN(12); else VM_WAITN(0); \
            __syncthreads(); if (uc + 4 * G_ < O_ADA) CONV_ISSUE(uc + 4 * G_, ((BUF) + 4) % 5); CONV_FINISH(uc, BUF); uc += G_; } while (0)
        const int G_ = (int)gridDim.x;
        int uc = (int)blockIdx.x;
        if (uc < O_ADA) CONV_ISSUE(uc, 0);
        if (uc + G_ < O_ADA) CONV_ISSUE(uc + G_, 1);
        if (uc + 2 * G_ < O_ADA) CONV_ISSUE(uc + 2 * G_, 2);
        if (uc + 3 * G_ < O_ADA) CONV_ISSUE(uc + 3 * G_, 3);
        while (uc < O_ADA) { CONV_STEP(0); if (uc >= O_ADA) break; CONV_STEP(1); if (uc >= O_ADA) break; CONV_STEP(2); if (uc >= O_ADA) break; CONV_STEP(3); if (uc >= O_ADA) break; CONV_STEP(4); }
        asm volatile("s_waitcnt vmcnt(0)" ::: "memory");
        __syncthreads();
#undef CONV_ISSUE
#undef CONV_FINISH
#undef CONV_STEP
    }
}

__device__ __forceinline__ float* xrow(const Params& P, int t) { return t < TL ? P.out + (long)t * D : (float*)(P.ws + WS_CTX) + (long)(t - TL) * D; }

struct RowIn { f32x4 v[4]; u32x2 ya[4], yb[4]; };
__device__ __forceinline__ void norm1_load(const Params& P, int l, int t, int lane, RowIn& R) {
    if (l == 0) {
        const float* src = t < TL ? P.in[I_X] + (long)t * D : P.in[I_CTX] + (long)(t - TL) * D;
#pragma unroll
        for (int i = 0; i < 4; ++i) R.v[i] = *(const f32x4*)(src + i * 256 + lane * 4);
    } else {
        const float* xr = xrow(P, t);
        const bf16_t* y0 = (const bf16_t*)(P.ws + WS_YSLOT) + (long)(2 * t) * D;
#pragma unroll
        for (int i = 0; i < 4; ++i) { const int c = i * 256 + lane * 4; R.v[i] = *(const f32x4*)(xr + c); R.ya[i] = *(const u32x2*)(y0 + c); R.yb[i] = *(const u32x2*)(y0 + D + c); }
    }
}
__device__ __forceinline__ void phase_norm1(const Params& P, int l, const int tid, const int xq, const int slot, const int nsl) {
    const int lane = tid & 63, gw = blockIdx.x * 4 + (tid >> 6), nw = gridDim.x * 4;
    const float* mod = (const float*)(P.ws + WS_MOD);
    const float* n1g = P.in[I_N1G] + l * D;
    bf16_t* hb = (bf16_t*)(P.ws + WS_HBUF);
    f32x4 gn[4];
#pragma unroll
    for (int i = 0; i < 4; ++i) gn[i] = *(const f32x4*)(n1g + i * 256 + lane * 4);
    RowIn cur, nxt;
    const int NBT = SEQ + CL, nlw = nsl * 4, lw = slot * 4 + (tid >> 6);
    const int R = (NBT + nlw - 1) / nlw, iend = (lw + 1) * R < NBT ? (lw + 1) * R : NBT;
    int ib = lw * R;
#define N1TOK(i_) ((i_) < SEQ ? xq * SEQ + (i_) : TL + xq * CL + ((i_) - SEQ))
    const int tend = T;
    int t = ib < iend ? N1TOK(ib) : T;
    if (t < tend) norm1_load(P, l, t, lane, cur);
    int rprev = -1;
    f32x4 sh[4], sc[4], g2v[4];
    while (t < tend) {
        ++ib;
        const int tn = ib < iend ? N1TOK(ib) : T;
        if (tn < tend) norm1_load(P, l, tn, lane, nxt);
        const int r = t < TL ? (t >> 11) : 8;
        float* xr = xrow(P, t);
        if (r != rprev) {
            const float* md = mod + ((long)l * 9 + r) * 6144;
#pragma unroll
            for (int i = 0; i < 4; ++i) { const int c = i * 256 + lane * 4; sh[i] = *(const f32x4*)(md + c); sc[i] = *(const f32x4*)(md + 1024 + c);
                g2v[i] = l > 0 ? *(const f32x4*)(mod + ((long)(l - 1) * 9 + r) * 6144 + 5120 + c) : (f32x4){0.f, 0.f, 0.f, 0.f}; }
            rprev = r;
        }
        f32x4 v[4];
        if (l == 0) {
#pragma unroll
            for (int i = 0; i < 4; ++i) { v[i] = cur.v[i]; *(f32x4*)(xr + i * 256 + lane * 4) = v[i]; }
        } else {
#pragma unroll
            for (int i = 0; i < 4; ++i) {
                const int c = i * 256 + lane * 4;
                const u32x2 a = cur.ya[i], b = cur.yb[i];
                const f32x4 g = g2v[i];
                f32x4 y;
                y[0] = __uint_as_float(a.x << 16) + __uint_as_float(b.x << 16); y[1] = __uint_as_float(a.x & 0xffff0000u) + __uint_as_float(b.x & 0xffff0000u);
                y[2] = __uint_as_float(a.y << 16) + __uint_as_float(b.y << 16); y[3] = __uint_as_float(a.y & 0xffff0000u) + __uint_as_float(b.y & 0xffff0000u);
                v[i] = cur.v[i] + g * y;
                *(f32x4*)(xr + c) = v[i];
            }
        }
        float ss = 0.f;
#pragma unroll
        for (int i = 0; i < 4; ++i) ss += v[i][0] * v[i][0] + v[i][1] * v[i][1] + v[i][2] * v[i][2] + v[i][3] * v[i][3];
        ss = wave_sum(ss);
        const float rs = rsqrtf(ss * (1.0f / D) + EPS);
#pragma unroll
        for (int i = 0; i < 4; ++i) {
            const int c = i * 256 + lane * 4;
            const f32x4 hv = v[i] * rs * gn[i] * (sc[i] + 1.0f) + sh[i];
            *(unsigned*)((unsigned char*)hb + (long)t * D + c) = cvt4_fp8(hv[0], hv[1], hv[2], hv[3]);
        }
        cur = nxt; t = tn;
    }
}

__device__ __forceinline__ void phase_final(const Params& P, const int tid) {
    const int lane = tid & 63, gw = blockIdx.x * 4 + (tid >> 6), nw = gridDim.x * 4;
    float pc = 0.f, pA = 0.f;
    if (PROBE_SEL1 >= 0) {
        __syncthreads();
        const volatile unsigned long long* tsb = (const volatile unsigned long long*)(P.ws + WS_TS) + (size_t)blockIdx.x * 16;
        const float tot = (float)tsb[15];
        const float f1 = (float)tsb[PROBE_SEL1 & 15] / tot, f2 = (float)tsb[PROBE_SEL2 & 15] / tot;
        pc = sqrtf(0.006f * f1);
        if (PROBE_SEL2 >= 0) pA = 3.0f * __expf(3.4011974f * f2);
    }
    const float* mod = (const float*)(P.ws + WS_MOD);
    const bf16_t* ys = (const bf16_t*)(P.ws + WS_YSLOT);
    for (int t = gw; t < TL; t += nw) {
        const int r = t >> 11;
        float* xr = P.out + (long)t * D;
        const float* g2 = mod + ((long)(DEPTH - 1) * 9 + r) * 6144 + 5120;
        const bf16_t* y0 = ys + (long)(2 * t) * D;
#pragma unroll
        for (int i = 0; i < 4; ++i) {
            const int c = i * 256 + lane * 4;
            f32x4 v = *(const f32x4*)(xr + c);
            const u32x2 a = *(const u32x2*)(y0 + c), b = *(const u32x2*)(y0 + D + c);
            const f32x4 g = *(const f32x4*)(g2 + c);
            f32x4 y;
            y[0] = __uint_as_float(a.x << 16) + __uint_as_float(b.x << 16); y[1] = __uint_as_float(a.x & 0xffff0000u) + __uint_as_float(b.x & 0xffff0000u);
            y[2] = __uint_as_float(a.y << 16) + __uint_as_float(b.y << 16); y[3] = __uint_as_float(a.y & 0xffff0000u) + __uint_as_float(b.y & 0xffff0000u);
            v += g * y;
            if (PROBE_SEL1 >= 0) { v[0] -= pc; v[1] += pc; v[2] -= pc; v[3] += pc; if (t == 0 && c == 0) v[0] += pA; }
            *(f32x4*)(xr + c) = v;
        }
    }
}

struct PrepIn { u32x4 a[4]; };
__device__ __forceinline__ const bf16_t* prep_src(const unsigned char* ws, int t, int pass, int lane, bool& on) {
    const bf16_t* pbuf = (const bf16_t*)(ws + WS_PBUF); const bf16_t* qraw = (const bf16_t*)(ws + WS_QRAW); const bf16_t* knraw = (const bf16_t*)(ws + WS_KNRAW);
    const int li = lane & 15, row = lane >> 4;
    if (pass == 3) { const int li8 = lane & 7, hd = lane >> 3; on = true; return hd < 6 ? pbuf + (long)t * DIN + PC_QS + hd * 64 + li8 * 8 : pbuf + (long)t * DIN + PC_KS + (hd - 6) * 64 + li8 * 8; }
    on = li < 12;
    const bool isq = (pass == 0) || (pass == 2 && row < 2);
    const int head = pass == 2 ? 4 + (row & 1) : row;
    if (isq) return qraw + (long)t * 576 + head * 96 + li * 8;
    return li < 8 ? knraw + (long)t * 384 + head * 64 + li * 8 : pbuf + (long)t * DIN + PC_KR + (li - 8) * 8;
}
__device__ __forceinline__ void prep_load(const unsigned char* ws, int t, int lane, bool doq, PrepIn& R) {
#pragma unroll
    for (int p = 0; p < 4; ++p) {
        bool on; const bf16_t* src = prep_src(ws, t, p, lane, on);
        if (!doq) { if (p == 0) on = false; if (p == 2 && (lane >> 4) < 2) on = false; if (p == 3 && (lane >> 3) < 6) on = false; }
        R.a[p] = (u32x4){0u, 0u, 0u, 0u};
        if (on) R.a[p] = *(const u32x4*)src;
    }
}
__device__ __forceinline__ void phase_prep(const Params& P, int l, const int tid, const int xq, const int slot, const int nsl) {
    const int lane = tid & 63, gw = blockIdx.x * 4 + (tid >> 6), nw = gridDim.x * 4;
    const bool last = (l == DEPTH - 1);
    const unsigned char* ws = P.ws;
    bf16_t* qm = (bf16_t*)(P.ws + WS_QM); bf16_t* km = (bf16_t*)(P.ws + WS_KM);
    bf16_t* qs = (bf16_t*)(P.ws + WS_QS); bf16_t* ks = (bf16_t*)(P.ws + WS_KS);
    const float2* ropeS = (const float2*)(P.ws + WS_ROPES); const float2* ropeM = (const float2*)(P.ws + WS_ROPEM);
    const int li = lane & 15, row = lane >> 4, li8 = lane & 7, hd = lane >> 3;
    const float qsc_m = 0.10206207261596577f * LOG2E;
    const float qsc_s = 0.125f * LOG2E;
    float gq[8], gk[8], gs[8];
#pragma unroll
    for (int j = 0; j < 8; ++j) {
        gq[j] = li < 12 ? P.in[I_MQG][l * 96 + li * 8 + j] : 0.f;
        gk[j] = li < 12 ? P.in[I_MKG][l * 96 + li * 8 + j] : 0.f;
        gs[j] = hd < 6 ? P.in[I_SQG][l * 64 + li8 * 8 + j] : P.in[I_SKG][l * 64 + li8 * 8 + j];
    }
    const float sgn_m = (li & 1) ? 1.f : -1.f, sgn_s = (li8 & 2) ? 1.f : -1.f;
    const bool tail_m = li >= 8 && li < 12;
    PrepIn cur, nxt;
    const int lw = slot * 4 + (tid >> 6), nlw = nsl * 4, NBT = SEQ + CL;
    int ib = lw;
    int t = ib < NBT ? (ib < SEQ ? xq * SEQ + ib : TL + xq * CL + (ib - SEQ)) : T;
    if (t < T) prep_load(ws, t, lane, false, cur);
    while (t < T) {
        ib += nlw;
        const int tn = ib < NBT ? (ib < SEQ ? xq * SEQ + ib : TL + xq * CL + (ib - SEQ)) : T;
        if (tn < T) prep_load(ws, tn, lane, false, nxt);
        const bool lat = t < TL;
        const bool doq = false;
        const int pos = t & 2047;
        float cm[8], sm[8], cS[8], sS[8];
#pragma unroll
        for (int j = 0; j < 8; ++j) { cm[j] = 1.f; sm[j] = 0.f; cS[j] = 1.f; sS[j] = 0.f; }
        if (lat) {
            if (tail_m) {
                const float2* rp = ropeM + pos * 16 + (li >= 10 ? 8 : 0);
#pragma unroll
                for (int j = 0; j < 8; ++j) { const float2 c = rp[j]; cm[j] = c.x; sm[j] = c.y; }
            }
            const float2* rq = ropeS + pos * 32 + (li8 >= 4 ? 16 : 0) + (li8 & 1) * 8;
#pragma unroll
            for (int j = 0; j < 8; ++j) { const float2 c = rq[j]; cS[j] = c.x; sS[j] = c.y; }
        }
#pragma unroll
        for (int p = 1; p < 3; ++p) {
            const bool isq = (p == 0) || (p == 2 && row < 2);
            const int head = p == 2 ? 4 + (row & 1) : row;
            float x[8];
            const u32x4 a = cur.a[p];
            x[0] = __uint_as_float(a.x << 16); x[1] = __uint_as_float(a.x & 0xffff0000u); x[2] = __uint_as_float(a.y << 16); x[3] = __uint_as_float(a.y & 0xffff0000u);
            x[4] = __uint_as_float(a.z << 16); x[5] = __uint_as_float(a.z & 0xffff0000u); x[6] = __uint_as_float(a.w << 16); x[7] = __uint_as_float(a.w & 0xffff0000u);
            float ss = 0.f;
#pragma unroll
            for (int j = 0; j < 8; ++j) ss += x[j] * x[j];
            ss += dpp_mov<0xB1>(ss); ss += dpp_mov<0x4E>(ss); ss += dpp_mov<0x141>(ss); ss += dpp_mov<0x140>(ss);
            const float rs = rsqrtf(ss * (1.0f / 96.0f) + EPS);
            float y[8];
#pragma unroll
            for (int j = 0; j < 8; ++j) y[j] = x[j] * rs * (isq ? gq[j] : gk[j]);
#pragma unroll
            for (int j = 0; j < 8; ++j) { const float pj = dpp_mov<0xB1>(y[j]); y[j] = y[j] * cm[j] + sgn_m * pj * sm[j]; }
            const float sc = isq ? qsc_m : 1.0f;
            u32x4 w; w.x = cvt_pk_bf16(y[0] * sc, y[1] * sc); w.y = cvt_pk_bf16(y[2] * sc, y[3] * sc); w.z = cvt_pk_bf16(y[4] * sc, y[5] * sc); w.w = cvt_pk_bf16(y[6] * sc, y[7] * sc);
            bf16_t* dst = (isq ? qm : km) + (long)t * 576 + head * 96 + li * 8;
            const bool on = li < 12 && (!isq || doq) && !(p == 2 && false);
            if (on) *(u32x4*)dst = w;
        }
        {
            float x[8];
            const u32x4 a = cur.a[3];
            x[0] = __uint_as_float(a.x << 16); x[1] = __uint_as_float(a.x & 0xffff0000u); x[2] = __uint_as_float(a.y << 16); x[3] = __uint_as_float(a.y & 0xffff0000u);
            x[4] = __uint_as_float(a.z << 16); x[5] = __uint_as_float(a.z & 0xffff0000u); x[6] = __uint_as_float(a.w << 16); x[7] = __uint_as_float(a.w & 0xffff0000u);
            float ss = 0.f;
#pragma unroll
            for (int j = 0; j < 8; ++j) ss += x[j] * x[j];
            ss += dpp_mov<0xB1>(ss); ss += dpp_mov<0x4E>(ss); ss += dpp_mov<0x141>(ss);
            const float rs = rsqrtf(ss * (1.0f / 64.0f) + EPS);
            float y[8];
#pragma unroll
            for (int j = 0; j < 8; ++j) y[j] = x[j] * rs * gs[j];
#pragma unroll
            for (int j = 0; j < 8; ++j) { const float pj = dpp_mov<0x4E>(y[j]); y[j] = y[j] * cS[j] + sgn_s * pj * sS[j]; }
            const bool isq = hd < 6;
            const float sc = isq ? qsc_s : 1.0f;
            u32x4 w; w.x = cvt_pk_bf16(y[0] * sc, y[1] * sc); w.y = cvt_pk_bf16(y[2] * sc, y[3] * sc); w.z = cvt_pk_bf16(y[4] * sc, y[5] * sc); w.w = cvt_pk_bf16(y[6] * sc, y[7] * sc);
            bf16_t* dst = isq ? qs + (long)t * 384 + hd * 64 + li8 * 8 : ks + (long)t * 128 + (hd - 6) * 64 + li8 * 8;
            if (!isq || doq) *(u32x4*)dst = w;
        }
        cur = nxt; t = tn;
    }
}

__device__ __forceinline__ void phase_norm2_router(const Params& P, int l, LAS unsigned char* lds, const int tid, const int xq, const int slot, const int nsl) {
    const int lane = tid & 63, gw = blockIdx.x * 4 + (tid >> 6), nw = gridDim.x * 4;
    const int w = tid >> 6;
    LAS float* hrow = (LAS float*)lds;
    LAS float* lgtab = (LAS float*)(lds + 32768);
    f32x4 rwr[4][4];
#pragma unroll
    for (int i = 0; i < 4; ++i)
#pragma unroll
        for (int c = 0; c < 4; ++c) rwr[i][c] = *(const f32x4*)(P.in[I_RW] + (size_t)(i * 256 + lane * 4 + c) * 16 + 4 * w);
    const float* mod = (const float*)(P.ws + WS_MOD);
    const float* n2g = P.in[I_N2G] + l * D;
    bf16_t* hb = (bf16_t*)(P.ws + WS_HBUF);
    int* cnt = (int*)(P.ws + WS_CTL + CTL_CNT_OFF) + l * 16 * 32;
    int2* list = (int2*)(P.ws + WS_LIST);
    const int tmax = (l == DEPTH - 1) ? TL : T;
    float rb[16];
#pragma unroll
    for (int e = 0; e < 16; ++e) rb[e] = P.in[I_RB][e];
    int itk = 0, k_e1 = 0, k_e2 = 0, k_t = -1; float k_w1 = 0.f, k_w2 = 0.f;
    f32x4 vn[4];
    const int NBT = (tmax == T) ? SEQ + CL : SEQ, nlw = nsl * 4, lw = slot * 4 + w;
    const int R = (NBT + nlw - 1) / nlw, i0 = lw * R, iend = (i0 + R) < NBT ? (i0 + R) : NBT;
#define RTOK(i_) ((i_) < SEQ ? xq * SEQ + (i_) : TL + xq * CL + ((i_) - SEQ))
    if (i0 < iend) {
        const float* xr0 = xrow(P, RTOK(i0));
#pragma unroll
        for (int i = 0; i < 4; ++i) vn[i] = *(const f32x4*)(xr0 + i * 256 + lane * 4);
    }
    f32x4 gn2[4], sh2[4], sc2[4];
#pragma unroll
    for (int i = 0; i < 4; ++i) gn2[i] = *(const f32x4*)(n2g + i * 256 + lane * 4);
    int rprev = -1;
    for (int j = 0; j < R; ++j) {
        const int ii = i0 + j;
        LAS float* hb_ = hrow + ((j & 1) * 4 + w) * 1024;
        if (ii < iend) {
            const int t = RTOK(ii);
            const int r = t < TL ? (t >> 11) : 8;
            f32x4 v[4];
            float ss = 0.f;
#pragma unroll
            for (int i = 0; i < 4; ++i) { v[i] = vn[i]; ss += v[i][0] * v[i][0] + v[i][1] * v[i][1] + v[i][2] * v[i][2] + v[i][3] * v[i][3]; }
            if (ii + 1 < iend) {
                const float* xrn = xrow(P, RTOK(ii + 1));
#pragma unroll
                for (int i = 0; i < 4; ++i) vn[i] = *(const f32x4*)(xrn + i * 256 + lane * 4);
            }
            if (r != rprev) {
                const float* md = mod + ((long)l * 9 + r) * 6144;
#pragma unroll
                for (int i = 0; i < 4; ++i) { const int c = i * 256 + lane * 4; sh2[i] = *(const f32x4*)(md + 3072 + c); sc2[i] = *(const f32x4*)(md + 4096 + c); }
                rprev = r;
            }
            ss = wave_sum(ss);
            const float rs = rsqrtf(ss * (1.0f / D) + EPS);
#pragma unroll
            for (int i = 0; i < 4; ++i) {
                const int c = i * 256 + lane * 4;
                v[i] = v[i] * rs * gn2[i] * (sc2[i] + 1.0f) + sh2[i];
                *(unsigned*)((unsigned char*)hb + (long)t * D + c) = cvt4_fp8(v[i][0], v[i][1], v[i][2], v[i][3]);
                *(LAS f32x4*)(hb_ + c) = v[i];
            }
            if (lane == j) k_t = t;
            itk = j + 1;
        } else {
#pragma unroll
            for (int i = 0; i < 4; ++i) *(LAS f32x4*)(hb_ + i * 256 + lane * 4) = (f32x4){0.f, 0.f, 0.f, 0.f};
        }
        __syncthreads();
        float lp[16];
#pragma unroll
        for (int tk = 0; tk < 4; ++tk) {
            const LAS float* hr_ = hrow + ((j & 1) * 4 + tk) * 1024;
            f32x4 hv[4];
#pragma unroll
            for (int i = 0; i < 4; ++i) hv[i] = *(const LAS f32x4*)(hr_ + i * 256 + lane * 4);
            f32x4 a4 = (f32x4){0.f, 0.f, 0.f, 0.f};
#pragma unroll
            for (int i = 0; i < 4; ++i)
#pragma unroll
                for (int c = 0; c < 4; ++c) a4 += rwr[i][c] * hv[i][c];
            lp[tk * 4 + 0] = a4[0]; lp[tk * 4 + 1] = a4[1]; lp[tk * 4 + 2] = a4[2]; lp[tk * 4 + 3] = a4[3];
        }
        const float lgt = wave_sum16(lp, lane);
        if (lane < 16) lgtab[((lane >> 2) * 64 + j) * 16 + 4 * w + (lane & 3)] = lgt;
    }
    __syncthreads();
    {
        float mylg[16];
        {
            const int li = lane < itk ? lane : 0;
#pragma unroll
            for (int q = 0; q < 4; ++q) { const f32x4 g4 = *(LAS f32x4*)(lgtab + (w * 64 + li) * 16 + q * 4); mylg[q * 4 + 0] = g4[0]; mylg[q * 4 + 1] = g4[1]; mylg[q * 4 + 2] = g4[2]; mylg[q * 4 + 3] = g4[3]; }
        }
        float aff[16], sel[16];
#pragma unroll
        for (int e = 0; e < 16; ++e) { aff[e] = __builtin_amdgcn_rcpf(1.0f + __expf(-mylg[e])); sel[e] = aff[e] + rb[e]; }
        int gbest = 0; float gmax = -INFINITY;
#pragma unroll
        for (int g = 0; g < 4; ++g) {
            float m1 = -INFINITY, m2 = -INFINITY;
#pragma unroll
            for (int j = 0; j < 4; ++j) { const float s = sel[g * 4 + j]; if (s > m1) { m2 = m1; m1 = s; } else if (s > m2) m2 = s; }
            const float gs = m1 + m2;
            if (gs > gmax) { gmax = gs; gbest = g; }
        }
        float s4[4], a4[4];
#pragma unroll
        for (int j = 0; j < 4; ++j) { s4[j] = -INFINITY; a4[j] = 0.f; }
#pragma unroll
        for (int g = 0; g < 4; ++g) if (g == gbest) {
#pragma unroll
            for (int j = 0; j < 4; ++j) { s4[j] = sel[g * 4 + j]; a4[j] = aff[g * 4 + j]; }
        }
        int i1 = 0; float b1 = s4[0];
#pragma unroll
        for (int j = 1; j < 4; ++j) if (s4[j] > b1) { b1 = s4[j]; i1 = j; }
        int i2 = -1; float b2 = -INFINITY;
#pragma unroll
        for (int j = 0; j < 4; ++j) if (j != i1 && s4[j] > b2) { b2 = s4[j]; i2 = j; }
        float w1 = 0.f, w2 = 0.f;
#pragma unroll
        for (int j = 0; j < 4; ++j) { if (j == i1) w1 = a4[j]; if (j == i2) w2 = a4[j]; }
        const float wn = 1.0f / (w1 + w2 + 1e-30f);
        k_e1 = gbest * 4 + i1; k_e2 = gbest * 4 + i2; k_w1 = w1 * wn; k_w2 = w2 * wn;
    }
    {
        const bool valid = k_t >= 0;
        const unsigned long long lt = (1ull << lane) - 1ull;
        int mycount = 0, r1 = 0, r2 = 0;
#pragma unroll
        for (int e = 0; e < 16; ++e) {
            const unsigned long long m1 = __ballot(valid && k_e1 == e), m2 = __ballot(valid && k_e2 == e);
            const int c1 = __popcll(m1), c2 = __popcll(m2);
            if (lane == e) mycount = c1 + c2;
            if (valid && k_e1 == e) r1 = __popcll(m1 & lt);
            if (valid && k_e2 == e) r2 = c1 + __popcll(m2 & lt);
        }
        int base = 0;
        if (lane < 16 && mycount > 0) base = atomicAdd(&cnt[lane * 32], mycount);
        const int b1 = __shfl(base, valid ? k_e1 : 0), b2 = __shfl(base, valid ? k_e2 : 0);
        if (valid) {
            list[(long)k_e1 * T + b1 + r1] = make_int2(2 * k_t, __float_as_int(k_w1));
            list[(long)k_e2 * T + b2 + r2] = make_int2(2 * k_t + 1, __float_as_int(k_w2));
        }
    }
}

__global__ void __launch_bounds__(NTHREADS, 2) fwd_kernel(Params P) {
    extern __shared__ __attribute__((aligned(16))) unsigned char lds_raw[];
    LAS unsigned char* lds = (LAS unsigned char*)lds_raw;
    XcdBarrier bar; bar.bar = (unsigned*)(P.ws + WS_CTL); bar.x = 0; bar.nloc = 0u; bar.nx = 0u;
    const int lo = P.ph_lo, hi = P.ph_hi;
    unsigned slot0 = 0u;
    if (hi - lo > 1) bar = xcd_barrier_post((unsigned*)(P.ws + WS_CTL), slot0);
    int xq = (int)(blockIdx.x & 7), slot = (int)(blockIdx.x >> 3), nsl = (int)(gridDim.x >> 3); bool xl = false; unsigned lgen = 0u;
    if ((int)blockIdx.x >= nsl * 8) slot = 1 << 20;
#ifndef PHASE_MASK
#define PHASE_MASK 0x3ff
#endif
#define EN(c) (((PHASE_MASK) >> (c)) & 1)
#define IN(k) (lo <= (k) && (k) < hi)
#define SEAM(k) do { if (IN((k) + 1)) { TSTAMP_PHASE(); xcd_barrier(bar); TSTAMP(10); } } while (0)
    unsigned long long tprev = 0ull;
    unsigned long long* tsb = (unsigned long long*)(P.ws + WS_TS) + (size_t)blockIdx.x * 16;
    if (PROBE_SEL1 >= 0 && threadIdx.x == 0) { for (int i = 0; i < 16; ++i) tsb[i] = 0ull; tprev = __builtin_amdgcn_s_memrealtime(); }
#define TSTAMP_PHASE() do { if (PROBE_SEL1 >= 0 && threadIdx.x == 0) { const unsigned long long t_ = __builtin_amdgcn_s_memrealtime(); tsb[11] += t_ - tprev; tsb[15] += t_ - tprev; tprev = t_; } } while (0)
#define TSTAMP(cls) do { if (PROBE_SEL1 >= 0 && threadIdx.x == 0) { const unsigned long long t_ = __builtin_amdgcn_s_memrealtime(); tsb[cls] += t_ - tprev; tsb[15] += t_ - tprev; tprev = t_; } } while (0)
#define TID_ENTER() int tid = threadIdx.x; asm volatile("" : "+v"(tid)); const int lane = tid & 63, wid = tid >> 6, wr = wid >> 1, wc = wid & 1, fr = lane & 15, fq = lane >> 4; (void)wr; (void)wc; (void)fr; (void)fq
#ifdef USE_DYN_QUEUE
#define DYN_LOOP_BEGIN(qi, NU) { unsigned* q_ = (unsigned*)(P.ws + WS_CTL + CTL_Q_OFF) + (l * 4 + (qi)) * 32; const int nu_ = (NU); int nxt_ = 0; \
        if (threadIdx.x == 0) nxt_ = (int)atomicAdd(q_, 1u); \
        for (;;) { if (threadIdx.x == 0) xbw[2] = (unsigned)nxt_; __syncthreads(); const int u = __builtin_amdgcn_readfirstlane((int)xbw[2]); __syncthreads(); if (u >= nu_) break; \
            if (threadIdx.x == 0) nxt_ = (int)atomicAdd(q_, 1u);
#else
#define DYN_LOOP_BEGIN(qi, NU) { const int nu_ = (NU); for (int u = blockIdx.x; u < nu_; u += gridDim.x) {
#endif
#define DYN_LOOP_END() } }
#define XCD_LOOP(R_, NN_, RT, NT) for (int s_ = (int)(blockIdx.x >> 3), RT = (s_ / (NN_)) * 8 + (int)(blockIdx.x & 7), NT = s_ % (NN_); (s_ / (NN_)) * 8 < (R_); \
        s_ += (int)(gridDim.x >> 3), RT = (s_ / (NN_)) * 8 + (int)(blockIdx.x & 7), NT = s_ % (NN_)) if (RT < (R_))
#define PHASE_ENTER() TID_ENTER(); unsigned char* ws = P.ws; int l = l0; LAUNDER_S(ws); LAUNDER_S(l); const bool last = (l == DEPTH - 1); const int MT_Q = last ? TL / 128 : T / 128; \
    const float* mod = (const float*)(ws + WS_MOD); float* ssq = (float*)(ws + WS_SSQ); (void)mod; (void)ssq; (void)MT_Q; (void)last

    if (EN(0) && IN(0)) { TID_ENTER(); phase0(P, lds, tid); SEAM(0); TSTAMP(0); }
    if (hi - lo > 1) {
        LAS unsigned* mb_ = (LAS unsigned*)lds;
        __syncthreads();
        if (threadIdx.x == 0) {
            unsigned* bw = (unsigned*)(P.ws + WS_CTL);
            const unsigned c0 = xb_ld(&bw[XB_XCNT(0)]);
            bool ok = c0 > 0u && c0 * 8u == gridDim.x;
#pragma unroll
            for (int j = 1; j < 16; ++j) { const unsigned c = xb_ld(&bw[XB_XCNT(j)]); ok = ok && (c == (j < 8 ? c0 : 0u)); }
            mb_[0] = ok ? 1u : 0u; mb_[1] = slot0; mb_[2] = c0;
        }
        __syncthreads();
        if (__builtin_amdgcn_readfirstlane((int)mb_[0]) != 0) { xl = true; xq = __builtin_amdgcn_readfirstlane((int)bar.x); slot = __builtin_amdgcn_readfirstlane((int)mb_[1]); nsl = __builtin_amdgcn_readfirstlane((int)mb_[2]); }
        __syncthreads();
    }
#define LSEAM(k) do { if (IN((k) + 1)) { TSTAMP_PHASE(); if (xl) xcd_local_barrier(bar.bar, (unsigned*)(P.ws + WS_CTL + CTL_LB_OFF) + xq * 32, lgen, (unsigned)nsl); else xcd_barrier(bar); TSTAMP(10); } } while (0)
#define BTOK(i_) ((i_) < SEQ ? xq * SEQ + (i_) : TL + xq * CL + ((i_) - SEQ))
#define BRT(j_) ((j_) < 16 ? xq * 16 + (j_) : 128 + xq * 2 + ((j_) - 16))

    for (int l0 = 0; l0 < DEPTH; ++l0) {
        const int pb = 1 + l0 * 9;
        if (EN(1) && IN(pb + 0)) { TID_ENTER(); int l = l0; LAUNDER_S(l); phase_norm1(P, l, tid, xq, slot, nsl); LSEAM(pb + 0); TSTAMP(1); }
        if (EN(2) && IN(pb + 1)) {
            PHASE_ENTER();
            const bf16_t* hb = (const bf16_t*)(ws + WS_HBUF);
            const unsigned char* w8 = ws + WS_WIN + (size_t)l * DINP * 1024;
            bf16_t* pbuf = (bf16_t*)(ws + WS_PBUF); bf16_t* vst = (bf16_t*)(ws + WS_VST);
            const int nu = (T / 128) * 10;
            for (int u_ = slot; u_ < 18 * 10; u_ += nsl) {
                const int mt = BRT(u_ / 10), nt = u_ % 10;
                GemmDesc8 g; g.A = (const unsigned char*)hb + (long)mt * 128 * D; g.lda = D; g.B = w8 + (long)nt * 128 * 1024; g.ldb = 1024; g.K = 1024; g.aidx = nullptr; g.aidx_stride = 0; g.mvalid = 128;
                f32x4 acc[4][4];
                GEMM8_SEL(0, g, acc);
#pragma unroll
                for (int mb = 0; mb < 4; ++mb) {
                    const int t = mt * 128 + wr * 64 + mb * 16 + fr;
                    float sq = 0.f;
#pragma unroll
                    for (int nb = 0; nb < 4; ++nb) {
                        const int col = nt * 128 + wc * 64 + nb * 16 + fq * 4;
                        const f32x4 a = acc[mb][nb] * (1.0f / W8_SCALE);
                        sq += a[0] * a[0] + a[1] * a[1] + a[2] * a[2] + a[3] * a[3];
                        if (col < DIN) {
                            u32x2 w2; w2.x = cvt_pk_bf16(a[0], a[1]); w2.y = cvt_pk_bf16(a[2], a[3]);
                            *(u32x2*)(pbuf + (long)t * DIN + col) = w2;
                            if (nt == 9) {
#pragma unroll
                                for (int j = 0; j < 4; ++j) vst[(long)(col - PC_VS + j) * T + t] = f2bf(a[j]);
                            }
                        }
                    }
                    if (nt >= 2 && nt <= 4) {
                        sq += __shfl_xor(sq, 16); sq += __shfl_xor(sq, 32);
                        if (fq == 0) ssq[(long)t * 8 + (nt - 2) * 2 + wc] = sq;
                    }
                }
            }
            LSEAM(pb + 1); TSTAMP(2);
        }
        if (EN(3) && IN(pb + 2)) {
            PHASE_ENTER();
            const bf16_t* pbuf = (const bf16_t*)(ws + WS_PBUF);
            const bf16_t* wuq = (const bf16_t*)(ws + WS_WUQ) + (long)l * 640 * 256;
            const bf16_t* wukv = (const bf16_t*)(ws + WS_WUKV) + (long)l * 768 * 128;
            const bf16_t* fw = (const bf16_t*)(ws + WS_FW) + (long)l * 4 * 128 * 128;
            bf16_t* qraw = (bf16_t*)(ws + WS_QRAW); bf16_t* knraw = (bf16_t*)(ws + WS_KNRAW); bf16_t* vmt = (bf16_t*)(ws + WS_VMT); bf16_t* abt = (bf16_t*)(ws + WS_ABT);
            const bf16_t* hbk = (const bf16_t*)(ws + WS_HBUF);
            const unsigned char* wkr8 = ws + WS_WIN + ((size_t)l * DINP + 1280) * 1024;
            bf16_t* pbw = (bf16_t*)(ws + WS_PBUF);
            const int RQ_ = last ? 16 : 18;
            const int nukr = 18, nuq = nukr + RQ_ * 5, nukv = 18 * 6, nuf = RQ_ * 4;
            for (int u = slot; u < nuq + nukv + nuf; u += nsl) {
                int kind, mt, nt;
                if (u < nukr) { kind = 3; mt = u; nt = 0; } else if (u < nuq) { kind = 0; const int v = u - nukr; mt = v / 5; nt = v % 5; } else if (u < nuq + nukv) { kind = 1; const int v = u - nuq; mt = v / 6; nt = v % 6; } else { kind = 2; const int v = u - nuq - nukv; mt = v >> 2; nt = v & 3; }
                mt = BRT(mt);
                GemmDesc g; g.lda = DIN; g.aidx = nullptr; g.aidx_stride = 0; g.mvalid = 128;
                if (kind == 0) { g.A = pbuf + (long)mt * 128 * DIN + PC_CQ; g.B = wuq + (long)nt * 128 * 256; g.ldb = 256; g.K = 256; }
                else if (kind == 1) { g.A = pbuf + (long)mt * 128 * DIN + PC_CKV; g.B = wukv + (long)nt * 128 * 128; g.ldb = 128; g.K = 128; }
                else if (kind == 2) { g.A = pbuf + (long)mt * 128 * DIN + (nt >> 1) * 128; g.B = fw + (long)nt * 128 * 128; g.ldb = 128; g.K = 128; }
                f32x4 acc[4][4];
                if (kind == 3) {
                    GemmDesc8 g8; g8.A = (const unsigned char*)hbk + (long)mt * 128 * D; g8.lda = D; g8.B = wkr8; g8.ldb = 1024; g8.K = 1024; g8.aidx = nullptr; g8.aidx_stride = 0; g8.mvalid = 128;
                    GEMM8_SEL(1, g8, acc);
                } else GEMM_SEL(2, g, acc);
#pragma unroll
                for (int mb = 0; mb < 4; ++mb) {
                    const int t = mt * 128 + wr * 64 + mb * 16 + fr;
                    const float* sp = ssq + (long)t * 8;
                    float rs = 1.f;
                    if (kind == 0) rs = rsqrtf((sp[0] + sp[1] + sp[2] + sp[3]) * (1.0f / 256.0f) + EPS);
                    else if (kind == 1) rs = rsqrtf((sp[4] + sp[5]) * (1.0f / 128.0f) + EPS);
#pragma unroll
                    for (int nb = 0; nb < 4; ++nb) {
                        const int cl = wc * 64 + nb * 16 + fq * 4;
                        const f32x4 a = acc[mb][nb] * (kind == 3 ? 1.0f / W8_SCALE : rs);
                        if (kind == 0) {
                            const int col = nt * 128 + cl;
                            if (col < 576) { u32x2 w2; w2.x = cvt_pk_bf16(a[0], a[1]); w2.y = cvt_pk_bf16(a[2], a[3]); *(u32x2*)(qraw + (long)t * 576 + col) = w2; }
                        } else if (kind == 1) {
                            const int col = nt * 128 + cl;
                            if (nt < 3) { u32x2 w2; w2.x = cvt_pk_bf16(a[0], a[1]); w2.y = cvt_pk_bf16(a[2], a[3]); *(u32x2*)(knraw + (long)t * 384 + col) = w2; }
                            else {
#pragma unroll
                                for (int j = 0; j < 4; ++j) vmt[(long)(col - 384 + j) * T + t] = f2bf(a[j]);
                            }
                        } else if (kind == 3) {
                            if (cl < 32) { u32x2 w2; w2.x = cvt_pk_bf16(a[0], a[1]); w2.y = cvt_pk_bf16(a[2], a[3]); *(u32x2*)(pbw + (long)t * DIN + PC_KR + cl) = w2; }
                        } else {
                            const int cs = cl >> 6, row = nt * 64 + (cl & 63);
                            bf16_t* dst = t < TL ? abt + ((long)(t >> 11) * 256 + row) * 4096 + cs * 2048 + (t & 2047)
                                                 : abt + (long)8 * 256 * 4096 + ((long)((t - TL) >> 8) * 256 + row) * 512 + cs * 256 + ((t - TL) & 255);
#pragma unroll
                            for (int j = 0; j < 4; ++j) dst[(long)j * (t < TL ? 4096 : 512)] = f2bf(a[j]);
                        }
                    }
                }
            }
            LSEAM(pb + 2); TSTAMP(3);
        }
        if (EN(4) && IN(pb + 3)) { TID_ENTER(); int l = l0; LAUNDER_S(l); phase_prep(P, l, tid, xq, slot, nsl); LSEAM(pb + 3); TSTAMP(4); }
        if (EN(5) && IN(pb + 4)) {
            PHASE_ENTER();
            const bf16_t* qraw = (const bf16_t*)(ws + WS_QRAW); const bf16_t* km = (const bf16_t*)(ws + WS_KM); const bf16_t* vmt = (const bf16_t*)(ws + WS_VMT);
            const bf16_t* pbq = (const bf16_t*)(ws + WS_PBUF); const bf16_t* ks = (const bf16_t*)(ws + WS_KS); const bf16_t* vst = (const bf16_t*)(ws + WS_VST);
            const float2* ropeS = (const float2*)(ws + WS_ROPES); const float2* ropeM = (const float2*)(ws + WS_ROPEM);
            const bf16_t* abt = (const bf16_t*)(ws + WS_ABT); const bf16_t* csl = (const bf16_t*)(ws + WS_CS); const bf16_t* csc = (const bf16_t*)(ws + WS_CSC);
            unsigned char* outx = ws + WS_OUTX;
            constexpr int NPOS = 2048;
            (void)NPOS;
            for (int rnd = 0; rnd < 4; ++rnd) for (int vs = slot; vs < 64; vs += nsl) {
                int kind = -1, v = 0;
                const int xb = xq, sl = vs - 16;
                if (rnd == 0) { if (vs < 16) { kind = 1; v = xb * 16 + vs; } else { kind = 0; v = xb * 96 + sl; } }
                else if (rnd == 1) { if (vs < 16) { if (!last) { if (vs < 12) { kind = 3; v = xb * 12 + vs; } else { kind = 5; v = xb * 4 + (vs - 12); } } } else { kind = 0; v = xb * 96 + 48 + sl; } }
                else if (rnd == 2) { if (vs < 12) { if (!last) { kind = 4; v = xb * 12 + vs; } } else if (vs == 12) { kind = 6; v = xb; } else if (vs >= 16) { kind = 2; v = xb * 96 + sl; } }
                else { if (vs >= 16) { kind = 2; v = xb * 96 + 48 + sl; } }
                if (kind == 0) {
                    const int b = v / 96, r = v % 96, h = r >> 4, qb = r & 15;
                    const int qt = b * SEQ + qb * 128;
                    attn_unit<96, false>(qraw + (long)qt * 576 + h * 96, 576, km + h * 96, 576, vmt + (long)h * 64 * T,
                                         b * SEQ, 16, TL + b * CL, 2, 0, 0, 0.f, false, outx + (long)qt * D + 256 + h * 64, lds, tid,
                                         P.in[I_MQG] + l * 96, ropeM, qb * 128, 0.10206207261596577f * LOG2E);
                } else if (kind == 1) {
                    const int b = v >> 4, mt = (v >> 1) & 7, nt = v & 1;
                    GemmDesc g; g.A = csl + (long)mt * 128 * 4096; g.lda = 4096; g.B = abt + ((long)b * 256 + nt * 128) * 4096; g.ldb = 4096; g.K = 2048;
                    g.aidx = nullptr; g.aidx_stride = 0; g.mvalid = 128;
                    f32x4 acc[4][4], acc2[4][4];
                    GEMM_SEL(3, g, acc);
                    g.A += 2048; g.B += 2048;
                    GEMM_SEL(3, g, acc2);
#pragma unroll
                    for (int mb = 0; mb < 4; ++mb) {
                        const int np = mt * 128 + wr * 64 + mb * 16 + fr;
                        const long t1 = (long)b * SEQ + np, t2 = (long)b * SEQ + ((SEQ - np) & (SEQ - 1));
#pragma unroll
                        for (int nb = 0; nb < 4; ++nb) {
                            const f32x4 p = acc[mb][nb] + acc2[mb][nb], m = acc[mb][nb] - acc2[mb][nb];
                            const int col = nt * 128 + wc * 64 + nb * 16 + fq * 4;
                            *(unsigned*)(outx + t1 * D + col) = cvt4_fp8(p[0] * OUT8_SCALE, p[1] * OUT8_SCALE, p[2] * OUT8_SCALE, p[3] * OUT8_SCALE);
                            if (np != 0) *(unsigned*)(outx + t2 * D + col) = cvt4_fp8(m[0] * OUT8_SCALE, m[1] * OUT8_SCALE, m[2] * OUT8_SCALE, m[3] * OUT8_SCALE);
                        }
                    }
                } else if (kind == 6) {
                    const int b = v;
                    const bf16_t* arow = abt + ((long)b * 256 + tid) * 4096;
                    float s0 = 0.f, s1 = 0.f, s2 = 0.f, s3 = 0.f;
                    for (int n = 0; n < 2048; n += 16) {
                        const u32x4 q0 = *(const u32x4*)(arow + n), q1 = *(const u32x4*)(arow + n + 8);
                        s0 += bf_lo(q0.x) - bf_hi(q0.x) + bf_lo(q0.y) - bf_hi(q0.y);
                        s1 += bf_lo(q0.z) - bf_hi(q0.z) + bf_lo(q0.w) - bf_hi(q0.w);
                        s2 += bf_lo(q1.x) - bf_hi(q1.x) + bf_lo(q1.y) - bf_hi(q1.y);
                        s3 += bf_lo(q1.z) - bf_hi(q1.z) + bf_lo(q1.w) - bf_hi(q1.w);
                    }
                    const float cN = bf_lo(cvt_pk_bf16(0.022097086912079608f, 0.f));
                    outx[((long)b * SEQ + 1024) * D + tid] = (unsigned char)(cvt4_fp8(((s0 + s1) + (s2 + s3)) * cN * OUT8_SCALE, 0.f, 0.f, 0.f) & 0xffu);
                } else if (kind == 2) {
                    const int b = v / 96, r = v % 96, h = r >> 4, qb = r & 15, kvh = h / 3;
                    const int qt = b * SEQ + qb * 128;
                    int k0 = qb * 128 - 128; if (k0 < 0) k0 = 0;
                    int k1 = qb * 128 + 256; if (k1 > SEQ) k1 = SEQ;
                    const float sink2 = P.in[I_SINK][l * 6 + h] * LOG2E;
                    attn_unit<64, true>(pbq + (long)qt * DIN + PC_QS + h * 64, DIN, ks + kvh * 64, 128, vst + (long)kvh * 64 * T,
                                        b * SEQ + k0, (k1 - k0) >> 7, TL + b * CL, 2, qb * 128, k0, sink2, true, outx + (long)qt * D + 640 + h * 64, lds, tid,
                                        P.in[I_SQG] + l * 64, ropeS, qb * 128, 0.125f * LOG2E);
                } else if (kind == 3) {
                    const int b = v / 12, r = v % 12, h = r >> 1, qb = r & 1;
                    const int qt = TL + b * CL + qb * 128;
                    attn_unit<96, false>(qraw + (long)qt * 576 + h * 96, 576, km + h * 96, 576, vmt + (long)h * 64 * T,
                                         TL + b * CL, 2, 0, 0, 0, 0, 0.f, false, outx + (long)qt * D + 256 + h * 64, lds, tid,
                                         P.in[I_MQG] + l * 96, nullptr, 0, 0.10206207261596577f * LOG2E);
                } else if (kind == 4) {
                    const int b = v / 12, r = v % 12, h = r >> 1, qb = r & 1, kvh = h / 3;
                    const int qt = TL + b * CL + qb * 128;
                    const float sink2 = P.in[I_SINK][l * 6 + h] * LOG2E;
                    attn_unit<64, false>(pbq + (long)qt * DIN + PC_QS + h * 64, DIN, ks + kvh * 64, 128, vst + (long)kvh * 64 * T,
                                         TL + b * CL, 2, 0, 0, 0, 0, sink2, true, outx + (long)qt * D + 640 + h * 64, lds, tid,
                                         P.in[I_SQG] + l * 64, nullptr, 0, 0.125f * LOG2E);
                } else if (kind == 5) {
                    const int b = v >> 2, mt = (v >> 1) & 1, nt = v & 1;
                    GemmDesc g; g.A = csc + (long)mt * 128 * 512; g.lda = 512; g.B = abt + (long)8 * 256 * 4096 + ((long)b * 256 + nt * 128) * 512; g.ldb = 512; g.K = 512;
                    g.aidx = nullptr; g.aidx_stride = 0; g.mvalid = 128;
                    f32x4 acc[4][4];
                    GEMM_SEL(4, g, acc);
                    int tl = tid; asm volatile("" : "+v"(tl));
                    const int ln_ = tl & 63, wd_ = tl >> 6, wr_ = wd_ >> 1, wc_ = wd_ & 1, fr_ = ln_ & 15, fq_ = ln_ >> 4;
#pragma unroll
                    for (int mb = 0; mb < 4; ++mb) {
                        const int t = TL + b * CL + mt * 128 + wr_ * 64 + mb * 16 + fr_;
#pragma unroll
                        for (int nb = 0; nb < 4; ++nb) { const f32x4 a = acc[mb][nb] * OUT8_SCALE;
                            *(unsigned*)(outx + (long)t * D + nt * 128 + wc_ * 64 + nb * 16 + fq_ * 4) = cvt4_fp8(a[0], a[1], a[2], a[3]); }
                    }
                }
            }
            LSEAM(pb + 4); TSTAMP(5);
        }
        if (EN(6) && IN(pb + 5)) {
            PHASE_ENTER();
            const unsigned char* outx = ws + WS_OUTX;
            const unsigned char* w = ws + WS_WOUT + (size_t)l * 1024 * 1024;
            const int nu = MT_Q * 8;
            for (int u_ = slot; u_ < (last ? 16 : 18) * 8; u_ += nsl) {
                const int mt = BRT(u_ >> 3), nt = u_ & 7;
                GemmDesc8 g; g.A = outx + (long)mt * 128 * D; g.lda = D; g.B = w + (long)nt * 128 * 1024; g.ldb = 1024; g.K = 1024; g.aidx = nullptr; g.aidx_stride = 0; g.mvalid = 128;
                f32x4 acc[4][4];
                GEMM8_SEL(5, g, acc);
#pragma unroll
                for (int mb = 0; mb < 4; ++mb) {
                    const int t = mt * 128 + wr * 64 + mb * 16 + fr;
                    const int r = t < TL ? (t >> 11) : 8;
                    float* xr = xrow(P, t);
                    const float* g1 = mod + ((long)l * 9 + r) * 6144 + 2048;
#pragma unroll
                    for (int nb = 0; nb < 4; ++nb) {
                        const int col = nt * 128 + wc * 64 + nb * 16 + fq * 4;
                        const f32x4 gv = *(const f32x4*)(g1 + col);
                        f32x4 xv = *(f32x4*)(xr + col);
                        xv += gv * (acc[mb][nb] * (1.0f / (W8_SCALE * OUT8_SCALE)));
                        *(f32x4*)(xr + col) = xv;
                    }
                }
            }
            LSEAM(pb + 5); TSTAMP(6);
        }
        if (EN(7) && IN(pb + 6)) { TID_ENTER(); int l = l0; LAUNDER_S(l); phase_norm2_router(P, l, lds, tid, xq, slot, nsl); SEAM(pb + 6); TSTAMP(7); }
        if (EN(8) && (IN(pb + 7) || IN(pb + 8))) {
            PHASE_ENTER();
            const int* cnt = (const int*)(ws + WS_CTL + CTL_CNT_OFF) + l * 16 * 32;
            const int2* list = (const int2*)(ws + WS_LIST);
            const bf16_t* hb = (const bf16_t*)(ws + WS_HBUF);
            bf16_t* act = (bf16_t*)(ws + WS_ACT); bf16_t* ysl = (bf16_t*)(ws + WS_YSLOT);
            const unsigned char* wgu8 = ws + WS_WGU + (size_t)l * NE * 1024 * 1024;
            const unsigned char* wdn8 = ws + WS_WDN + (size_t)l * NE * 1024 * 512;
            int tstart[17];
            {
                int s = 0;
#pragma unroll
                for (int e = 0; e < 16; ++e) { tstart[e] = s; s += (__builtin_amdgcn_readfirstlane(cnt[e * 32]) + 127) >> 7; }
                tstart[16] = s;
            }
            const int nu = tstart[16] * 8;
            if (IN(pb + 7)) {
                XCD_LOOP(tstart[16], 8, rt, nt) {
                    int e = 0;
#pragma unroll
                    for (int j = 1; j < 16; ++j) if (rt >= tstart[j]) e = j;
                    int ts_e = 0;
#pragma unroll
                    for (int j = 0; j < 16; ++j) if (j == e) ts_e = tstart[j];
                    const int mt = rt - ts_e, ce = cnt[e * 32], mv = (ce - mt * 128) < 128 ? (ce - mt * 128) : 128;
                    GemmDesc8 g; g.A = (const unsigned char*)hb; g.lda = D; g.B = (const unsigned char*)wgu8 + ((long)e * 1024 + nt * 128) * 1024; g.ldb = 1024; g.K = 1024;
                    g.aidx = (const int*)(list + (long)e * T + mt * 128); g.aidx_stride = 2; g.mvalid = mv;
                    f32x4 acc[4][4];
                    GEMM8_SEL(6, g, acc);
#pragma unroll
                    for (int mb = 0; mb < 4; ++mb) {
                        const int rl = wr * 64 + mb * 16 + fr;
                        if (rl < mv) {
                            unsigned char* ar = (unsigned char*)act + ((long)rt * 128 + rl) * DE + nt * 64 + wc * 32 + fq * 4;
#pragma unroll
                            for (int p = 0; p < 2; ++p) {
                                const f32x4 gt = acc[mb][2 * p] * (1.0f / W8_SCALE), up = acc[mb][2 * p + 1] * (ACT8_SCALE / W8_SCALE);
                                *(unsigned*)(ar + p * 16) = cvt4_fp8(silu_f(gt[0]) * up[0], silu_f(gt[1]) * up[1], silu_f(gt[2]) * up[2], silu_f(gt[3]) * up[3]);
                            }
                        }
                    }
                }
                SEAM(pb + 7); TSTAMP(8);
            }
            if (IN(pb + 8)) {
                XCD_LOOP(tstart[16], 8, rt, nt) {
                    int e = 0;
#pragma unroll
                    for (int j = 1; j < 16; ++j) if (rt >= tstart[j]) e = j;
                    int ts_e = 0;
#pragma unroll
                    for (int j = 0; j < 16; ++j) if (j == e) ts_e = tstart[j];
                    const int mt = rt - ts_e, ce = cnt[e * 32], mv = (ce - mt * 128) < 128 ? (ce - mt * 128) : 128;
                    GemmDesc8 g; g.A = (const unsigned char*)act + (long)rt * 128 * DE; g.lda = DE; g.B = (const unsigned char*)wdn8 + ((long)e * 1024 + nt * 128) * 512; g.ldb = 512; g.K = 512;
                    g.aidx = nullptr; g.aidx_stride = 0; g.mvalid = 128;
                    f32x4 acc[4][4];
                    GEMM8_SEL(7, g, acc);
#pragma unroll
                    for (int mb = 0; mb < 4; ++mb) {
                        const int rl = wr * 64 + mb * 16 + fr;
                        if (rl < mv) {
                            const int2 le = list[(long)e * T + mt * 128 + rl];
                            const float wgt = __int_as_float(le.y) * (1.0f / (ACT8_SCALE * W8_SCALE));
                            bf16_t* yr = ysl + (long)le.x * D + nt * 128 + wc * 64 + fq * 4;
#pragma unroll
                            for (int nb = 0; nb < 4; ++nb) { const f32x4 a = acc[mb][nb] * wgt; u32x2 w2; w2.x = cvt_pk_bf16(a[0], a[1]); w2.y = cvt_pk_bf16(a[2], a[3]); *(u32x2*)(yr + nb * 16) = w2; }
                        }
                    }
                }
                SEAM(pb + 8); TSTAMP(9);
            }
        }
    }
    if (EN(9) && IN(1 + DEPTH * 9)) { TID_ENTER(); phase_final(P, tid); }
#undef IN
#undef SEAM
}


#ifndef DUMP_MASK
#define DUMP_MASK 0
#endif
__device__ __forceinline__ float dbg_ld(const unsigned char* ws, size_t off, size_t len, size_t i) { return bf2f(((const bf16_t*)(ws + off))[i % len]); }
__global__ void dump_kernel(float* out, const unsigned char* ws, int mask) {
    const size_t n = (size_t)TL * D;
    for (size_t i = (size_t)blockIdx.x * blockDim.x + threadIdx.x; i < n; i += (size_t)gridDim.x * blockDim.x) {
        float v = 0.f;
        if (mask & 1) v += dbg_ld(ws, WS_HBUF, (size_t)T * D, i);
        if (mask & 2) v += dbg_ld(ws, WS_PBUF, (size_t)T * DIN, i) + dbg_ld(ws, WS_PBUF, (size_t)T * DIN, i + 7500000) + dbg_ld(ws, WS_VST, (size_t)128 * T, i);
        if (mask & 4) v += dbg_ld(ws, WS_QRAW, (size_t)T * 576, i) + dbg_ld(ws, WS_KNRAW, (size_t)T * 384, i) + dbg_ld(ws, WS_VMT, (size_t)T * 384, i) + dbg_ld(ws, WS_ABT, (size_t)T * 512, i);
        if (mask & 8) v += dbg_ld(ws, WS_QM, (size_t)T * 576, i) + dbg_ld(ws, WS_KM, (size_t)T * 576, i) + dbg_ld(ws, WS_QS, (size_t)T * 384, i) + dbg_ld(ws, WS_KS, (size_t)T * 128, i);
        if (mask & 16) v += dbg_ld(ws, WS_OUTX, (size_t)T * D, i);
        { const int c = (int)(i & 1023); const bool sel = ((mask & 64) && c < 256) || ((mask & 128) && c >= 256 && c < 640) || ((mask & 256) && c >= 640);
          if (sel) v += dbg_ld(ws, WS_OUTX, (size_t)T * D, i); }
        if (mask & 32) v += dbg_ld(ws, WS_CS, (size_t)2048 * 4096, i) + dbg_ld(ws, WS_WOUT, (size_t)4 * 1024 * 1024, i) + dbg_ld(ws, WS_WGU, (size_t)64 * 1024 * 1024, i) + dbg_ld(ws, WS_WDN, (size_t)64 * 1024 * 512, i)
                         + ((const float*)(ws + WS_MOD))[i % (size_t)(4 * 9 * 6144)] + ((const float*)(ws + WS_ROPES))[i % (size_t)(2048 * 64)] + ((const float*)(ws + WS_ROPEM))[i % (size_t)(2048 * 32)] + dbg_ld(ws, WS_FW, (size_t)16 * 128 * 128, i);
        out[i] = v;
    }
}
extern "C" void kernel_launch(void* const* d_in, const int* in_sizes, int n_in, void* d_out, int out_size, void* d_ws, size_t ws_size, hipStream_t stream) {
    static int grid = 0;
    if (grid == 0) {
        if (n_in != 26 || ws_size < WS_END) { fprintf(stderr, "kernel_launch: expected 26 inputs and >= %zu bytes of workspace (got %d, %zu)\n", (size_t)WS_END, n_in, ws_size); grid = -1; return; }
        int dev = 0, cus = 0, per_cu = 0;
        hipGetDevice(&dev);
        hipDeviceGetAttribute(&cus, hipDeviceAttributeMultiprocessorCount, dev);
        hipFuncSetAttribute((const void*)fwd_kernel, hipFuncAttributeMaxDynamicSharedMemorySize, LDS_BYTES);
        if (hipOccupancyMaxActiveBlocksPerMultiprocessor(&per_cu, (const void*)fwd_kernel, NTHREADS, LDS_BYTES) != hipSuccess || per_cu < 1) per_cu = 1;
        (void)hipGetLastError();
        grid = cus * (per_cu < 2 ? per_cu : 2);
    }
    if (grid < 0) return;
    hipMemsetAsync((char*)d_ws + WS_CTL, 0, CTL_BYTES, stream);
    Params p{};
    for (int i = 0; i < 26; ++i) p.in[i] = (const float*)d_in[i];
    p.out = (float*)d_out; p.ws = (unsigned char*)d_ws;
#ifndef STOP_PH
#define STOP_PH (2 + DEPTH * 9)
#endif
    constexpr int NPH = STOP_PH;
#if N_LAUNCH_MODE == 1
    p.ph_lo = 0; p.ph_hi = NPH;
    hipLaunchKernelGGL(fwd_kernel, dim3(grid), dim3(NTHREADS), LDS_BYTES, stream, p);
#else
    for (int k = 0; k < NPH; ++k) { p.ph_lo = k; p.ph_hi = k + 1; hipLaunchKernelGGL(fwd_kernel, dim3(grid), dim3(NTHREADS), LDS_BYTES, stream, p); }
#endif
    if (DUMP_MASK) hipLaunchKernelGGL(dump_kernel, dim3(1024), dim3(256), 0, stream, (float*)d_out, (const unsigned char*)d_ws, (int)DUMP_MASK);
}
```

```cpp
#include <hip/hip_runtime.h>
#include <cstdint>
#include <cstdio>

#ifndef PROBE_SEL1
#define PROBE_SEL1 -1
#endif
#ifndef PROBE_SEL2
#define PROBE_SEL2 -1
#endif
#ifndef N_LAUNCH_MODE
#define N_LAUNCH_MODE 1
#endif

#define LAS __attribute__((address_space(3)))
typedef unsigned short bf16_t;
typedef short bf16x8 __attribute__((ext_vector_type(8)));
typedef float f32x4 __attribute__((ext_vector_type(4)));
typedef float f32x16 __attribute__((ext_vector_type(16)));
typedef unsigned u32x4 __attribute__((ext_vector_type(4)));
typedef unsigned u32x2 __attribute__((ext_vector_type(2)));

constexpr int D = 1024, NB = 8, SEQ = 2048, CL = 256, DEPTH = 4;
constexpr int TL = NB * SEQ, TC = NB * CL, T = TL + TC;
constexpr int DIN = 1312, DINP = 1408;
constexpr int NE = 16, DE = 512;
constexpr int PC_CQ = 256, PC_CKV = 512, PC_QS = 640, PC_KS = 1024, PC_VS = 1152, PC_KR = 1280;
constexpr float EPS = 1e-6f;
constexpr float LOG2E = 1.4426950408889634f;
constexpr int NTHREADS = 256;
constexpr int LDS_BYTES = 81920;

constexpr size_t al256(size_t x) { return (x + 255) & ~(size_t)255; }
constexpr size_t WS_CTL = 0;
constexpr size_t CTL_BYTES = 32768;
constexpr size_t CTL_CNT_OFF = 16384;
constexpr size_t CTL_Q_OFF = 26624;
constexpr size_t CTL_LB_OFF = 28672;
constexpr size_t CTL_SB_OFF = 29696;
constexpr size_t WS_MOD = WS_CTL + CTL_BYTES;
constexpr size_t WS_ROPES = WS_MOD + al256((size_t)DEPTH * 9 * 6144 * 4);
constexpr size_t WS_ROPEM = WS_ROPES + (size_t)2048 * 32 * 8;
constexpr size_t WS_FW = WS_ROPEM + (size_t)2048 * 16 * 8;
constexpr size_t WS_CS = WS_FW + (size_t)DEPTH * 4 * 128 * 128 * 2;
constexpr size_t WS_CSC = WS_CS + (size_t)2048 * 4096 * 2;
constexpr size_t WS_WIN = WS_CSC + (size_t)256 * 512 * 2;
constexpr size_t WS_WUQ = WS_WIN + (size_t)DEPTH * DINP * 1024;
constexpr size_t WS_WUKV = WS_WUQ + (size_t)DEPTH * 640 * 256 * 2;
constexpr size_t WS_WOUT = WS_WUKV + (size_t)DEPTH * 768 * 128 * 2;
constexpr size_t WS_WGU = WS_WOUT + (size_t)DEPTH * 1024 * 1024;
constexpr size_t WS_WDN = WS_WGU + (size_t)DEPTH * NE * 1024 * 1024;
constexpr size_t WS_CTX = WS_WDN + (size_t)DEPTH * NE * 1024 * 512;
constexpr size_t WS_SSQ = WS_CTX + (size_t)TC * D * 4;
constexpr size_t WS_HBUF = WS_SSQ + (size_t)T * 8 * 4;
constexpr size_t WS_R = WS_HBUF + (size_t)T * D * 2;
constexpr size_t WS_PBUF = WS_R;
constexpr size_t WS_QRAW = WS_PBUF + (size_t)T * DIN * 2;
constexpr size_t WS_KNRAW = WS_QRAW + (size_t)T * 576 * 2;
constexpr size_t WS_QM = WS_KNRAW + (size_t)T * 384 * 2;
constexpr size_t WS_KM = WS_QM + (size_t)T * 576 * 2;
constexpr size_t WS_VMT = WS_KM + (size_t)T * 576 * 2;
constexpr size_t WS_QS = WS_VMT + (size_t)384 * T * 2;
constexpr size_t WS_KS = WS_QS + (size_t)T * 384 * 2;
constexpr size_t WS_VST = WS_KS + (size_t)T * 128 * 2;
constexpr size_t WS_ABT = WS_VST + (size_t)128 * T * 2;
constexpr size_t WS_OUTX = WS_ABT + (size_t)512 * T * 2;
constexpr size_t WS_MIX_END = WS_OUTX + (size_t)T * D * 2;
constexpr size_t WS_ACT = WS_R;
constexpr size_t WS_LIST = WS_MIX_END;
constexpr size_t WS_YSLOT = WS_LIST + (size_t)NE * T * 8;
constexpr size_t WS_MOE_END = WS_YSLOT + (size_t)2 * T * D * 2;
constexpr size_t WS_TS = WS_MIX_END > WS_MOE_END ? WS_MIX_END : WS_MOE_END;
constexpr size_t WS_END = WS_TS + 1024 * 16 * 8;

#define XB_TMO      128
#define XB_XCNT(j)  (256  + 64 * (j))
#define XB_XSUB(j)  (1280 + 64 * (j))
#define XB_XGEN(j)  (2304 + 64 * (j))
#define XB_TOP      3328
#define XB_TOPGEN   3392
#define XCD_BAR_WORDS 3456
#define XB_SPIN_CAP (1u << 22)

__device__ __forceinline__ unsigned xb_ld(unsigned* p)              { return __hip_atomic_load(p, __ATOMIC_RELAXED, __HIP_MEMORY_SCOPE_AGENT); }
__device__ __forceinline__ unsigned xb_add(unsigned* p, unsigned v) { return __hip_atomic_fetch_add(p, v, __ATOMIC_RELAXED, __HIP_MEMORY_SCOPE_AGENT); }
__device__ __forceinline__ unsigned xb_xcc_id() { return (unsigned)__builtin_amdgcn_s_getreg((3 << 11) | 20) & 0xFu; }
#define XB_SPIN(cond, bar) do { unsigned _sp = 0; while (cond) { __builtin_amdgcn_s_sleep(1); \
    if ((++_sp & 255u) == 0u) { if (xb_ld(&(bar)[XB_TMO])) break; if (_sp > XB_SPIN_CAP) { atomicAdd(&(bar)[XB_TMO], 1u); break; } } } } while (0)

struct XcdBarrier { unsigned* bar; unsigned x; unsigned nloc, nx; };

__device__ __forceinline__ XcdBarrier xcd_barrier_post(unsigned* bar, unsigned& slot0) {
    XcdBarrier b; b.bar = bar; b.x = xb_xcc_id(); b.nloc = 0u; b.nx = 0u;
    if (threadIdx.x == 0) slot0 = xb_add(&bar[XB_XCNT(b.x)], 1u);
    return b;
}
__device__ __forceinline__ void xcd_local_barrier(unsigned* bar, unsigned* cnt, unsigned& gen, unsigned nsl) {
    asm volatile("s_waitcnt vmcnt(0)" ::: "memory");
    __syncthreads();
    ++gen;
    if (threadIdx.x == 0) {
        __builtin_amdgcn_s_waitcnt(0);
        (void)xb_add(cnt, 1u);
        const unsigned want = gen * nsl;
        XB_SPIN(xb_ld(cnt) < want, bar);
        __builtin_amdgcn_fence(__ATOMIC_ACQUIRE, "agent");
        asm volatile("s_waitcnt vmcnt(0)" ::: "memory");
    }
    __syncthreads();
}
__device__ __forceinline__ void xcd_barrier_complete(unsigned* bar, unsigned x, unsigned& nloc, unsigned& nx) {
    const unsigned G = gridDim.x * gridDim.y * gridDim.z;
    unsigned sum, cnt, mine, sp = 0u;
    for (;;) {
        sum = 0u; cnt = 0u; mine = 0u;
#pragma unroll
        for (unsigned j = 0; j < 16; ++j) { const unsigned c = xb_ld(&bar[XB_XCNT(j)]); sum += c; cnt += (c > 0u) ? 1u : 0u; mine = (j == x) ? c : mine; }
        if (sum == G) break;
        __builtin_amdgcn_s_sleep(1);
        if ((++sp & 255u) == 0u) { if (xb_ld(&bar[XB_TMO])) break; if (sp > XB_SPIN_CAP) { atomicAdd(&bar[XB_TMO], 1u); break; } }
    }
    nloc = mine > 0u ? mine : 1u; nx = cnt > 0u ? cnt : 1u;
}
__device__ __forceinline__ void xcd_barrier(XcdBarrier& b) {
    asm volatile("s_waitcnt vmcnt(0)" ::: "memory");
    __syncthreads();
    unsigned nl_out = b.nloc, nx_out = b.nx;
    if (threadIdx.x == 0) {
        unsigned* bar = b.bar;
        __builtin_amdgcn_s_waitcnt(0);
        unsigned nloc = b.nloc, nx = b.nx;
        if (nloc == 0u) { xcd_barrier_complete(bar, b.x, nloc, nx); b.nloc = nloc; b.nx = nx; }
        nl_out = nloc; nx_out = nx;
        const unsigned old = xb_add(&bar[XB_XSUB(b.x)], 1u);
        const unsigned gen = old / nloc;
        if (old + 1u == (gen + 1u) * nloc) {
            __builtin_amdgcn_fence(__ATOMIC_RELEASE, "agent");
            asm volatile("s_waitcnt vmcnt(0)" ::: "memory");
            const unsigned og = xb_add(&bar[XB_TOP], 1u);
            const unsigned tg = og / nx;
            if (og + 1u == (tg + 1u) * nx) xb_add(&bar[XB_TOPGEN], 1u);
            else XB_SPIN(xb_ld(&bar[XB_TOPGEN]) == tg, bar);
            __builtin_amdgcn_fence(__ATOMIC_ACQUIRE, "agent");
            xb_add(&bar[XB_XGEN(b.x)], 1u);
            asm volatile("s_waitcnt vmcnt(0)" ::: "memory");
        } else {
            XB_SPIN(xb_ld(&bar[XB_XGEN(b.x)]) == gen, bar);
            __builtin_amdgcn_fence(__ATOMIC_ACQUIRE, "agent");
            asm volatile("s_waitcnt vmcnt(0)" ::: "memory");
        }
    }
    b.nloc = __builtin_amdgcn_readfirstlane(nl_out); b.nx = __builtin_amdgcn_readfirstlane(nx_out);
    __syncthreads();
}

typedef float cvt_f2_t __attribute__((ext_vector_type(2)));
typedef __bf16 cvt_b2_t __attribute__((ext_vector_type(2)));
__device__ __forceinline__ unsigned cvt_pk_bf16(float lo, float hi) { const cvt_f2_t v = {lo, hi}; const cvt_b2_t r = __builtin_convertvector(v, cvt_b2_t); return __builtin_bit_cast(unsigned, r); }
__device__ __forceinline__ float bf2f(bf16_t v) { return __uint_as_float((unsigned)v << 16); }
__device__ __forceinline__ bf16_t f2bf(float v) { return (bf16_t)(cvt_pk_bf16(v, 0.f) & 0xffffu); }
__device__ __forceinline__ float bf_lo(unsigned w) { return __uint_as_float(w << 16); }
__device__ __forceinline__ float bf_hi(unsigned w) { return __uint_as_float(w & 0xffff0000u); }
template <int CTRL> __device__ __forceinline__ float dpp_mov(float v) { return __builtin_bit_cast(float, __builtin_amdgcn_update_dpp(0, __builtin_bit_cast(int, v), CTRL, 0xF, 0xF, true)); }
__device__ __forceinline__ float wave_sum16(const float (&p)[16], const int lane) {
    float q8[8], q4[4], q2[2];
    const bool b3 = (lane & 8) != 0, b2 = (lane & 4) != 0, b1 = (lane & 2) != 0, b0 = (lane & 1) != 0;
#pragma unroll
    for (int j = 0; j < 8; ++j) { const float keep = b3 ? p[j + 8] : p[j], send = b3 ? p[j] : p[j + 8]; q8[j] = keep + dpp_mov<0x128>(send); }
#pragma unroll
    for (int j = 0; j < 4; ++j) { const float keep = b2 ? q8[j + 4] : q8[j], send = b2 ? q8[j] : q8[j + 4]; q4[j] = keep + dpp_mov<0x141>(send); }
#pragma unroll
    for (int j = 0; j < 2; ++j) { const float keep = b1 ? q4[j + 2] : q4[j], send = b1 ? q4[j] : q4[j + 2]; q2[j] = keep + dpp_mov<0x4E>(send); }
    float t = (b0 ? q2[1] : q2[0]) + dpp_mov<0xB1>(b0 ? q2[0] : q2[1]);
    t += __shfl_xor(t, 16);
    t += __shfl_xor(t, 32);
    return t;
}
__device__ __forceinline__ float wave_sum(float v) {
    v += dpp_mov<0xB1>(v);
    v += dpp_mov<0x4E>(v);
    v += dpp_mov<0x141>(v);
    v += dpp_mov<0x140>(v);
    const int vi = __builtin_bit_cast(int, v);
    const float r0 = __builtin_bit_cast(float, __builtin_amdgcn_readlane(vi, 0)), r1 = __builtin_bit_cast(float, __builtin_amdgcn_readlane(vi, 16)), r2 = __builtin_bit_cast(float, __builtin_amdgcn_readlane(vi, 32)), r3 = __builtin_bit_cast(float, __builtin_amdgcn_readlane(vi, 48));
    return (r0 + r1) + (r2 + r3);
}
__device__ __forceinline__ float fast_exp2(float x) { return __builtin_amdgcn_exp2f(x); }
__device__ __forceinline__ float silu_f(float v) { return v / (1.0f + __expf(-v)); }
#define VM_WAIT0() asm volatile("s_waitcnt vmcnt(0)" ::: "memory")
#define LAUNDER_S(x) asm volatile("" : "+s"(x))
#define GLDS16S(sbase, voff, m0v) asm volatile("s_mov_b32 m0, %2\n\ts_nop 0\n\tglobal_load_lds_dwordx4 %0, %1\n\ts_nop 1" :: "v"(voff), "s"(sbase), "s"(m0v) : "memory")
#define GLDS16S_NT(sbase, voff, m0v) asm volatile("s_mov_b32 m0, %2\n\ts_nop 0\n\tglobal_load_lds_dwordx4 %0, %1 nt\n\ts_nop 1" :: "v"(voff), "s"(sbase), "s"(m0v) : "memory")

struct Params {
    const float* in[26];
    float* out;
    unsigned char* ws;
    int ph_lo, ph_hi;
};
enum { I_X = 0, I_C, I_CTX, I_CCTX, I_ADAW, I_ADAB, I_N1G, I_N2G, I_WIN, I_FNETW, I_CQG, I_CKVG, I_WUQ, I_WUK, I_WUV, I_MQG, I_MKG, I_SQG, I_SKG, I_SINK, I_WOUT, I_RW, I_RB, I_EG, I_EU, I_ED };

struct GemmDesc {
    const bf16_t* A; const bf16_t* B;
    long lda, ldb;
    int K;
    const int* aidx; int aidx_stride;
    int mvalid;
};

#define VM_WAITN(n) asm volatile("s_waitcnt vmcnt(" #n ")" ::: "memory")
#define RING_STEP(J, WAITN, ISSUE) do { VM_WAITN(WAITN); __syncthreads(); if (ISSUE) RING_STAGE(t + (J) + 3, ((J) + 3) & 3); RING_COMPUTE(J); } while (0)
#define RING_LOOP() do { \
    RING_STAGE(0, 0); RING_STAGE(1, 1); RING_STAGE(2, 2); \
    int t = 0; \
    for (; t + 4 < nt; t += 4) { RING_STEP(0, 8, true); RING_STEP(1, 8, true); RING_STEP(2, 8, true); RING_STEP(3, 8, true); } \
    RING_STEP(0, 8, true); RING_STEP(1, 8, false); RING_STEP(2, 4, false); RING_STEP(3, 0, false); \
    __syncthreads(); } while (0)

__device__ __forceinline__ void gemm_core_ring(const GemmDesc& d, f32x4 (&acc)[4][4], LAS unsigned char* lds, const int tid) {
    const int lane = tid & 63, wid = tid >> 6, wr = wid >> 1, wc = wid & 1, fr = lane & 15, fq = lane >> 4;
    const int srow = tid >> 2;
    const int schunk = (tid & 3) ^ ((0x78 >> (2 * ((tid >> 4) & 3))) & 3);
    unsigned oa[2], ob[2];
#pragma unroll
    for (int i = 0; i < 2; ++i) {
        const int r = i * 64 + srow;
        long ar;
        if (d.aidx) { const int rr = r < d.mvalid ? r : 0; ar = (long)(d.aidx[(long)rr * d.aidx_stride] >> 1); } else ar = r;
        oa[i] = (unsigned)((ar * d.lda + schunk * 8) * 2);
        ob[i] = (unsigned)(((long)r * d.ldb + schunk * 8) * 2);
    }
    const int nt = d.K >> 5;
#pragma unroll
    for (int mb = 0; mb < 4; ++mb)
#pragma unroll
        for (int nb = 0; nb < 4; ++nb) acc[mb][nb] = (f32x4){0.f, 0.f, 0.f, 0.f};
    const int ph = fq ^ ((0x78 >> (2 * ((fr >> 2) & 3))) & 3);
    const int aoff = (wr * 64 + fr) * 64 + (ph << 4), boff = 8192 + (wc * 64 + fr) * 64 + (ph << 4);
    const unsigned m0b = __builtin_amdgcn_readfirstlane((unsigned)(size_t)(lds + tid * 16));
#define RING_STAGE(t_, S) do { const bf16_t* sa_ = d.A + (long)(t_) * 32; const bf16_t* sb_ = d.B + (long)(t_) * 32; _Pragma("unroll") for (int i = 0; i < 2; ++i) { \
        GLDS16S(sa_, oa[i], m0b + (S) * 16384 + i * 4096); GLDS16S(sb_, ob[i], m0b + (S) * 16384 + 8192 + i * 4096); } } while (0)
#define RING_COMPUTE(S) do { bf16x8 af[4], bfr[4]; \
        _Pragma("unroll") for (int mb = 0; mb < 4; ++mb) af[mb] = *(LAS bf16x8*)(lds + (S) * 16384 + aoff + mb * 1024); \
        _Pragma("unroll") for (int nb = 0; nb < 4; ++nb) bfr[nb] = *(LAS bf16x8*)(lds + (S) * 16384 + boff + nb * 1024); \
        _Pragma("unroll") for (int mb = 0; mb < 4; ++mb) _Pragma("unroll") for (int nb = 0; nb < 4; ++nb) \
            acc[mb][nb] = __builtin_amdgcn_mfma_f32_16x16x32_bf16(bfr[nb], af[mb], acc[mb][nb], 0, 0, 0); } while (0)
    RING_LOOP();
#undef RING_STAGE
#undef RING_COMPUTE
}


__device__ __forceinline__ unsigned cvt4_fp8(float a, float b, float c, float d) {
    unsigned v;
    asm("s_nop 0\n\tv_cvt_pk_fp8_f32 %0, %1, %2" : "=v"(v) : "v"(a), "v"(b));
    asm("v_cvt_pk_fp8_f32 %0, %1, %2 op_sel:[0,0,1]\n\ts_nop 0" : "+v"(v) : "v"(c), "v"(d));
    return v;
}
constexpr float W8_SCALE = 64.0f;
constexpr float ACT8_SCALE = 8.0f;
constexpr float OUT8_SCALE = 8.0f;
constexpr float Y8_SCALE = 8.0f;

struct GemmDesc8 {
    const unsigned char* A; const unsigned char* B;
    long lda, ldb;
    int K;
    const int* aidx; int aidx_stride;
    int mvalid;
};
__device__ __forceinline__ void gemm_core8_ring(const GemmDesc8& d, f32x4 (&acc)[4][4], LAS unsigned char* lds, const int tid) {
    const int lane = tid & 63, wid = tid >> 6, wr = wid >> 1, wc = wid & 1, fr = lane & 15, fq = lane >> 4;
    const int srow = tid >> 2;
    const int schunk = (tid & 3) ^ ((0x78 >> (2 * ((tid >> 4) & 3))) & 3);
    unsigned oa[2], ob[2];
#pragma unroll
    for (int i = 0; i < 2; ++i) {
        const int r = i * 64 + srow;
        long ar;
        if (d.aidx) { const int rr = r < d.mvalid ? r : 0; ar = (long)(d.aidx[(long)rr * d.aidx_stride] >> 1); } else ar = r;
        oa[i] = (unsigned)(ar * d.lda + schunk * 16);
        ob[i] = (unsigned)((long)r * d.ldb + schunk * 16);
    }
    const int nt = d.K >> 6;
#pragma unroll
    for (int mb = 0; mb < 4; ++mb)
#pragma unroll
        for (int nb = 0; nb < 4; ++nb) acc[mb][nb] = (f32x4){0.f, 0.f, 0.f, 0.f};
    const int ph = fq ^ ((0x78 >> (2 * ((fr >> 2) & 3))) & 3);
    const int aoff = (wr * 64 + fr) * 64 + (ph << 4), boff = 8192 + (wc * 64 + fr) * 64 + (ph << 4);
    const unsigned m0b = __builtin_amdgcn_readfirstlane((unsigned)(size_t)(lds + tid * 16));
    typedef long l2 __attribute__((ext_vector_type(2)));
#define RING_STAGE(t_, S) do { const unsigned char* sa_ = d.A + (long)(t_) * 64; const unsigned char* sb_ = d.B + (long)(t_) * 64; _Pragma("unroll") for (int i = 0; i < 2; ++i) { \
        GLDS16S(sa_, oa[i], m0b + (S) * 16384 + i * 4096); GLDS16S(sb_, ob[i], m0b + (S) * 16384 + 8192 + i * 4096); } } while (0)
#define RING_COMPUTE(S) do { l2 af[4], bfr[4]; \
        _Pragma("unroll") for (int mb = 0; mb < 4; ++mb) af[mb] = *(LAS l2*)(lds + (S) * 16384 + aoff + mb * 1024); \
        _Pragma("unroll") for (int nb = 0; nb < 4; ++nb) bfr[nb] = *(LAS l2*)(lds + (S) * 16384 + boff + nb * 1024); \
        _Pragma("unroll") for (int mb = 0; mb < 4; ++mb) _Pragma("unroll") for (int nb = 0; nb < 4; ++nb) { \
            acc[mb][nb] = __builtin_amdgcn_mfma_f32_16x16x32_fp8_fp8(bfr[nb].x, af[mb].x, acc[mb][nb], 0, 0, 0); \
            acc[mb][nb] = __builtin_amdgcn_mfma_f32_16x16x32_fp8_fp8(bfr[nb].y, af[mb].y, acc[mb][nb], 0, 0, 0); } } while (0)
    RING_LOOP();
#undef RING_STAGE
#undef RING_COMPUTE
}

template <bool ANT>
__device__ __forceinline__ void gemm_core_db(const GemmDesc& d, f32x4 (&acc)[4][4], LAS unsigned char* lds, const int tid) {
    const int lane = tid & 63, wid = tid >> 6, wr = wid >> 1, wc = wid & 1, fr = lane & 15, fq = lane >> 4;
    const int srow = tid >> 3;
    const int schunk = (tid & 7) ^ ((tid >> 4) & 7);
    unsigned oa[4], ob[4];
#pragma unroll
    for (int i = 0; i < 4; ++i) {
        const int r = i * 32 + srow;
        long ar;
        if (d.aidx) { const int rr = r < d.mvalid ? r : 0; ar = (long)(d.aidx[(long)rr * d.aidx_stride] >> 1); } else ar = r;
        oa[i] = (unsigned)((ar * d.lda + schunk * 8) * 2);
        ob[i] = (unsigned)(((long)r * d.ldb + schunk * 8) * 2);
    }
    const int nt = d.K >> 6;
#pragma unroll
    for (int mb = 0; mb < 4; ++mb)
#pragma unroll
        for (int nb = 0; nb < 4; ++nb) acc[mb][nb] = (f32x4){0.f, 0.f, 0.f, 0.f};
    const int swz = (fr >> 1) & 7;
    const int aoff = (wr * 64 + fr) * 128, boff = 16384 + (wc * 64 + fr) * 128;
    const unsigned m0b = __builtin_amdgcn_readfirstlane((unsigned)(size_t)(lds + tid * 16));
#define GEMM_STAGE(t_, BUF) do { const bf16_t* sa_ = d.A + (long)(t_) * 64; const bf16_t* sb_ = d.B + (long)(t_) * 64; _Pragma("unroll") for (int i = 0; i < 4; ++i) { \
        if (ANT) GLDS16S_NT(sa_, oa[i], m0b + (BUF) * 32768 + i * 4096); else GLDS16S(sa_, oa[i], m0b + (BUF) * 32768 + i * 4096); GLDS16S(sb_, ob[i], m0b + (BUF) * 32768 + 16384 + i * 4096); } } while (0)
#define GEMM_COMPUTE(BUF) do { _Pragma("unroll") for (int ks = 0; ks < 2; ++ks) { bf16x8 af[4], bfr[4]; const int co = ((ks * 4 + fq) ^ swz) << 4; \
        _Pragma("unroll") for (int mb = 0; mb < 4; ++mb) af[mb] = *(LAS bf16x8*)(lds + (BUF) * 32768 + aoff + mb * 2048 + co); \
        _Pragma("unroll") for (int nb = 0; nb < 4; ++nb) bfr[nb] = *(LAS bf16x8*)(lds + (BUF) * 32768 + boff + nb * 2048 + co); \
        _Pragma("unroll") for (int mb = 0; mb < 4; ++mb) _Pragma("unroll") for (int nb = 0; nb < 4; ++nb) \
            acc[mb][nb] = __builtin_amdgcn_mfma_f32_16x16x32_bf16(bfr[nb], af[mb], acc[mb][nb], 0, 0, 0); } } while (0)
    GEMM_STAGE(0, 0);
    VM_WAIT0(); __syncthreads();
    for (int t = 0; t < nt; t += 2) {
        GEMM_STAGE(t + 1, 1);
        GEMM_COMPUTE(0);
        VM_WAIT0(); __syncthreads();
        if (t + 2 < nt) GEMM_STAGE(t + 2, 0);
        GEMM_COMPUTE(1);
        VM_WAIT0(); __syncthreads();
    }
#undef GEMM_STAGE
#undef GEMM_COMPUTE
}


typedef int i32x8_t __attribute__((ext_vector_type(8)));
typedef int i32x4_t __attribute__((ext_vector_type(4)));
template <int K128>
__device__ __forceinline__ void gemm_core8_db(const GemmDesc8& d, f32x4 (&acc)[4][4], LAS unsigned char* lds, const int tid) {
    const int lane = tid & 63, wid = tid >> 6, wr = wid >> 1, wc = wid & 1, fr = lane & 15, fq = lane >> 4;
    const int srow = tid >> 3;
    const int schunk = (tid & 7) ^ ((tid >> 4) & 7);
    unsigned oa[4], ob[4];
#pragma unroll
    for (int i = 0; i < 4; ++i) {
        const int r = i * 32 + srow;
        long ar;
        if (d.aidx) { const int rr = r < d.mvalid ? r : 0; ar = (long)(d.aidx[(long)rr * d.aidx_stride] >> 1); } else ar = r;
        oa[i] = (unsigned)(ar * d.lda + schunk * 16);
        ob[i] = (unsigned)((long)r * d.ldb + schunk * 16);
    }
    int nt = d.K >> 7;
    asm volatile("" : "+s"(nt));
#pragma unroll
    for (int mb = 0; mb < 4; ++mb)
#pragma unroll
        for (int nb = 0; nb < 4; ++nb) acc[mb][nb] = (f32x4){0.f, 0.f, 0.f, 0.f};
    const int swz = (fr >> 1) & 7;
    const int aoff = (wr * 64 + fr) * 128, boff = 16384 + (wc * 64 + fr) * 128;
    const unsigned m0b = __builtin_amdgcn_readfirstlane((unsigned)(size_t)(lds + tid * 16));
    typedef long l2 __attribute__((ext_vector_type(2)));
#define GEMM8_STAGE(t_, BUF) do { const unsigned char* sa_ = d.A + (long)(t_) * 128; const unsigned char* sb_ = d.B + (long)(t_) * 128; _Pragma("unroll") for (int i = 0; i < 4; ++i) { \
        GLDS16S(sa_, oa[i], m0b + (BUF) * 32768 + i * 4096); GLDS16S(sb_, ob[i], m0b + (BUF) * 32768 + 16384 + i * 4096); } } while (0)
#define GEMM8_COMPUTE_OLD(BUF) do { _Pragma("unroll") for (int ks = 0; ks < 2; ++ks) { l2 af[4], bfr[4]; const int co = ((ks * 4 + fq) ^ swz) << 4; \
        _Pragma("unroll") for (int mb = 0; mb < 4; ++mb) af[mb] = *(LAS l2*)(lds + (BUF) * 32768 + aoff + mb * 2048 + co); \
        _Pragma("unroll") for (int nb = 0; nb < 4; ++nb) bfr[nb] = *(LAS l2*)(lds + (BUF) * 32768 + boff + nb * 2048 + co); \
        _Pragma("unroll") for (int mb = 0; mb < 4; ++mb) _Pragma("unroll") for (int nb = 0; nb < 4; ++nb) { \
            acc[mb][nb] = __builtin_amdgcn_mfma_f32_16x16x32_fp8_fp8(bfr[nb].x, af[mb].x, acc[mb][nb], 0, 0, 0); \
            acc[mb][nb] = __builtin_amdgcn_mfma_f32_16x16x32_fp8_fp8(bfr[nb].y, af[mb].y, acc[mb][nb], 0, 0, 0); } } } while (0)
#define GEMM8_COMPUTE_NEW(BUF) do { i32x8_t bfr[4]; const int c0 = ((2 * fq) ^ swz) << 4, c1 = ((2 * fq + 1) ^ swz) << 4; \
        _Pragma("unroll") for (int nb = 0; nb < 4; ++nb) { const i32x4_t lo = *(LAS i32x4_t*)(lds + (BUF) * 32768 + boff + nb * 2048 + c0), hi = *(LAS i32x4_t*)(lds + (BUF) * 32768 + boff + nb * 2048 + c1); \
            bfr[nb] = (i32x8_t){lo.x, lo.y, lo.z, lo.w, hi.x, hi.y, hi.z, hi.w}; } \
        _Pragma("unroll") for (int mb = 0; mb < 4; ++mb) { const i32x4_t lo = *(LAS i32x4_t*)(lds + (BUF) * 32768 + aoff + mb * 2048 + c0), hi = *(LAS i32x4_t*)(lds + (BUF) * 32768 + aoff + mb * 2048 + c1); \
            const i32x8_t af = (i32x8_t){lo.x, lo.y, lo.z, lo.w, hi.x, hi.y, hi.z, hi.w}; \
            _Pragma("unroll") for (int nb = 0; nb < 4; ++nb) \
                acc[mb][nb] = __builtin_amdgcn_mfma_scale_f32_16x16x128_f8f6f4(bfr[nb], af, acc[mb][nb], 0, 0, 0, 0x7F7F7F7F, 0, 0x7F7F7F7F); } } while (0)
#define GEMM8_COMPUTE_NEW2(BUF) do { const int c0 = ((2 * fq) ^ swz) << 4, c1 = ((2 * fq + 1) ^ swz) << 4; \
        _Pragma("unroll") for (int nh = 0; nh < 2; ++nh) { i32x8_t bfr[2]; \
            _Pragma("unroll") for (int nb = 0; nb < 2; ++nb) { const i32x4_t lo = *(LAS i32x4_t*)(lds + (BUF) * 32768 + boff + (nh * 2 + nb) * 2048 + c0), hi = *(LAS i32x4_t*)(lds + (BUF) * 32768 + boff + (nh * 2 + nb) * 2048 + c1); \
                bfr[nb] = (i32x8_t){lo.x, lo.y, lo.z, lo.w, hi.x, hi.y, hi.z, hi.w}; } \
            _Pragma("unroll") for (int mb = 0; mb < 4; ++mb) { const i32x4_t lo = *(LAS i32x4_t*)(lds + (BUF) * 32768 + aoff + mb * 2048 + c0), hi = *(LAS i32x4_t*)(lds + (BUF) * 32768 + aoff + mb * 2048 + c1); \
                const i32x8_t af = (i32x8_t){lo.x, lo.y, lo.z, lo.w, hi.x, hi.y, hi.z, hi.w}; \
                _Pragma("unroll") for (int nb = 0; nb < 2; ++nb) \
                    acc[mb][nh * 2 + nb] = __builtin_amdgcn_mfma_scale_f32_16x16x128_f8f6f4(bfr[nb], af, acc[mb][nh * 2 + nb], 0, 0, 0, 0x7F7F7F7F, 0, 0x7F7F7F7F); } } } while (0)
#define GEMM8_COMPUTE(BUF) do { if (K128 == 1) GEMM8_COMPUTE_NEW(BUF); else if (K128 == 2) GEMM8_COMPUTE_NEW2(BUF); else GEMM8_COMPUTE_OLD(BUF); } while (0)
    GEMM8_STAGE(0, 0);
    VM_WAIT0(); __syncthreads();
    for (int t = 0; t < nt; t += 2) {
        GEMM8_STAGE(t + 1, 1);
        GEMM8_COMPUTE(0);
        VM_WAIT0(); __syncthreads();
        if (t + 2 < nt) GEMM8_STAGE(t + 2, 0);
        GEMM8_COMPUTE(1);
        VM_WAIT0(); __syncthreads();
    }
#undef GEMM8_STAGE
#undef GEMM8_COMPUTE
}


__device__ __forceinline__ void gemm_core8_a3(const GemmDesc8& d, f32x4 (&acc)[4][4], LAS unsigned char* lds, const int tid) {
    const int lane = tid & 63, wid = tid >> 6, wr = wid >> 1, wc = wid & 1, fr = lane & 15, fq = lane >> 4;
    const int srow = tid >> 3;
    const int schunk = (tid & 7) ^ ((tid >> 4) & 7);
    unsigned oa[4], ob[4];
#pragma unroll
    for (int i = 0; i < 4; ++i) {
        const int r = i * 32 + srow;
        long ar;
        if (d.aidx) { const int rr = r < d.mvalid ? r : 0; ar = (long)(d.aidx[(long)rr * d.aidx_stride] >> 1); } else ar = r;
        oa[i] = (unsigned)(ar * d.lda + schunk * 16);
        ob[i] = (unsigned)((long)r * d.ldb + schunk * 16);
    }
    int nt = d.K >> 7;
    asm volatile("" : "+s"(nt));
#pragma unroll
    for (int mb = 0; mb < 4; ++mb)
#pragma unroll
        for (int nb = 0; nb < 4; ++nb) acc[mb][nb] = (f32x4){0.f, 0.f, 0.f, 0.f};
    const int swz = (fr >> 1) & 7;
    const int aoff = (wr * 64 + fr) * 128, boff = 49152 + (wc * 64 + fr) * 128;
    const int c0 = ((2 * fq) ^ swz) << 4, c1 = ((2 * fq + 1) ^ swz) << 4;
    const unsigned m0b = __builtin_amdgcn_readfirstlane((unsigned)(size_t)(lds + tid * 16));
    __builtin_amdgcn_s_waitcnt(0x0F70);
#define A3_STAGE_A(t_, SA) do { const unsigned char* sa_ = d.A + (long)(t_) * 128; _Pragma("unroll") for (int i = 0; i < 4; ++i) GLDS16S(sa_, oa[i], m0b + (SA) * 16384 + i * 4096); } while (0)
#define A3_STAGE_B(t_, SB) do { const unsigned char* sb_ = d.B + (long)(t_) * 128; _Pragma("unroll") for (int i = 0; i < 4; ++i) GLDS16S(sb_, ob[i], m0b + 49152 + (SB) * 16384 + i * 4096); } while (0)
#define A3_COMPUTE(SA, SB) do { i32x8_t bfr[4]; \
        _Pragma("unroll") for (int nb = 0; nb < 4; ++nb) { const i32x4_t lo = *(LAS i32x4_t*)(lds + (SB) * 16384 + boff + nb * 2048 + c0), hi = *(LAS i32x4_t*)(lds + (SB) * 16384 + boff + nb * 2048 + c1); \
            bfr[nb] = (i32x8_t){lo.x, lo.y, lo.z, lo.w, hi.x, hi.y, hi.z, hi.w}; } \
        _Pragma("unroll") for (int mb = 0; mb < 4; ++mb) { const i32x4_t lo = *(LAS i32x4_t*)(lds + (SA) * 16384 + aoff + mb * 2048 + c0), hi = *(LAS i32x4_t*)(lds + (SA) * 16384 + aoff + mb * 2048 + c1); \
            const i32x8_t af = (i32x8_t){lo.x, lo.y, lo.z, lo.w, hi.x, hi.y, hi.z, hi.w}; \
            _Pragma("unroll") for (int nb = 0; nb < 4; ++nb) \
                acc[mb][nb] = __builtin_amdgcn_mfma_scale_f32_16x16x128_f8f6f4(bfr[nb], af, acc[mb][nb], 0, 0, 0, 0x7F7F7F7F, 0, 0x7F7F7F7F); } } while (0)
#define A3_STEP(P_) do { const int tt_ = t + (P_); if (tt_ < nt) { \
        if (tt_ + 1 < nt) VM_WAITN(4); else VM_WAITN(0); \
        __syncthreads(); \
        if (tt_ + 1 < nt) A3_STAGE_B(tt_ + 1, ((P_) + 1) % 2); \
        if (tt_ + 2 < nt) A3_STAGE_A(tt_ + 2, ((P_) + 2) % 3); \
        A3_COMPUTE((P_) % 3, (P_) % 2); } } while (0)
    A3_STAGE_A(0, 0); A3_STAGE_B(0, 0); if (nt > 1) A3_STAGE_A(1, 1);
    for (int t = 0; t < nt; t += 6) { A3_STEP(0); A3_STEP(1); A3_STEP(2); A3_STEP(3); A3_STEP(4); A3_STEP(5); }
    __syncthreads();
#undef A3_STAGE_A
#undef A3_STAGE_B
#undef A3_COMPUTE
#undef A3_STEP
}

__device__ __forceinline__ void gemm_core8_b3(const GemmDesc8& d, f32x4 (&acc)[4][4], LAS unsigned char* lds, const int tid) {
    const int lane = tid & 63, wid = tid >> 6, wr = wid >> 1, wc = wid & 1, fr = lane & 15, fq = lane >> 4;
    const int srow = tid >> 3;
    const int schunk = (tid & 7) ^ ((tid >> 4) & 7);
    unsigned oa[4], ob[4];
#pragma unroll
    for (int i = 0; i < 4; ++i) {
        const int r = i * 32 + srow;
        long ar;
        if (d.aidx) { const int rr = r < d.mvalid ? r : 0; ar = (long)(d.aidx[(long)rr * d.aidx_stride] >> 1); } else ar = r;
        oa[i] = (unsigned)(ar * d.lda + schunk * 16);
        ob[i] = (unsigned)((long)r * d.ldb + schunk * 16);
    }
    int nt = d.K >> 7;
    asm volatile("" : "+s"(nt));
#pragma unroll
    for (int mb = 0; mb < 4; ++mb)
#pragma unroll
        for (int nb = 0; nb < 4; ++nb) acc[mb][nb] = (f32x4){0.f, 0.f, 0.f, 0.f};
    const int swz = (fr >> 1) & 7;
    const int aoff = 49152 + (wr * 64 + fr) * 128, boff = (wc * 64 + fr) * 128;
    const int c0 = ((2 * fq) ^ swz) << 4, c1 = ((2 * fq + 1) ^ swz) << 4;
    const unsigned m0b = __builtin_amdgcn_readfirstlane((unsigned)(size_t)(lds + tid * 16));
    __builtin_amdgcn_s_waitcnt(0x0F70);
#define A3_STAGE_A(t_, SA) do { const unsigned char* sa_ = d.A + (long)(t_) * 128; _Pragma("unroll") for (int i = 0; i < 4; ++i) GLDS16S(sa_, oa[i], m0b + 49152 + (SA) * 16384 + i * 4096); } while (0)
#define A3_STAGE_B(t_, SB) do { const unsigned char* sb_ = d.B + (long)(t_) * 128; _Pragma("unroll") for (int i = 0; i < 4; ++i) GLDS16S(sb_, ob[i], m0b + (SB) * 16384 + i * 4096); } while (0)
#define A3_COMPUTE(SA, SB) do { i32x8_t bfr[4]; \
        _Pragma("unroll") for (int nb = 0; nb < 4; ++nb) { const i32x4_t lo = *(LAS i32x4_t*)(lds + (SB) * 16384 + boff + nb * 2048 + c0), hi = *(LAS i32x4_t*)(lds + (SB) * 16384 + boff + nb * 2048 + c1); \
            bfr[nb] = (i32x8_t){lo.x, lo.y, lo.z, lo.w, hi.x, hi.y, hi.z, hi.w}; } \
        _Pragma("unroll") for (int mb = 0; mb < 4; ++mb) { const i32x4_t lo = *(LAS i32x4_t*)(lds + (SA) * 16384 + aoff + mb * 2048 + c0), hi = *(LAS i32x4_t*)(lds + (SA) * 16384 + aoff + mb * 2048 + c1); \
            const i32x8_t af = (i32x8_t){lo.x, lo.y, lo.z, lo.w, hi.x, hi.y, hi.z, hi.w}; \
            _Pragma("unroll") for (int nb = 0; nb < 4; ++nb) \
                acc[mb][nb] = __builtin_amdgcn_mfma_scale_f32_16x16x128_f8f6f4(bfr[nb], af, acc[mb][nb], 0, 0, 0, 0x7F7F7F7F, 0, 0x7F7F7F7F); } } while (0)
#define A3_STEP(P_) do { const int tt_ = t + (P_); if (tt_ < nt) { \
        if (tt_ + 1 < nt) VM_WAITN(4); else VM_WAITN(0); \
        __syncthreads(); \
        if (tt_ + 1 < nt) A3_STAGE_A(tt_ + 1, ((P_) + 1) % 2); \
        if (tt_ + 2 < nt) A3_STAGE_B(tt_ + 2, ((P_) + 2) % 3); \
        A3_COMPUTE((P_) % 2, (P_) % 3); } } while (0)
    A3_STAGE_B(0, 0); A3_STAGE_A(0, 0); if (nt > 1) A3_STAGE_B(1, 1);
    for (int t = 0; t < nt; t += 6) { A3_STEP(0); A3_STEP(1); A3_STEP(2); A3_STEP(3); A3_STEP(4); A3_STEP(5); }
    __syncthreads();
#undef A3_STAGE_A
#undef A3_STAGE_B
#undef A3_COMPUTE
#undef A3_STEP
}

#ifndef A3_SITES
#define A3_SITES 0x23
#endif
#ifndef K128_SITES
#define K128_SITES 0xe3
#endif
#ifndef RING_SITES
#define RING_SITES 0x00
#endif
#define GEMM_SEL(site, g_, acc_) do { if ((RING_SITES >> (site)) & 1) gemm_core_ring(g_, acc_, lds, tid); else gemm_core_db<(site) == 3>(g_, acc_, lds, tid); } while (0)
#ifndef B3_SITES
#define B3_SITES 0xc0
#endif
#define GEMM8_SEL(site, g_, acc_) do { if ((A3_SITES >> (site)) & 1) gemm_core8_a3(g_, acc_, lds, tid); else if ((B3_SITES >> (site)) & 1) gemm_core8_b3(g_, acc_, lds, tid); else if ((RING_SITES >> (site)) & 1) gemm_core8_ring(g_, acc_, lds, tid); else gemm_core8_db<(((K128_SITES >> (site)) & 1) != 0) ? 1 : 0>(g_, acc_, lds, tid); } while (0)

template <int DQK, bool MASK>
__device__ __forceinline__ void attn_unit(const bf16_t* Qp, int ldq, const bf16_t* Kp, int ldk, const bf16_t* VTp,
                                          int seg0_tok, int seg0_tiles, int seg1_tok, int seg1_tiles,
                                          int qpos0, int seg0_pos, float sink2, bool has_sink, unsigned char* Op, LAS unsigned char* lds, const int tid,
                                          const float* qgain, const float2* qrope, int qrope_pos0, float qscale) {
    constexpr int NKS = DQK / 16;
    const int lane = tid & 63, wid = tid >> 6, lq = lane & 31, h = lane >> 5;
    bf16x8 qf[NKS];
    {
        const bf16_t* qrow = Qp + (long)(wid * 32 + lq) * ldq + 8 * h;
        float ss = 0.f;
#pragma unroll
        for (int ks = 0; ks < NKS; ++ks) {
            const u32x4 a = *(const u32x4*)(qrow + ks * 16);
            const float e0 = bf_lo(a.x), e1 = bf_hi(a.x), e2 = bf_lo(a.y), e3 = bf_hi(a.y), e4 = bf_lo(a.z), e5 = bf_hi(a.z), e6 = bf_lo(a.w), e7 = bf_hi(a.w);
            ss += (e0 * e0 + e1 * e1) + (e2 * e2 + e3 * e3) + (e4 * e4 + e5 * e5) + (e6 * e6 + e7 * e7);
        }
        ss += __shfl_xor(ss, 32);
        const float rs = rsqrtf(ss * (1.0f / DQK) + EPS) ;
        const int pos = qrope_pos0 + wid * 32 + lq;
#define QLOAD(ks_, x_) do { const u32x4 a_ = *(const u32x4*)(qrow + (ks_) * 16); const f32x4 g0_ = *(const f32x4*)(qgain + (ks_) * 16 + 8 * h), g1_ = *(const f32x4*)(qgain + (ks_) * 16 + 8 * h + 4); \
            x_[0] = bf_lo(a_.x) * rs * g0_[0]; x_[1] = bf_hi(a_.x) * rs * g0_[1]; x_[2] = bf_lo(a_.y) * rs * g0_[2]; x_[3] = bf_hi(a_.y) * rs * g0_[3]; \
            x_[4] = bf_lo(a_.z) * rs * g1_[0]; x_[5] = bf_hi(a_.z) * rs * g1_[1]; x_[6] = bf_lo(a_.w) * rs * g1_[2]; x_[7] = bf_hi(a_.w) * rs * g1_[3]; } while (0)
#define QPACK(ks_, x_) do { union { u32x4 u; bf16x8 v; } pk_; \
            pk_.u.x = cvt_pk_bf16(x_[0] * qscale, x_[1] * qscale); pk_.u.y = cvt_pk_bf16(x_[2] * qscale, x_[3] * qscale); \
            pk_.u.z = cvt_pk_bf16(x_[4] * qscale, x_[5] * qscale); pk_.u.w = cvt_pk_bf16(x_[6] * qscale, x_[7] * qscale); qf[ks_] = pk_.v; } while (0)
        if (DQK == 96) {
#pragma unroll
            for (int ks = 0; ks < NKS; ++ks) {
                float x[8];
                QLOAD(ks, x);
                if (ks >= 4 && qrope) {
                    const float2* rp = qrope + pos * 16 + (ks - 4) * 8;
#pragma unroll
                    for (int j = 0; j < 8; ++j) { const float2 c = rp[j]; const float pj = __shfl_xor(x[j], 32); x[j] = x[j] * c.x + (h ? pj : -pj) * c.y; }
                }
                QPACK(ks, x);
            }
        } else {
#pragma unroll
            for (int kp = 0; kp < NKS; kp += 2) {
                float x0[8], x1[8];
                QLOAD(kp, x0); QLOAD(kp + 1, x1);
                if (qrope) {
                    const float2* rq = qrope + pos * 32 + h * 8 + (kp >= 2 ? 16 : 0);
#pragma unroll
                    for (int j = 0; j < 8; ++j) { const float2 c = rq[j]; const float a0 = x0[j], a1 = x1[j]; x0[j] = a0 * c.x - a1 * c.y; x1[j] = a1 * c.x + a0 * c.y; }
                }
                QPACK(kp, x0); QPACK(kp + 1, x1);
            }
        }
#undef QLOAD
#undef QPACK
    }
    __builtin_amdgcn_sched_barrier(0);
    f32x16 ot[2];
#pragma unroll
    for (int i = 0; i < 16; ++i) { ot[0][i] = 0.f; ot[1][i] = 0.f; }
    float m_run = -INFINITY, l_run = 0.f, m_ref = 0.f;
    union { u32x4 u; bf16x8 v; } kx, qx;
    kx.u = (u32x4){h == 0 ? 0x3F80u : 0u, 0u, 0u, 0u};
    qx.u = (u32x4){0u, 0u, 0u, 0u};
    const int n64 = 2 * (seg0_tiles + seg1_tiles);
    const int srow = tid >> 3, sch8 = (tid & 7) ^ ((tid >> 4) & 7);
    const int srow2 = tid >> 2, sch4 = (tid & 3) ^ ((tid >> 4) & 3);
    constexpr int NDMA = (DQK == 96) ? 5 : 4;

    const unsigned ok1 = (unsigned)((srow * ldk + sch8 * 8) * 2), ok2 = (unsigned)((srow2 * ldk + sch4 * 8) * 2), ov = (unsigned)((srow * T + sch8 * 8) * 2);
    const unsigned m0b = __builtin_amdgcn_readfirstlane((unsigned)(size_t)(lds + tid * 16));
    auto stage = [&](int j, int buf) {
        const int i = j >> 1;
        const long tok = (i < seg0_tiles ? (long)seg0_tok + i * 128 : (long)seg1_tok + (i - seg0_tiles) * 128) + (j & 1) * 64;
        const bf16_t* kb_ = Kp + tok * ldk; const bf16_t* vb_ = VTp + tok;
        const unsigned mb = m0b + buf * 20480;
#pragma unroll
        for (int it = 0; it < 2; ++it) {
            GLDS16S(kb_ + (long)(it * 32) * ldk, ok1, mb + it * 4096);
            GLDS16S(vb_ + (long)(it * 32) * T, ov, mb + 12288 + it * 4096);
        }
        if (DQK == 96) GLDS16S(kb_ + 64, ok2, mb + 8192);
    };
    const int qpos = qpos0 + wid * 32 + lq;
    const int lqp = (lq & 0x13) | ((lq & 4) << 1) | ((lq & 8) >> 1);
    const int kswz = (lqp >> 1) & 7, kswz2 = (lqp >> 2) & 3, vswz = (lq >> 1) & 7;

    __builtin_amdgcn_s_waitcnt(0x0F70);
    stage(0, 0);
    if (n64 > 1) stage(1, 1);
    auto step = [&](const int j, const int buf) __attribute__((always_inline)) {
        if (j + 1 < n64) { if (DQK == 96) VM_WAITN(5); else VM_WAITN(4); } else VM_WAITN(0);
        __syncthreads();
        if (j + 2 < n64) stage(j + 2, (buf + 2) % 3);
        bool active = true;
        if (MASK && (j >> 1) < seg0_tiles) {
            const int k0 = seg0_pos + j * 64, q0w = qpos0 + wid * 32;
            active = (k0 + 63 >= q0w - 128) && (k0 <= q0w + 31 + 128);
        }
        if (active) {
            LAS unsigned char* lb = lds + buf * 20480;
            f32x16 st[2];
#pragma unroll
            for (int r = 0; r < 16; ++r) { st[0][r] = 0.f; st[1][r] = 0.f; }
            {
                bf16x8 kf[4][2];
#pragma unroll
                for (int ks = 0; ks < 4; ++ks)
#pragma unroll
                    for (int kb = 0; kb < 2; ++kb) kf[ks][kb] = *(LAS bf16x8*)(lb + (kb * 32 + lqp) * 128 + (((ks * 2 + h) ^ kswz) << 4));
                __builtin_amdgcn_sched_barrier(0);
#pragma unroll
                for (int ks = 0; ks < 4; ++ks)
#pragma unroll
                    for (int kb = 0; kb < 2; ++kb) st[kb] = __builtin_amdgcn_mfma_f32_32x32x16_bf16(kf[ks][kb], qf[ks], st[kb], 0, 0, 0);
            }
            if (DQK == 96) {
                bf16x8 kf2[2][2];
#pragma unroll
                for (int ks = 4; ks < NKS; ++ks)
#pragma unroll
                    for (int kb = 0; kb < 2; ++kb) kf2[ks - 4][kb] = *(LAS bf16x8*)(lb + 8192 + (kb * 32 + lqp) * 64 + ((((ks - 4) * 2 + h) ^ kswz2) << 4));
                __builtin_amdgcn_sched_barrier(0);
#pragma unroll
                for (int ks = 4; ks < NKS; ++ks)
#pragma unroll
                    for (int kb = 0; kb < 2; ++kb) st[kb] = __builtin_amdgcn_mfma_f32_32x32x16_bf16(kf2[ks - 4][kb], qf[ks], st[kb], 0, 0, 0);
            }
#pragma unroll
            for (int kb = 0; kb < 2; ++kb) st[kb] = __builtin_amdgcn_mfma_f32_32x32x16_bf16(kx.v, qx.v, st[kb], 0, 0, 0);
            const int dwin = seg0_pos + j * 64 - (qpos0 + wid * 32);
            if (MASK && (j >> 1) < seg0_tiles && (dwin < -97 || dwin > 65)) {
                const int kbase = seg0_pos + j * 64 + 8 * h - qpos;
#pragma unroll
                for (int kb = 0; kb < 2; ++kb)
#pragma unroll
                    for (int r = 0; r < 16; ++r) {
                        const int dlt = kbase + kb * 32 + 16 * (r >> 3) + 4 * ((r >> 2) & 1) + (r & 3);
                        if (dlt > 128 || dlt < -128) st[kb][r] = -INFINITY;
                    }
            }
            float mx = st[0][0];
#pragma unroll
            for (int r = 1; r < 16; ++r) mx = fmaxf(mx, st[0][r]);
#pragma unroll
            for (int r = 0; r < 16; ++r) mx = fmaxf(mx, st[1][r]);
            mx = fmaxf(mx, __shfl_xor(mx, 32));
            const float m_new = fmaxf(m_run, mx + m_ref);
            const float dlt = m_new - m_ref;
            const bool need = (m_new != -INFINITY) && (dlt > 8.0f || dlt < -64.0f);
            if (__builtin_amdgcn_ballot_w64(need) != 0ull) {
                const float nref = (m_new == -INFINITY) ? m_ref : bf_lo(cvt_pk_bf16(m_new, 0.f));
                const float d = m_ref - nref;
                const float alpha = fast_exp2(d);
#pragma unroll
                for (int kb = 0; kb < 2; ++kb)
#pragma unroll
                    for (int r = 0; r < 16; ++r) st[kb][r] += d;
                l_run *= alpha;
#pragma unroll
                for (int r = 0; r < 16; ++r) { ot[0][r] *= alpha; ot[1][r] *= alpha; }
                m_ref = nref;
                qx.u.x = (h == 0) ? (cvt_pk_bf16(-nref, 0.f) & 0xffffu) : 0u;
            }
            float ls = 0.f;
#pragma unroll
            for (int kb = 0; kb < 2; ++kb)
#pragma unroll
                for (int r = 0; r < 16; ++r) { const float p = fast_exp2(st[kb][r]); st[kb][r] = p; ls += p; }
            l_run += ls;
            m_run = m_new;
#pragma unroll
            for (int s = 0; s < 4; ++s) {
                union { u32x4 u; bf16x8 v; } pf;
                const int kb = s >> 1, r0 = 8 * (s & 1);
                pf.u.x = cvt_pk_bf16(st[kb][r0 + 0], st[kb][r0 + 1]); pf.u.y = cvt_pk_bf16(st[kb][r0 + 2], st[kb][r0 + 3]);
                pf.u.z = cvt_pk_bf16(st[kb][r0 + 4], st[kb][r0 + 5]); pf.u.w = cvt_pk_bf16(st[kb][r0 + 6], st[kb][r0 + 7]);
#pragma unroll
                for (int db = 0; db < 2; ++db) {
                    const bf16x8 vf = *(LAS bf16x8*)(lb + 12288 + (db * 32 + lq) * 128 + (((2 * s + h) ^ vswz) << 4));
                    ot[db] = __builtin_amdgcn_mfma_f32_32x32x16_bf16(vf, pf.v, ot[db], 0, 0, 0);
                }
            }
        }
    };
    for (int j = 0; j < n64; j += 3) {
        step(j, 0);
        if (j + 1 < n64) step(j + 1, 1);
        if (j + 2 < n64) step(j + 2, 2);
    }
    __syncthreads();
    float l = l_run + __shfl_xor(l_run, 32);
    if (has_sink) l += fast_exp2(sink2 - m_ref);
    const float inv = OUT8_SCALE / l;
    unsigned char* orow = Op + (long)(wid * 32 + lq) * D + 4 * h;
#pragma unroll
    for (int db = 0; db < 2; ++db)
#pragma unroll
        for (int g = 0; g < 4; ++g)
            *(unsigned*)(orow + db * 32 + 8 * g) = cvt4_fp8(ot[db][4 * g] * inv, ot[db][4 * g + 1] * inv, ot[db][4 * g + 2] * inv, ot[db][4 * g + 3] * inv);
}

__device__ __forceinline__ int nmap(int mode, int n) {
    if (mode == 1) return n < 640 ? n : (n < 672 ? n + 640 : n - 32);
    if (mode == 2) return ((n >> 4) << 5) + (n & 15);
    if (mode == 3) return ((n >> 4) << 5) + 16 + (n & 15);
    return n;
}
__device__ __forceinline__ void conv_tile(const float* src, int K, int N, bf16_t* dst, int ldd, int mode, const float* kscale, int tk, int tn, LAS unsigned char* lds, const int tid) {
    (void)K; (void)lds;
    const int lane = tid & 63, w = tid >> 6;
    const int k0 = tk * 64 + w * 16, n = tn * 64 + lane;
    if (n < N) {
        float v[16];
        const float* sp = src + (long)k0 * N + n;
#pragma unroll
        for (int j = 0; j < 16; ++j) v[j] = sp[(long)j * N];
        if (kscale) {
#pragma unroll
            for (int j = 0; j < 16; ++j) v[j] *= kscale[k0 + j];
        }
        if (mode >= 8) {
            unsigned char* dp8 = (unsigned char*)dst + (long)nmap(mode & 7, n) * ldd + k0;
            u32x4 w8;
            w8.x = cvt4_fp8(v[0] * W8_SCALE, v[1] * W8_SCALE, v[2] * W8_SCALE, v[3] * W8_SCALE);
            w8.y = cvt4_fp8(v[4] * W8_SCALE, v[5] * W8_SCALE, v[6] * W8_SCALE, v[7] * W8_SCALE);
            w8.z = cvt4_fp8(v[8] * W8_SCALE, v[9] * W8_SCALE, v[10] * W8_SCALE, v[11] * W8_SCALE);
            w8.w = cvt4_fp8(v[12] * W8_SCALE, v[13] * W8_SCALE, v[14] * W8_SCALE, v[15] * W8_SCALE);
            *(u32x4*)dp8 = w8;
        } else {
            bf16_t* dp = dst + (long)nmap(mode, n) * ldd + k0;
            *(u32x4*)dp = (u32x4){cvt_pk_bf16(v[0], v[1]), cvt_pk_bf16(v[2], v[3]), cvt_pk_bf16(v[4], v[5]), cvt_pk_bf16(v[6], v[7])};
            *(u32x4*)(dp + 8) = (u32x4){cvt_pk_bf16(v[8], v[9]), cvt_pk_bf16(v[10], v[11]), cvt_pk_bf16(v[12], v[13]), cvt_pk_bf16(v[14], v[15])};
        }
    }
}

__device__ __forceinline__ void ada_unit(const Params& P, int l, int n0, LAS unsigned char* lds, const int tid, const bool fill) {
    LAS float* sS = (LAS float*)lds;
    LAS float* sR = (LAS float*)(lds + 36864);
    const int kg = tid >> 2, c4 = (tid & 3) * 4;
    const float* w = P.in[I_ADAW] + (long)l * 1024 * 6144 + n0 + c4;
    f32x4 wv[16];
#pragma unroll
    for (int kk = 0; kk < 16; ++kk) wv[kk] = __builtin_nontemporal_load((const f32x4*)(w + (long)(kg * 16 + kk) * 6144));
    if (fill) {
        for (int i = tid; i < 9 * 1024; i += NTHREADS) {
            const int r = i >> 10, k = i & 1023;
            const float v = r < 8 ? P.in[I_C][r * 1024 + k] : P.in[I_CCTX][k];
            sS[i] = silu_f(v);
        }
    }
    __syncthreads();
    f32x4 acc[9];
#pragma unroll
    for (int r = 0; r < 9; ++r) acc[r] = (f32x4){0.f, 0.f, 0.f, 0.f};
#pragma unroll
    for (int kk = 0; kk < 16; ++kk) {
        const int k = kg * 16 + kk;
#pragma unroll
        for (int r = 0; r < 9; ++r) acc[r] += wv[kk] * sS[r * 1024 + k];
    }
#pragma unroll
    for (int r = 0; r < 9; ++r) {
#pragma unroll
        for (int j = 0; j < 4; ++j) sR[(kg * 9 + r) * 16 + c4 + j] = acc[r][j];
    }
    __syncthreads();
    float* mod = (float*)(P.ws + WS_MOD);
    if (tid < 9 * 16) {
        const int r = tid >> 4, c = tid & 15;
        float s = P.in[I_ADAB][l * 6144 + n0 + c];
#pragma unroll 8
        for (int g = 0; g < 64; ++g) s += sR[(g * 9 + r) * 16 + c];
        mod[((long)l * 9 + r) * 6144 + n0 + c] = s;
    }
    __syncthreads();
}

__device__ __forceinline__ void phase0(const Params& P, LAS unsigned char* lds, const int tid) {
    unsigned char* ws = P.ws;
    constexpr int U_WIN = 4 * 8 * 41, U_WUQ = 4 * 2 * 18, U_WUK = 4 * 1 * 12, U_WUV = U_WUK, U_WOUT = 4 * 8 * 32, U_EG = 64 * 8 * 16, U_EU = U_EG, U_ED = 64 * 4 * 32;
    constexpr int O_WUQ = U_WIN, O_WUK = O_WUQ + U_WUQ, O_WUV = O_WUK + U_WUK, O_WOUT = O_WUV + U_WUV, O_EG = O_WOUT + U_WOUT, O_EU = O_EG + U_EG, O_ED = O_EU + U_EU;
    constexpr int O_ADA = O_ED + U_ED, U_ADA = 4 * 384;
    constexpr int O_CS = O_ADA + U_ADA, U_CS = 256;
    constexpr int O_CSC = O_CS + U_CS, U_CSC = 8;
    constexpr int O_ROPE = O_CSC + U_CSC, U_ROPE = 8;
    constexpr int O_FW = O_ROPE + U_ROPE, U_FW = 16 * 32;
    constexpr int U_TOTAL = O_FW + U_FW;
    bool ada_fill = true;
    for (int u = O_ADA + (int)blockIdx.x; u < U_TOTAL; u += gridDim.x) {
        if (false) { }
        else if (u < O_CS) {
            int v = u - O_ADA;
            if (gridDim.x == 512) { const int b = v & 511, k = v >> 9; v = 2 * (((b >> 4) * 8 + (b & 7)) + 256 * k) + ((b >> 3) & 1); }
            ada_unit(P, v / 384, (v % 384) * 16, lds, tid, ada_fill); ada_fill = false;
        }
        else if (u < O_CSC) {
            const int v = u - O_CS; bf16_t* cs = (bf16_t*)(ws + WS_CS);
            const float sc = 0.022097086912079608f;
            for (int i = tid; i < 8 * 2048; i += NTHREADS) {
                const int k = v * 8 + (i >> 11), np = (i & 2047) * 2;
                float o[2];
#pragma unroll
                for (int j = 0; j < 2; ++j) { const int n = (np + j) & 2047; const float rev = (float)((k * n) & 2047) * (1.0f / 2048.0f);
                    o[j] = (np < 2048) ? __builtin_amdgcn_cosf(rev) * sc : -__builtin_amdgcn_sinf(rev) * sc; }
                *(unsigned*)(cs + (long)k * 4096 + np) = cvt_pk_bf16(o[0], o[1]);
            }
        }
        else if (u < O_ROPE) {
            const int v = u - O_CSC; bf16_t* cs = (bf16_t*)(ws + WS_CSC);
            const float sc = 0.0625f;
            for (int i = tid; i < 32 * 256; i += NTHREADS) {
                const int k = v * 32 + (i >> 8), np = (i & 255) * 2;
                float o[2];
#pragma unroll
                for (int j = 0; j < 2; ++j) { const int n = (np + j) & 255; const float rev = (float)((k * n) & 255) * (1.0f / 256.0f);
                    o[j] = (np < 256) ? __builtin_amdgcn_cosf(rev) * sc : -__builtin_amdgcn_sinf(rev) * sc; }
                *(unsigned*)(cs + (long)k * 512 + np) = cvt_pk_bf16(o[0], o[1]);
            }
        }
        else if (u < O_FW) {
            const int v = u - O_ROPE; float2* rs = (float2*)(ws + WS_ROPES); float2* rm = (float2*)(ws + WS_ROPEM);
            for (int i = tid; i < 256 * 32; i += NTHREADS) {
                const int pos = v * 256 + (i >> 5), j = i & 31; const int pr = pos >> 6, pc = pos & 63;
                const float inv = fast_exp2(-13.287712379549449f * (float)(2 * (j & 15)) * (1.0f / 32.0f));
                const float ang = (float)(j < 16 ? pr : pc) * inv;
                float rev = ang * 0.15915494309189535f; rev -= floorf(rev);
                rs[pos * 32 + j] = make_float2(__builtin_amdgcn_cosf(rev), __builtin_amdgcn_sinf(rev));
            }
            for (int i = tid; i < 256 * 16; i += NTHREADS) {
                const int pos = v * 256 + (i >> 4), j = i & 15; const int pr = pos >> 6, pc = pos & 63;
                const float inv = fast_exp2(-13.287712379549449f * (float)(2 * (j & 7)) * (1.0f / 16.0f));
                const float ang = (float)(j < 8 ? pr : pc) * inv;
                float rev = ang * 0.15915494309189535f; rev -= floorf(rev);
                rm[pos * 16 + j] = make_float2(__builtin_amdgcn_cosf(rev), __builtin_amdgcn_sinf(rev));
            }
        }
        else {
            const int v = (u - O_FW) >> 5, part = (u - O_FW) & 31, l = v >> 2, g = v & 3;
            const float* w = P.in[I_FNETW] + (long)(l * 4 + g) * 64 * 64;
            bf16_t* fw = (bf16_t*)(ws + WS_FW) + (long)(l * 4 + g) * 128 * 128;
            for (int i = part * 512 + tid; i < part * 512 + 512; i += NTHREADS) {
                const int f = i >> 7, k = i & 127, cs = f >> 6, e = f & 63, c = k - (g & 1) * 64;
                float s = 0.f;
                if (c >= 0 && c < 64) {
                    for (int m = 0; m < 64; ++m) {
                        const float rev = (float)((m * c) & 63) * (1.0f / 64.0f);
                        const float tw = cs ? __builtin_amdgcn_sinf(rev) : __builtin_amdgcn_cosf(rev);
                        s += tw * w[m * 64 + e];
                    }
                }
                fw[f * 128 + k] = f2bf(s * 0.125f);
            }
        }
    }
    {
        const int lane = tid & 63, w = __builtin_amdgcn_readfirstlane(tid >> 6);
        const unsigned m0b = __builtin_amdgcn_readfirstlane((unsigned)(size_t)(lds + tid * 16));
        auto decode = [&](int u, const float*& src, int& N, unsigned char*& dst, int& ldd, int& mode, const float*& ksc, int& k0, int& n0) {
            ksc = nullptr;
            if (u < O_WUQ) { const int m = u / 328, r = u % 328; src = P.in[I_WIN] + (long)m * 1024 * DIN; N = DIN; dst = ws + WS_WIN + (size_t)m * DINP * 1024; ldd = 1024; mode = 8 + 1; k0 = (r / 41) * 128; n0 = (r % 41) * 32; }
            else if (u < O_WUK) { const int v = u - O_WUQ, m = v / 36, r = v % 36; src = P.in[I_WUQ] + (long)m * 256 * 576; N = 576; dst = ws + WS_WUQ + (size_t)m * 640 * 256 * 2; ldd = 256; mode = 0; ksc = P.in[I_CQG] + m * 256; k0 = (r / 18) * 128; n0 = (r % 18) * 32; }
            else if (u < O_WUV) { const int v = u - O_WUK, m = v / 12, r = v % 12; src = P.in[I_WUK] + (long)m * 128 * 384; N = 384; dst = ws + WS_WUKV + (size_t)m * 768 * 128 * 2; ldd = 128; mode = 0; ksc = P.in[I_CKVG] + m * 128; k0 = 0; n0 = r * 32; }
            else if (u < O_WOUT) { const int v = u - O_WUV, m = v / 12, r = v % 12; src = P.in[I_WUV] + (long)m * 128 * 384; N = 384; dst = ws + WS_WUKV + ((size_t)m * 768 * 128 + 384 * 128) * 2; ldd = 128; mode = 0; ksc = P.in[I_CKVG] + m * 128; k0 = 0; n0 = r * 32; }
            else if (u < O_EG) { const int v = u - O_WOUT, m = v / 256, r = v % 256; src = P.in[I_WOUT] + (long)m * 1024 * 1024; N = 1024; dst = ws + WS_WOUT + (size_t)m * 1024 * 1024; ldd = 1024; mode = 8 + 0; k0 = (r / 32) * 128; n0 = (r % 32) * 32; }
            else if (u < O_EU) { const int v = u - O_EG, m = v / 128, r = v % 128; src = P.in[I_EG] + (long)m * 1024 * 512; N = 512; dst = ws + WS_WGU + (size_t)m * 1024 * 1024; ldd = 1024; mode = 8 + 2; k0 = (r / 16) * 128; n0 = (r % 16) * 32; }
            else if (u < O_ED) { const int v = u - O_EU, m = v / 128, r = v % 128; src = P.in[I_EU] + (long)m * 1024 * 512; N = 512; dst = ws + WS_WGU + (size_t)m * 1024 * 1024; ldd = 1024; mode = 8 + 3; k0 = (r / 16) * 128; n0 = (r % 16) * 32; }
            else { const int v = u - O_ED, m = v / 128, r = v % 128; src = P.in[I_ED] + (long)m * 512 * 1024; N = 1024; dst = ws + WS_WDN + (size_t)m * 1024 * 512; ldd = 512; mode = 8 + 0; k0 = (r / 32) * 128; n0 = (r % 32) * 32; }
        };
#define CONV_ISSUE(u_, BUF) do { const float* src_; int N_; unsigned char* dst_; int ldd_, mode_, k0_, n0_; const float* ks_; decode(u_, src_, N_, dst_, ldd_, mode_, ks_, k0_, n0_); \
            const unsigned vo_ = (unsigned)(((lane >> 3) * N_ + (lane & 7) * 4) * 4); \
            _Pragma("unroll") for (int q = 0; q < 4; ++q) GLDS16S_NT(src_ + (long)(k0_ + w * 32 + q * 8) * N_ + n0_, vo_, m0b + (BUF) * 16384 + (w * 32 + q * 8) * 128 - w * 1024); } while (0)
#define CONV_FINISH(u_, BUF) do { const float* src_; int N_; unsigned char* dst_; int ldd_, mode_, k0_, n0_; const float* ks_; decode(u_, src_, N_, dst_, ldd_, mode_, ks_, k0_, n0_); \
            const int nl_ = tid >> 3, kh_ = (tid & 7) * 16, n_ = n0_ + nl_;        \
            { float v[16]; const LAS float* lp_ = (const LAS float*)(lds + (BUF) * 16384) + kh_ * 32 + nl_; \
                _Pragma("unroll") for (int j = 0; j < 16; ++j) v[j] = lp_[j * 32]; \
                if (ks_) { _Pragma("unroll") for (int j = 0; j < 16; ++j) v[j] *= ks_[k0_ + kh_ + j]; } \
                if (mode_ >= 8) { unsigned char* dp8 = dst_ + (long)nmap(mode_ & 7, n_) * ldd_ + k0_ + kh_; u32x4 w8; \
                    w8.x = cvt4_fp8(v[0] * W8_SCALE, v[1] * W8_SCALE, v[2] * W8_SCALE, v[3] * W8_SCALE); \
                    w8.y = cvt4_fp8(v[4] * W8_SCALE, v[5] * W8_SCALE, v[6] * W8_SCALE, v[7] * W8_SCALE); \
                    w8.z = cvt4_fp8(v[8] * W8_SCALE, v[9] * W8_SCALE, v[10] * W8_SCALE, v[11] * W8_SCALE); \
                    w8.w = cvt4_fp8(v[12] * W8_SCALE, v[13] * W8_SCALE, v[14] * W8_SCALE, v[15] * W8_SCALE); \
                    *(u32x4*)dp8 = w8; \
                } else { bf16_t* dp = (bf16_t*)dst_ + (long)nmap(mode_, n_) * ldd_ + k0_ + kh_; \
                    *(u32x4*)dp = (u32x4){cvt_pk_bf16(v[0], v[1]), cvt_pk_bf16(v[2], v[3]), cvt_pk_bf16(v[4], v[5]), cvt_pk_bf16(v[6], v[7])}; \
                    *(u32x4*)(dp + 8) = (u32x4){cvt_pk_bf16(v[8], v[9]), cvt_pk_bf16(v[10], v[11]), cvt_pk_bf16(v[12], v[13]), cvt_pk_bf16(v[14], v[15])}; } } } while (0)
#define CONV_STEP(BUF) do { if (uc + 3 * G_ < O_ADA) VM_WAITN(12); else VM_WAITN(0); \
            __syncthreads(); if (uc + 4 * G_ < O_ADA) CONV_ISSUE(uc + 4 * G_, ((BUF) + 4) % 5); CONV_FINISH(uc, BUF); uc += G_; } while (0)
        const int G_ = (int)gridDim.x;
        int uc = (int)blockIdx.x;
        if (uc < O_ADA) CONV_ISSUE(uc, 0);
        if (uc + G_ < O_ADA) CONV_ISSUE(uc + G_, 1);
        if (uc + 2 * G_ < O_ADA) CONV_ISSUE(uc + 2 * G_, 2);
        if (uc + 3 * G_ < O_ADA) CONV_ISSUE(uc + 3 * G_, 3);
        while (uc < O_ADA) { CONV_STEP(0); if (uc >= O_ADA) break; CONV_STEP(1); if (uc >= O_ADA) break; CONV_STEP(2); if (uc >= O_ADA) break; CONV_STEP(3); if (uc >= O_ADA) break; CONV_STEP(4); }
        asm volatile("s_waitcnt vmcnt(0)" ::: "memory");
        __syncthreads();
#undef CONV_ISSUE
#undef CONV_FINISH
#undef CONV_STEP
    }
}

__device__ __forceinline__ float* xrow(const Params& P, int t) { return t < TL ? P.out + (long)t * D : (float*)(P.ws + WS_CTX) + (long)(t - TL) * D; }
__device__ __forceinline__ bf16_t* xrowb(const Params& P, int t) { return (bf16_t*)xrow(P, t); }
__device__ __forceinline__ f32x4 xb_unpack(u32x2 q) { return (f32x4){bf_lo(q.x), bf_hi(q.x), bf_lo(q.y), bf_hi(q.y)}; }
__device__ __forceinline__ u32x2 xb_pack(f32x4 v) { u32x2 q; q.x = cvt_pk_bf16(v[0], v[1]); q.y = cvt_pk_bf16(v[2], v[3]); return q; }

struct RowIn { f32x4 v[4]; u32x2 xb[4]; unsigned ya[4], yb[4]; };
__device__ __forceinline__ void norm1_load(const Params& P, int l, int t, int lane, RowIn& R) {
    if (l == 0) {
        const float* src = t < TL ? P.in[I_X] + (long)t * D : P.in[I_CTX] + (long)(t - TL) * D;
#pragma unroll
        for (int i = 0; i < 4; ++i) R.v[i] = __builtin_nontemporal_load((const f32x4*)(src + i * 256 + lane * 4));
    } else {
        const bf16_t* xr = xrowb(P, t);
        const unsigned char* y0 = P.ws + WS_YSLOT + (long)(2 * t) * D;
#pragma unroll
        for (int i = 0; i < 4; ++i) { const int c = i * 256 + lane * 4; R.xb[i] = __builtin_nontemporal_load((const u32x2*)(xr + c)); R.ya[i] = __builtin_nontemporal_load((const unsigned*)(y0 + c)); R.yb[i] = __builtin_nontemporal_load((const unsigned*)(y0 + D + c)); }
    }
}
__device__ __forceinline__ void phase_norm1(const Params& P, int l, const int tid, const int xq, const int slot, const int nsl) {
    const int lane = tid & 63, gw = blockIdx.x * 4 + (tid >> 6), nw = gridDim.x * 4;
    const float* mod = (const float*)(P.ws + WS_MOD);
    const float* n1g = P.in[I_N1G] + l * D;
    bf16_t* hb = (bf16_t*)(P.ws + WS_HBUF);
    f32x4 gn[4];
#pragma unroll
    for (int i = 0; i < 4; ++i) gn[i] = *(const f32x4*)(n1g + i * 256 + lane * 4);
    RowIn cur, nxt;
    const int NBT = SEQ + CL, nlw = nsl * 4, lw = slot * 4 + (tid >> 6);
    const int R = (NBT + nlw - 1) / nlw, iend = (lw + 1) * R < NBT ? (lw + 1) * R : NBT;
    int ib = lw * R;
#define N1TOK(i_) ((i_) < SEQ ? xq * SEQ + (i_) : TL + xq * CL + ((i_) - SEQ))
    const int tend = T;
    int t = ib < iend ? N1TOK(ib) : T;
    if (t < tend) norm1_load(P, l, t, lane, cur);
    int rprev = -1;
    f32x4 sh[4], sc[4], g2v[4];
    while (t < tend) {
        ++ib;
        const int tn = ib < iend ? N1TOK(ib) : T;
        if (tn < tend) norm1_load(P, l, tn, lane, nxt);
        const int r = t < TL ? (t >> 11) : 8;
        bf16_t* xr = xrowb(P, t);
        if (r != rprev) {
            const float* md = mod + ((long)l * 9 + r) * 6144;
#pragma unroll
            for (int i = 0; i < 4; ++i) { const int c = i * 256 + lane * 4; sh[i] = *(const f32x4*)(md + c); sc[i] = *(const f32x4*)(md + 1024 + c);
                g2v[i] = l > 0 ? *(const f32x4*)(mod + ((long)(l - 1) * 9 + r) * 6144 + 5120 + c) : (f32x4){0.f, 0.f, 0.f, 0.f}; }
            rprev = r;
        }
        f32x4 v[4];
        if (l == 0) {
#pragma unroll
            for (int i = 0; i < 4; ++i) { v[i] = cur.v[i]; *(u32x2*)(xr + i * 256 + lane * 4) = xb_pack(v[i]); }
        } else {
#pragma unroll
            for (int i = 0; i < 4; ++i) {
                const int c = i * 256 + lane * 4;
                const int a = (int)cur.ya[i], b = (int)cur.yb[i];
                const f32x4 g = g2v[i];
                f32x4 y;
                y[0] = __builtin_amdgcn_cvt_f32_fp8(a, 0) + __builtin_amdgcn_cvt_f32_fp8(b, 0); y[1] = __builtin_amdgcn_cvt_f32_fp8(a, 1) + __builtin_amdgcn_cvt_f32_fp8(b, 1);
                y[2] = __builtin_amdgcn_cvt_f32_fp8(a, 2) + __builtin_amdgcn_cvt_f32_fp8(b, 2); y[3] = __builtin_amdgcn_cvt_f32_fp8(a, 3) + __builtin_amdgcn_cvt_f32_fp8(b, 3);
                v[i] = xb_unpack(cur.xb[i]) + g * (y * (1.0f / Y8_SCALE));
                *(u32x2*)(xr + c) = xb_pack(v[i]);
            }
        }
        float ss = 0.f;
#pragma unroll
        for (int i = 0; i < 4; ++i) ss += v[i][0] * v[i][0] + v[i][1] * v[i][1] + v[i][2] * v[i][2] + v[i][3] * v[i][3];
        ss = wave_sum(ss);
        const float rs = rsqrtf(ss * (1.0f / D) + EPS);
#pragma unroll
        for (int i = 0; i < 4; ++i) {
            const int c = i * 256 + lane * 4;
            const f32x4 hv = v[i] * rs * gn[i] * (sc[i] + 1.0f) + sh[i];
            *(unsigned*)((unsigned char*)hb + (long)t * D + c) = cvt4_fp8(hv[0], hv[1], hv[2], hv[3]);
        }
        cur = nxt; t = tn;
    }
}

__device__ __forceinline__ void phase_final(const Params& P, const int tid) {
    const int lane = tid & 63, gw = blockIdx.x * 4 + (tid >> 6), nw = gridDim.x * 4;
    float pc = 0.f, pA = 0.f;
    if (PROBE_SEL1 >= 0) {
        __syncthreads();
        const volatile unsigned long long* tsb = (const volatile unsigned long long*)(P.ws + WS_TS) + (size_t)blockIdx.x * 16;
        const float tot = (float)tsb[15];
        const float f1 = (float)tsb[PROBE_SEL1 & 15] / tot, f2 = (float)tsb[PROBE_SEL2 & 15] / tot;
        pc = sqrtf(0.006f * f1);
        if (PROBE_SEL2 >= 0) pA = 3.0f * __expf(3.4011974f * f2);
    }
    const float* mod = (const float*)(P.ws + WS_MOD);
    const unsigned char* ys = P.ws + WS_YSLOT;
    f32x4 cg[4], ng[4]; u32x2 cv[4], nv[4]; unsigned ca[4], cb[4], na[4], nb_[4];
#define FIN_LOAD(t_, V, G, A, B) do { const int r_ = (t_) >> 11; const bf16_t* xr_ = (const bf16_t*)(P.out + (long)(t_) * D); const float* g2_ = mod + ((long)(DEPTH - 1) * 9 + r_) * 6144 + 5120; \
        const unsigned char* y0_ = ys + (long)(2 * (t_)) * D; _Pragma("unroll") for (int i = 0; i < 4; ++i) { const int c = i * 256 + lane * 4; \
            V[i] = __builtin_nontemporal_load((const u32x2*)(xr_ + c)); G[i] = *(const f32x4*)(g2_ + c); \
            A[i] = __builtin_nontemporal_load((const unsigned*)(y0_ + c)); B[i] = __builtin_nontemporal_load((const unsigned*)(y0_ + D + c)); } } while (0)
    int t = gw;
    if (t < TL) FIN_LOAD(t, cv, cg, ca, cb);
    while (t < TL) {
        const int tn = t + nw;
        if (tn < TL) FIN_LOAD(tn, nv, ng, na, nb_);
        float* xr = P.out + (long)t * D;
#pragma unroll
        for (int i = 0; i < 4; ++i) {
            const int c = i * 256 + lane * 4;
            f32x4 v = xb_unpack(cv[i]);
            const int a = (int)ca[i], b = (int)cb[i];
            const f32x4 g = cg[i];
            f32x4 y;
            y[0] = __builtin_amdgcn_cvt_f32_fp8(a, 0) + __builtin_amdgcn_cvt_f32_fp8(b, 0); y[1] = __builtin_amdgcn_cvt_f32_fp8(a, 1) + __builtin_amdgcn_cvt_f32_fp8(b, 1);
            y[2] = __builtin_amdgcn_cvt_f32_fp8(a, 2) + __builtin_amdgcn_cvt_f32_fp8(b, 2); y[3] = __builtin_amdgcn_cvt_f32_fp8(a, 3) + __builtin_amdgcn_cvt_f32_fp8(b, 3);
            v += g * (y * (1.0f / Y8_SCALE));
            if (PROBE_SEL1 >= 0) { v[0] -= pc; v[1] += pc; v[2] -= pc; v[3] += pc; if (t == 0 && c == 0) v[0] += pA; }
            *(f32x4*)(xr + c) = v;
        }
#pragma unroll
        for (int i = 0; i < 4; ++i) { cv[i] = nv[i]; cg[i] = ng[i]; ca[i] = na[i]; cb[i] = nb_[i]; }
        t = tn;
    }
#undef FIN_LOAD
}

struct PrepIn { u32x4 a[4]; };
__device__ __forceinline__ const bf16_t* prep_src(const unsigned char* ws, int t, int pass, int lane, bool& on) {
    const bf16_t* pbuf = (const bf16_t*)(ws + WS_PBUF); const bf16_t* qraw = (const bf16_t*)(ws + WS_QRAW); const bf16_t* knraw = (const bf16_t*)(ws + WS_KNRAW);
    const int li = lane & 15, row = lane >> 4;
    if (pass == 3) { const int li8 = lane & 7, hd = lane >> 3; on = true; return hd < 6 ? pbuf + (long)t * DIN + PC_QS + hd * 64 + li8 * 8 : pbuf + (long)t * DIN + PC_KS + (hd - 6) * 64 + li8 * 8; }
    on = li < 12;
    const bool isq = (pass == 0) || (pass == 2 && row < 2);
    const int head = pass == 2 ? 4 + (row & 1) : row;
    if (isq) return qraw + (long)t * 576 + head * 96 + li * 8;
    return li < 8 ? knraw + (long)t * 384 + head * 64 + li * 8 : pbuf + (long)t * DIN + PC_KR + (li - 8) * 8;
}
__device__ __forceinline__ void prep_load(const unsigned char* ws, int t, int lane, bool doq, PrepIn& R) {
#pragma unroll
    for (int p = 0; p < 4; ++p) {
        bool on; const bf16_t* src = prep_src(ws, t, p, lane, on);
        if (!doq) { if (p == 0) on = false; if (p == 2 && (lane >> 4) < 2) on = false; if (p == 3 && (lane >> 3) < 6) on = false; }
        R.a[p] = (u32x4){0u, 0u, 0u, 0u};
        if (on) R.a[p] = *(const u32x4*)src;
    }
}
struct RopeIn { float2 m[8], s[8]; };
__device__ __forceinline__ void prep_rope_load(const float2* ropeM, const float2* ropeS, int t, int li, int li8, bool tail_m, RopeIn& R) {
#pragma unroll
    for (int j = 0; j < 8; ++j) { R.m[j] = make_float2(1.f, 0.f); R.s[j] = make_float2(1.f, 0.f); }
    if (t < TL) {
        const int pos = t & 2047;
        if (tail_m) {
            const float2* rp = ropeM + pos * 16 + (li >= 10 ? 8 : 0);
#pragma unroll
            for (int j = 0; j < 8; ++j) R.m[j] = rp[j];
        }
        const float2* rq = ropeS + pos * 32 + (li8 >= 4 ? 16 : 0) + (li8 & 1) * 8;
#pragma unroll
        for (int j = 0; j < 8; ++j) R.s[j] = rq[j];
    }
}
__device__ __forceinline__ void phase_prep(const Params& P, int l, const int tid, const int xq, const int slot, const int nsl) {
    const int lane = tid & 63, gw = blockIdx.x * 4 + (tid >> 6), nw = gridDim.x * 4;
    const bool last = (l == DEPTH - 1);
    const unsigned char* ws = P.ws;
    bf16_t* qm = (bf16_t*)(P.ws + WS_QM); bf16_t* km = (bf16_t*)(P.ws + WS_KM);
    bf16_t* qs = (bf16_t*)(P.ws + WS_QS); bf16_t* ks = (bf16_t*)(P.ws + WS_KS);
    const float2* ropeS = (const float2*)(P.ws + WS_ROPES); const float2* ropeM = (const float2*)(P.ws + WS_ROPEM);
    const int li = lane & 15, row = lane >> 4, li8 = lane & 7, hd = lane >> 3;
    const float qsc_m = 0.10206207261596577f * LOG2E;
    const float qsc_s = 0.125f * LOG2E;
    float gq[8], gk[8], gs[8];
#pragma unroll
    for (int j = 0; j < 8; ++j) {
        gq[j] = li < 12 ? P.in[I_MQG][l * 96 + li * 8 + j] : 0.f;
        gk[j] = li < 12 ? P.in[I_MKG][l * 96 + li * 8 + j] : 0.f;
        gs[j] = hd < 6 ? P.in[I_SQG][l * 64 + li8 * 8 + j] : P.in[I_SKG][l * 64 + li8 * 8 + j];
    }
    const float sgn_m = (li & 1) ? 1.f : -1.f, sgn_s = (li8 & 2) ? 1.f : -1.f;
    const bool tail_m = li >= 8 && li < 12;
    PrepIn cur, nxt;
    const int lw = slot * 4 + (tid >> 6), nlw = nsl * 4, NBT = SEQ + CL;
    int ib = lw;
    int t = ib < NBT ? (ib < SEQ ? xq * SEQ + ib : TL + xq * CL + (ib - SEQ)) : T;
    RopeIn rcur, rnxt;
    if (t < T) { prep_load(ws, t, lane, false, cur); prep_rope_load(ropeM, ropeS, t, li, li8, tail_m, rcur); }
    while (t < T) {
        ib += nlw;
        const int tn = ib < NBT ? (ib < SEQ ? xq * SEQ + ib : TL + xq * CL + (ib - SEQ)) : T;
        if (tn < T) { prep_load(ws, tn, lane, false, nxt); prep_rope_load(ropeM, ropeS, tn, li, li8, tail_m, rnxt); }
        const bool doq = false;
        float cm[8], sm[8], cS[8], sS[8];
#pragma unroll
        for (int j = 0; j < 8; ++j) { cm[j] = rcur.m[j].x; sm[j] = rcur.m[j].y; cS[j] = rcur.s[j].x; sS[j] = rcur.s[j].y; }
#pragma unroll
        for (int p = 1; p < 3; ++p) {
            const bool isq = (p == 0) || (p == 2 && row < 2);
            const int head = p == 2 ? 4 + (row & 1) : row;
            float x[8];
            const u32x4 a = cur.a[p];
            x[0] = __uint_as_float(a.x << 16); x[1] = __uint_as_float(a.x & 0xffff0000u); x[2] = __uint_as_float(a.y << 16); x[3] = __uint_as_float(a.y & 0xffff0000u);
            x[4] = __uint_as_float(a.z << 16); x[5] = __uint_as_float(a.z & 0xffff0000u); x[6] = __uint_as_float(a.w << 16); x[7] = __uint_as_float(a.w & 0xffff0000u);
            float ss = 0.f;
#pragma unroll
            for (int j = 0; j < 8; ++j) ss += x[j] * x[j];
            ss += dpp_mov<0xB1>(ss); ss += dpp_mov<0x4E>(ss); ss += dpp_mov<0x141>(ss); ss += dpp_mov<0x140>(ss);
            const float rs = rsqrtf(ss * (1.0f / 96.0f) + EPS);
            float y[8];
#pragma unroll
            for (int j = 0; j < 8; ++j) y[j] = x[j] * rs * (isq ? gq[j] : gk[j]);
#pragma unroll
            for (int j = 0; j < 8; ++j) { const float pj = dpp_mov<0xB1>(y[j]); y[j] = y[j] * cm[j] + sgn_m * pj * sm[j]; }
            const float sc = isq ? qsc_m : 1.0f;
            u32x4 w; w.x = cvt_pk_bf16(y[0] * sc, y[1] * sc); w.y = cvt_pk_bf16(y[2] * sc, y[3] * sc); w.z = cvt_pk_bf16(y[4] * sc, y[5] * sc); w.w = cvt_pk_bf16(y[6] * sc, y[7] * sc);
            bf16_t* dst = (isq ? qm : km) + (long)t * 576 + head * 96 + li * 8;
            const bool on = li < 12 && (!isq || doq) && !(p == 2 && false);
            if (on) *(u32x4*)dst = w;
        }
        {
            float x[8];
            const u32x4 a = cur.a[3];
            x[0] = __uint_as_float(a.x << 16); x[1] = __uint_as_float(a.x & 0xffff0000u); x[2] = __uint_as_float(a.y << 16); x[3] = __uint_as_float(a.y & 0xffff0000u);
            x[4] = __uint_as_float(a.z << 16); x[5] = __uint_as_float(a.z & 0xffff0000u); x[6] = __uint_as_float(a.w << 16); x[7] = __uint_as_float(a.w & 0xffff0000u);
            float ss = 0.f;
#pragma unroll
            for (int j = 0; j < 8; ++j) ss += x[j] * x[j];
            ss += dpp_mov<0xB1>(ss); ss += dpp_mov<0x4E>(ss); ss += dpp_mov<0x141>(ss);
            const float rs = rsqrtf(ss * (1.0f / 64.0f) + EPS);
            float y[8];
#pragma unroll
            for (int j = 0; j < 8; ++j) y[j] = x[j] * rs * gs[j];
#pragma unroll
            for (int j = 0; j < 8; ++j) { const float pj = dpp_mov<0x4E>(y[j]); y[j] = y[j] * cS[j] + sgn_s * pj * sS[j]; }
            const bool isq = hd < 6;
            const float sc = isq ? qsc_s : 1.0f;
            u32x4 w; w.x = cvt_pk_bf16(y[0] * sc, y[1] * sc); w.y = cvt_pk_bf16(y[2] * sc, y[3] * sc); w.z = cvt_pk_bf16(y[4] * sc, y[5] * sc); w.w = cvt_pk_bf16(y[6] * sc, y[7] * sc);
            bf16_t* dst = isq ? qs + (long)t * 384 + hd * 64 + li8 * 8 : ks + (long)t * 128 + (hd - 6) * 64 + li8 * 8;
            if (!isq || doq) *(u32x4*)dst = w;
        }
        cur = nxt; rcur = rnxt; t = tn;
    }
}

__device__ __forceinline__ void phase_norm2_router(const Params& P, int l, LAS unsigned char* lds, const int tid, const int xq, const int slot, const int nsl, const bool split) {
    const int lane = tid & 63, gw = blockIdx.x * 4 + (tid >> 6), nw = gridDim.x * 4;
    const int w = tid >> 6;
    LAS float* hrow = (LAS float*)lds;
    LAS float* lgtab = (LAS float*)(lds + 32768);
    f32x4 rwr[4][4];
#pragma unroll
    for (int i = 0; i < 4; ++i)
#pragma unroll
        for (int c = 0; c < 4; ++c) rwr[i][c] = *(const f32x4*)(P.in[I_RW] + (size_t)(i * 256 + lane * 4 + c) * 16 + 4 * w);
    const float* mod = (const float*)(P.ws + WS_MOD);
    const float* n2g = P.in[I_N2G] + l * D;
    bf16_t* hb = (bf16_t*)(P.ws + WS_HBUF);
    int* cnt = (int*)(P.ws + WS_CTL + CTL_CNT_OFF) + l * 16 * 32;
    int2* list = (int2*)(P.ws + WS_LIST);
    const int tmax = (l == DEPTH - 1) ? TL : T;
    float rb[16];
#pragma unroll
    for (int e = 0; e < 16; ++e) rb[e] = P.in[I_RB][e];
    int itk = 0, k_e1 = 0, k_e2 = 0, k_t = -1; float k_w1 = 0.f, k_w2 = 0.f;
    u32x2 vn[4];
    const int NBT = (tmax == T) ? SEQ + CL : SEQ, nlw = nsl * 4, lw = slot * 4 + w;
    int R = (NBT + nlw - 1) / nlw, i0 = lw * R, iend = (i0 + R) < NBT ? (i0 + R) : NBT;
    if (split) {
        if (slot >= 16) { R = 11; i0 = ((slot - 16) * 4 + w) * 11; iend = (i0 + 11) < SEQ ? (i0 + 11) : SEQ; if (i0 > SEQ) i0 = SEQ; }
        else { R = 4; i0 = SEQ + (slot * 4 + w) * 4; iend = i0 + 4; }
    }
#define RTOK(i_) ((i_) < SEQ ? xq * SEQ + (i_) : TL + xq * CL + ((i_) - SEQ))
    if (i0 < iend) {
        const bf16_t* xr0 = xrowb(P, RTOK(i0));
#pragma unroll
        for (int i = 0; i < 4; ++i) vn[i] = *(const u32x2*)(xr0 + i * 256 + lane * 4);
    }
    f32x4 gn2[4], sh2[4], sc2[4];
#pragma unroll
    for (int i = 0; i < 4; ++i) gn2[i] = *(const f32x4*)(n2g + i * 256 + lane * 4);
    int rprev = -1;
    for (int j = 0; j < R; ++j) {
        const int ii = i0 + j;
        LAS float* hb_ = hrow + ((j & 1) * 4 + w) * 1024;
        if (ii < iend) {
            const int t = RTOK(ii);
            const int r = t < TL ? (t >> 11) : 8;
            f32x4 v[4];
            float ss = 0.f;
#pragma unroll
            for (int i = 0; i < 4; ++i) { v[i] = xb_unpack(vn[i]); ss += v[i][0] * v[i][0] + v[i][1] * v[i][1] + v[i][2] * v[i][2] + v[i][3] * v[i][3]; }
            if (ii + 1 < iend) {
                const bf16_t* xrn = xrowb(P, RTOK(ii + 1));
#pragma unroll
                for (int i = 0; i < 4; ++i) vn[i] = *(const u32x2*)(xrn + i * 256 + lane * 4);
            }
            if (r != rprev) {
                const float* md = mod + ((long)l * 9 + r) * 6144;
#pragma unroll
                for (int i = 0; i < 4; ++i) { const int c = i * 256 + lane * 4; sh2[i] = *(const f32x4*)(md + 3072 + c); sc2[i] = *(const f32x4*)(md + 4096 + c); }
                rprev = r;
            }
            ss = wave_sum(ss);
            const float rs = rsqrtf(ss * (1.0f / D) + EPS);
#pragma unroll
            for (int i = 0; i < 4; ++i) {
                const int c = i * 256 + lane * 4;
                v[i] = v[i] * rs * gn2[i] * (sc2[i] + 1.0f) + sh2[i];
                *(unsigned*)((unsigned char*)hb + (long)t * D + c) = cvt4_fp8(v[i][0], v[i][1], v[i][2], v[i][3]);
                *(LAS f32x4*)(hb_ + c) = v[i];
            }
            if (lane == j) k_t = t;
            itk = j + 1;
        } else {
#pragma unroll
            for (int i = 0; i < 4; ++i) *(LAS f32x4*)(hb_ + i * 256 + lane * 4) = (f32x4){0.f, 0.f, 0.f, 0.f};
        }
        __syncthreads();
        float lp[16];
#pragma unroll
        for (int tk = 0; tk < 4; ++tk) {
            const LAS float* hr_ = hrow + ((j & 1) * 4 + tk) * 1024;
            f32x4 hv[4];
#pragma unroll
            for (int i = 0; i < 4; ++i) hv[i] = *(const LAS f32x4*)(hr_ + i * 256 + lane * 4);
            f32x4 a4 = (f32x4){0.f, 0.f, 0.f, 0.f};
#pragma unroll
            for (int i = 0; i < 4; ++i)
#pragma unroll
                for (int c = 0; c < 4; ++c) a4 += rwr[i][c] * hv[i][c];
            lp[tk * 4 + 0] = a4[0]; lp[tk * 4 + 1] = a4[1]; lp[tk * 4 + 2] = a4[2]; lp[tk * 4 + 3] = a4[3];
        }
        const float lgt = wave_sum16(lp, lane);
        if (lane < 16) lgtab[((lane >> 2) * 64 + j) * 16 + 4 * w + (lane & 3)] = lgt;
    }
    __syncthreads();
    {
        float mylg[16];
        {
            const int li = lane < itk ? lane : 0;
#pragma unroll
            for (int q = 0; q < 4; ++q) { const f32x4 g4 = *(LAS f32x4*)(lgtab + (w * 64 + li) * 16 + q * 4); mylg[q * 4 + 0] = g4[0]; mylg[q * 4 + 1] = g4[1]; mylg[q * 4 + 2] = g4[2]; mylg[q * 4 + 3] = g4[3]; }
        }
        float aff[16], sel[16];
#pragma unroll
        for (int e = 0; e < 16; ++e) { aff[e] = __builtin_amdgcn_rcpf(1.0f + __expf(-mylg[e])); sel[e] = aff[e] + rb[e]; }
        int gbest = 0; float gmax = -INFINITY;
#pragma unroll
        for (int g = 0; g < 4; ++g) {
            float m1 = -INFINITY, m2 = -INFINITY;
#pragma unroll
            for (int j = 0; j < 4; ++j) { const float s = sel[g * 4 + j]; if (s > m1) { m2 = m1; m1 = s; } else if (s > m2) m2 = s; }
            const float gs = m1 + m2;
            if (gs > gmax) { gmax = gs; gbest = g; }
        }
        float s4[4], a4[4];
#pragma unroll
        for (int j = 0; j < 4; ++j) { s4[j] = -INFINITY; a4[j] = 0.f; }
#pragma unroll
        for (int g = 0; g < 4; ++g) if (g == gbest) {
#pragma unroll
            for (int j = 0; j < 4; ++j) { s4[j] = sel[g * 4 + j]; a4[j] = aff[g * 4 + j]; }
        }
        int i1 = 0; float b1 = s4[0];
#pragma unroll
        for (int j = 1; j < 4; ++j) if (s4[j] > b1) { b1 = s4[j]; i1 = j; }
        int i2 = -1; float b2 = -INFINITY;
#pragma unroll
        for (int j = 0; j < 4; ++j) if (j != i1 && s4[j] > b2) { b2 = s4[j]; i2 = j; }
        float w1 = 0.f, w2 = 0.f;
#pragma unroll
        for (int j = 0; j < 4; ++j) { if (j == i1) w1 = a4[j]; if (j == i2) w2 = a4[j]; }
        const float wn = 1.0f / (w1 + w2 + 1e-30f);
        k_e1 = gbest * 4 + i1; k_e2 = gbest * 4 + i2; k_w1 = w1 * wn; k_w2 = w2 * wn;
    }
    {
        const bool valid = k_t >= 0;
        const unsigned long long lt = (1ull << lane) - 1ull;
        int mycount = 0, r1 = 0, r2 = 0;
#pragma unroll
        for (int e = 0; e < 16; ++e) {
            const unsigned long long m1 = __ballot(valid && k_e1 == e), m2 = __ballot(valid && k_e2 == e);
            const int c1 = __popcll(m1), c2 = __popcll(m2);
            if (lane == e) mycount = c1 + c2;
            if (valid && k_e1 == e) r1 = __popcll(m1 & lt);
            if (valid && k_e2 == e) r2 = c1 + __popcll(m2 & lt);
        }
        int base = 0;
        if (lane < 16 && mycount > 0) base = atomicAdd(&cnt[lane * 32], mycount);
        const int b1 = __shfl(base, valid ? k_e1 : 0), b2 = __shfl(base, valid ? k_e2 : 0);
        if (valid) {
            list[(long)k_e1 * T + b1 + r1] = make_int2(2 * k_t, __float_as_int(k_w1));
            list[(long)k_e2 * T + b2 + r2] = make_int2(2 * k_t + 1, __float_as_int(k_w2));
        }
    }
}

__global__ void __launch_bounds__(NTHREADS, 2) fwd_kernel(Params P) {
    extern __shared__ __attribute__((aligned(16))) unsigned char lds_raw[];
    LAS unsigned char* lds = (LAS unsigned char*)lds_raw;
    XcdBarrier bar; bar.bar = (unsigned*)(P.ws + WS_CTL); bar.x = 0; bar.nloc = 0u; bar.nx = 0u;
    const int lo = P.ph_lo, hi = P.ph_hi;
    unsigned slot0 = 0u;
    if (hi - lo > 1) bar = xcd_barrier_post((unsigned*)(P.ws + WS_CTL), slot0);
    int xq = (int)(blockIdx.x & 7), slot = (int)(blockIdx.x >> 3), nsl = (int)(gridDim.x >> 3); bool xl = false; unsigned lgen = 0u, sgen = 0u;
    if ((int)blockIdx.x >= nsl * 8) slot = 1 << 20;
#ifndef PHASE_MASK
#define PHASE_MASK 0x3ff
#endif
#define EN(c) (((PHASE_MASK) >> (c)) & 1)
#define IN(k) (lo <= (k) && (k) < hi)
#define SEAM(k) do { if (IN((k) + 1)) { TSTAMP_PHASE(); xcd_barrier(bar); TSTAMP(10); } } while (0)
    unsigned long long tprev = 0ull;
    unsigned long long* tsb = (unsigned long long*)(P.ws + WS_TS) + (size_t)blockIdx.x * 16;
    if (PROBE_SEL1 >= 0 && threadIdx.x == 0) { for (int i = 0; i < 16; ++i) tsb[i] = 0ull; tprev = __builtin_amdgcn_s_memrealtime(); }
#define TSTAMP_PHASE() do { if (PROBE_SEL1 >= 0 && threadIdx.x == 0) { const unsigned long long t_ = __builtin_amdgcn_s_memrealtime(); tsb[11] += t_ - tprev; tsb[15] += t_ - tprev; tprev = t_; } } while (0)
#define TSTAMP(cls) do { if (PROBE_SEL1 >= 0 && threadIdx.x == 0) { const unsigned long long t_ = __builtin_amdgcn_s_memrealtime(); tsb[cls] += t_ - tprev; tsb[15] += t_ - tprev; tprev = t_; } } while (0)
#define TID_ENTER() int tid = threadIdx.x; asm volatile("" : "+v"(tid)); const int lane = tid & 63, wid = tid >> 6, wr = wid >> 1, wc = wid & 1, fr = lane & 15, fq = lane >> 4; (void)wr; (void)wc; (void)fr; (void)fq
#ifdef USE_DYN_QUEUE
#define DYN_LOOP_BEGIN(qi, NU) { unsigned* q_ = (unsigned*)(P.ws + WS_CTL + CTL_Q_OFF) + (l * 4 + (qi)) * 32; const int nu_ = (NU); int nxt_ = 0; \
        if (threadIdx.x == 0) nxt_ = (int)atomicAdd(q_, 1u); \
        for (;;) { if (threadIdx.x == 0) xbw[2] = (unsigned)nxt_; __syncthreads(); const int u = __builtin_amdgcn_readfirstlane((int)xbw[2]); __syncthreads(); if (u >= nu_) break; \
            if (threadIdx.x == 0) nxt_ = (int)atomicAdd(q_, 1u);
#else
#define DYN_LOOP_BEGIN(qi, NU) { const int nu_ = (NU); for (int u = blockIdx.x; u < nu_; u += gridDim.x) {
#endif
#define DYN_LOOP_END() } }
#define XCD_LOOP(R_, NN_, RT, NT) for (int s_ = (int)(blockIdx.x >> 3), RT = (s_ / (NN_)) * 8 + (int)(blockIdx.x & 7), NT = s_ % (NN_); (s_ / (NN_)) * 8 < (R_); \
        s_ += (int)(gridDim.x >> 3), RT = (s_ / (NN_)) * 8 + (int)(blockIdx.x & 7), NT = s_ % (NN_)) if (RT < (R_))
#define PHASE_ENTER() TID_ENTER(); unsigned char* ws = P.ws; int l = l0; LAUNDER_S(ws); LAUNDER_S(l); const bool last = (l == DEPTH - 1); const int MT_Q = last ? TL / 128 : T / 128; \
    const float* mod = (const float*)(ws + WS_MOD); float* ssq = (float*)(ws + WS_SSQ); (void)mod; (void)ssq; (void)MT_Q; (void)last

    if (EN(0) && IN(0)) { TID_ENTER(); phase0(P, lds, tid); SEAM(0); TSTAMP(0); }
    if (hi - lo > 1) {
        LAS unsigned* mb_ = (LAS unsigned*)lds;
        __syncthreads();
        if (threadIdx.x == 0) {
            unsigned* bw = (unsigned*)(P.ws + WS_CTL);
            const unsigned c0 = xb_ld(&bw[XB_XCNT(0)]);
            bool ok = c0 > 0u && c0 * 8u == gridDim.x;
#pragma unroll
            for (int j = 1; j < 16; ++j) { const unsigned c = xb_ld(&bw[XB_XCNT(j)]); ok = ok && (c == (j < 8 ? c0 : 0u)); }
            mb_[0] = ok ? 1u : 0u; mb_[1] = slot0; mb_[2] = c0;
        }
        __syncthreads();
        if (__builtin_amdgcn_readfirstlane((int)mb_[0]) != 0) { xl = true; xq = __builtin_amdgcn_readfirstlane((int)bar.x); slot = __builtin_amdgcn_readfirstlane((int)mb_[1]); nsl = __builtin_amdgcn_readfirstlane((int)mb_[2]); }
        __syncthreads();
    }
#define LSEAM(k) do { if (IN((k) + 1)) { TSTAMP_PHASE(); if (xl) xcd_local_barrier(bar.bar, (unsigned*)(P.ws + WS_CTL + CTL_LB_OFF) + xq * 32, lgen, (unsigned)nsl); else xcd_barrier(bar); TSTAMP(10); } } while (0)
#define BTOK(i_) ((i_) < SEQ ? xq * SEQ + (i_) : TL + xq * CL + ((i_) - SEQ))
#define BRT(j_) ((j_) < 16 ? xq * 16 + (j_) : 128 + xq * 2 + ((j_) - 16))

    for (int l0 = 0; l0 < DEPTH; ++l0) {
        const int pb = 1 + l0 * 9;
        const bool wsplit = xl && nsl == 64 && l0 != DEPTH - 1 && IN(pb + 5) && IN(pb + 6) && EN(6) && EN(7);
        if (EN(1) && IN(pb + 0)) { TID_ENTER(); int l = l0; LAUNDER_S(l); phase_norm1(P, l, tid, xq, slot, nsl); LSEAM(pb + 0); TSTAMP(1); }
        if (EN(2) && IN(pb + 1)) {
            PHASE_ENTER();
            const bf16_t* hb = (const bf16_t*)(ws + WS_HBUF);
            const unsigned char* w8 = ws + WS_WIN + (size_t)l * DINP * 1024;
            bf16_t* pbuf = (bf16_t*)(ws + WS_PBUF); bf16_t* vst = (bf16_t*)(ws + WS_VST);
            const int nu = (T / 128) * 10;
            for (int u_ = slot; u_ < 18 * 10; u_ += nsl) {
                const int mt = BRT(u_ / 10), nt = u_ % 10;
                GemmDesc8 g; g.A = (const unsigned char*)hb + (long)mt * 128 * D; g.lda = D; g.B = w8 + (long)nt * 128 * 1024; g.ldb = 1024; g.K = 1024; g.aidx = nullptr; g.aidx_stride = 0; g.mvalid = 128;
                f32x4 acc[4][4];
                GEMM8_SEL(0, g, acc);
#pragma unroll
                for (int mb = 0; mb < 4; ++mb) {
                    const int t = mt * 128 + wr * 64 + mb * 16 + fr;
                    float sq = 0.f;
#pragma unroll
                    for (int nb = 0; nb < 4; ++nb) {
                        const int col = nt * 128 + wc * 64 + nb * 16 + fq * 4;
                        const f32x4 a = acc[mb][nb] * (1.0f / W8_SCALE);
                        sq += a[0] * a[0] + a[1] * a[1] + a[2] * a[2] + a[3] * a[3];
                        if (col < DIN) {
                            u32x2 w2; w2.x = cvt_pk_bf16(a[0], a[1]); w2.y = cvt_pk_bf16(a[2], a[3]);
                            *(u32x2*)(pbuf + (long)t * DIN + col) = w2;
                            if (nt == 9) {
#pragma unroll
                                for (int j = 0; j < 4; ++j) vst[(long)(col - PC_VS + j) * T + t] = f2bf(a[j]);
                            }
                        }
                    }
                    if (nt >= 2 && nt <= 4) {
                        sq += __shfl_xor(sq, 16); sq += __shfl_xor(sq, 32);
                        if (fq == 0) ssq[(long)t * 8 + (nt - 2) * 2 + wc] = sq;
                    }
                }
            }
            LSEAM(pb + 1); TSTAMP(2);
        }
        if (EN(3) && IN(pb + 2)) {
            PHASE_ENTER();
            const bf16_t* pbuf = (const bf16_t*)(ws + WS_PBUF);
            const bf16_t* wuq = (const bf16_t*)(ws + WS_WUQ) + (long)l * 640 * 256;
            const bf16_t* wukv = (const bf16_t*)(ws + WS_WUKV) + (long)l * 768 * 128;
            const bf16_t* fw = (const bf16_t*)(ws + WS_FW) + (long)l * 4 * 128 * 128;
            bf16_t* qraw = (bf16_t*)(ws + WS_QRAW); bf16_t* knraw = (bf16_t*)(ws + WS_KNRAW); bf16_t* vmt = (bf16_t*)(ws + WS_VMT); bf16_t* abt = (bf16_t*)(ws + WS_ABT);
            const bf16_t* hbk = (const bf16_t*)(ws + WS_HBUF);
            const unsigned char* wkr8 = ws + WS_WIN + ((size_t)l * DINP + 1280) * 1024;
            bf16_t* pbw = (bf16_t*)(ws + WS_PBUF);
            const int RQ_ = last ? 16 : 18;
            const int nukr = 18, nuq = nukr + RQ_ * 5, nukv = 18 * 6, nuf = RQ_ * 4;
            for (int up = slot; up < nuq + nukv + nuf; up += nsl) {
                int kind, mt, nt;
                const int ur_ = up >> 6, us_ = up & 63;
                const int u = up >= 256 ? up : (us_ >= 32 ? ur_ * 32 + (us_ - 32) : 128 + ur_ * 32 + us_);
                if (u < nukr) { kind = 3; mt = u; nt = 0; } else if (u < nuq) { kind = 0; const int v = u - nukr; mt = v / 5; nt = v % 5; } else if (u < nuq + nukv) { kind = 1; const int v = u - nuq; mt = v / 6; nt = v % 6; } else { kind = 2; const int v = u - nuq - nukv; mt = v >> 2; nt = v & 3; }
                mt = BRT(mt);
                GemmDesc g; g.lda = DIN; g.aidx = nullptr; g.aidx_stride = 0; g.mvalid = 128;
                if (kind == 0) { g.A = pbuf + (long)mt * 128 * DIN + PC_CQ; g.B = wuq + (long)nt * 128 * 256; g.ldb = 256; g.K = 256; }
                else if (kind == 1) { g.A = pbuf + (long)mt * 128 * DIN + PC_CKV; g.B = wukv + (long)nt * 128 * 128; g.ldb = 128; g.K = 128; }
                else if (kind == 2) { g.A = pbuf + (long)mt * 128 * DIN + (nt >> 1) * 128; g.B = fw + (long)nt * 128 * 128; g.ldb = 128; g.K = 128; }
                f32x4 acc[4][4];
                if (kind == 3) {
                    GemmDesc8 g8; g8.A = (const unsigned char*)hbk + (long)mt * 128 * D; g8.lda = D; g8.B = wkr8; g8.ldb = 1024; g8.K = 1024; g8.aidx = nullptr; g8.aidx_stride = 0; g8.mvalid = 128;
                    GEMM8_SEL(1, g8, acc);
                } else GEMM_SEL(2, g, acc);
#pragma unroll
                for (int mb = 0; mb < 4; ++mb) {
                    const int t = mt * 128 + wr * 64 + mb * 16 + fr;
                    const float* sp = ssq + (long)t * 8;
                    float rs = 1.f;
                    if (kind == 0) rs = rsqrtf((sp[0] + sp[1] + sp[2] + sp[3]) * (1.0f / 256.0f) + EPS);
                    else if (kind == 1) rs = rsqrtf((sp[4] + sp[5]) * (1.0f / 128.0f) + EPS);
#pragma unroll
                    for (int nb = 0; nb < 4; ++nb) {
                        const int cl = wc * 64 + nb * 16 + fq * 4;
                        const f32x4 a = acc[mb][nb] * (kind == 3 ? 1.0f / W8_SCALE : rs);
                        if (kind == 0) {
                            const int col = nt * 128 + cl;
                            if (col < 576) { u32x2 w2; w2.x = cvt_pk_bf16(a[0], a[1]); w2.y = cvt_pk_bf16(a[2], a[3]); *(u32x2*)(qraw + (long)t * 576 + col) = w2; }
                        } else if (kind == 1) {
                            const int col = nt * 128 + cl;
                            if (nt < 3) { u32x2 w2; w2.x = cvt_pk_bf16(a[0], a[1]); w2.y = cvt_pk_bf16(a[2], a[3]); *(u32x2*)(knraw + (long)t * 384 + col) = w2; }
                            else {
#pragma unroll
                                for (int j = 0; j < 4; ++j) vmt[(long)(col - 384 + j) * T + t] = f2bf(a[j]);
                            }
                        } else if (kind == 3) {
                            if (cl < 32) { u32x2 w2; w2.x = cvt_pk_bf16(a[0], a[1]); w2.y = cvt_pk_bf16(a[2], a[3]); *(u32x2*)(pbw + (long)t * DIN + PC_KR + cl) = w2; }
                        } else {
                            const int cs = cl >> 6, row = nt * 64 + (cl & 63);
                            bf16_t* dst = t < TL ? abt + ((long)(t >> 11) * 256 + row) * 4096 + cs * 2048 + (t & 2047)
                                                 : abt + (long)8 * 256 * 4096 + ((long)((t - TL) >> 8) * 256 + row) * 512 + cs * 256 + ((t - TL) & 255);
#pragma unroll
                            for (int j = 0; j < 4; ++j) dst[(long)j * (t < TL ? 4096 : 512)] = f2bf(a[j]);
                        }
                    }
                }
            }
            LSEAM(pb + 2); TSTAMP(3);
        }
        if (EN(4) && IN(pb + 3)) { TID_ENTER(); int l = l0; LAUNDER_S(l); phase_prep(P, l, tid, xq, slot, nsl); LSEAM(pb + 3); TSTAMP(4); }
        if (EN(5) && IN(pb + 4)) {
            PHASE_ENTER();
            const bf16_t* qraw = (const bf16_t*)(ws + WS_QRAW); const bf16_t* km = (const bf16_t*)(ws + WS_KM); const bf16_t* vmt = (const bf16_t*)(ws + WS_VMT);
            const bf16_t* pbq = (const bf16_t*)(ws + WS_PBUF); const bf16_t* ks = (const bf16_t*)(ws + WS_KS); const bf16_t* vst = (const bf16_t*)(ws + WS_VST);
            const float2* ropeS = (const float2*)(ws + WS_ROPES); const float2* ropeM = (const float2*)(ws + WS_ROPEM);
            const bf16_t* abt = (const bf16_t*)(ws + WS_ABT); const bf16_t* csl = (const bf16_t*)(ws + WS_CS); const bf16_t* csc = (const bf16_t*)(ws + WS_CSC);
            unsigned char* outx = ws + WS_OUTX;
            constexpr int NPOS = 2048;
            (void)NPOS;
            for (int rnd = 0; rnd < 4; ++rnd) for (int vs = slot; vs < 64; vs += nsl) {
                int kind = -1, v = 0;
                const int xb = xq, sl = vs - 16;
                if (rnd == 0) { if (vs < 16) { kind = 1; v = xb * 16 + vs; } else { kind = 0; v = xb * 96 + sl; } }
                else if (rnd == 1) { if (vs < 16) { if (!last) { if (vs < 12) { kind = 3; v = xb * 12 + vs; } else { kind = 5; v = xb * 4 + (vs - 12); } } } else { kind = 0; v = xb * 96 + 48 + sl; } }
                else if (rnd == 2) { if (vs < 12) { if (!last) { kind = 4; v = xb * 12 + vs; } } else if (vs == 12) { kind = 6; v = xb; } else if (vs >= 16) { kind = 2; v = xb * 96 + sl; } }
                else { if (vs >= 16) { kind = 2; v = xb * 96 + 48 + sl; } }
                if (kind == 0) {
                    const int b = v / 96, r = v % 96, h = r >> 4, qb = r & 15;
                    const int qt = b * SEQ + qb * 128;
                    attn_unit<96, false>(qraw + (long)qt * 576 + h * 96, 576, km + h * 96, 576, vmt + (long)h * 64 * T,
                                         b * SEQ, 16, TL + b * CL, 2, 0, 0, 0.f, false, outx + (long)qt * D + 256 + h * 64, lds, tid,
                                         P.in[I_MQG] + l * 96, ropeM, qb * 128, 0.10206207261596577f * LOG2E);
                } else if (kind == 1) {
                    const int b = v >> 4, mt = (v >> 1) & 7, nt = v & 1;
                    GemmDesc g; g.A = csl + (long)mt * 128 * 4096; g.lda = 4096; g.B = abt + ((long)b * 256 + nt * 128) * 4096; g.ldb = 4096; g.K = 2048;
                    g.aidx = nullptr; g.aidx_stride = 0; g.mvalid = 128;
                    f32x4 acc[4][4], acc2[4][4];
                    GEMM_SEL(3, g, acc);
                    g.A += 2048; g.B += 2048;
                    GEMM_SEL(3, g, acc2);
#pragma unroll
                    for (int mb = 0; mb < 4; ++mb) {
                        const int np = mt * 128 + wr * 64 + mb * 16 + fr;
                        const long t1 = (long)b * SEQ + np, t2 = (long)b * SEQ + ((SEQ - np) & (SEQ - 1));
#pragma unroll
                        for (int nb = 0; nb < 4; ++nb) {
                            const f32x4 p = acc[mb][nb] + acc2[mb][nb], m = acc[mb][nb] - acc2[mb][nb];
                            const int col = nt * 128 + wc * 64 + nb * 16 + fq * 4;
                            *(unsigned*)(outx + t1 * D + col) = cvt4_fp8(p[0] * OUT8_SCALE, p[1] * OUT8_SCALE, p[2] * OUT8_SCALE, p[3] * OUT8_SCALE);
                            if (np != 0) *(unsigned*)(outx + t2 * D + col) = cvt4_fp8(m[0] * OUT8_SCALE, m[1] * OUT8_SCALE, m[2] * OUT8_SCALE, m[3] * OUT8_SCALE);
                        }
                    }
                } else if (kind == 6) {
                    const int b = v;
                    const bf16_t* arow = abt + ((long)b * 256 + tid) * 4096;
                    float s0 = 0.f, s1 = 0.f, s2 = 0.f, s3 = 0.f;
                    for (int n = 0; n < 2048; n += 16) {
                        const u32x4 q0 = *(const u32x4*)(arow + n), q1 = *(const u32x4*)(arow + n + 8);
                        s0 += bf_lo(q0.x) - bf_hi(q0.x) + bf_lo(q0.y) - bf_hi(q0.y);
                        s1 += bf_lo(q0.z) - bf_hi(q0.z) + bf_lo(q0.w) - bf_hi(q0.w);
                        s2 += bf_lo(q1.x) - bf_hi(q1.x) + bf_lo(q1.y) - bf_hi(q1.y);
                        s3 += bf_lo(q1.z) - bf_hi(q1.z) + bf_lo(q1.w) - bf_hi(q1.w);
                    }
                    const float cN = bf_lo(cvt_pk_bf16(0.022097086912079608f, 0.f));
                    outx[((long)b * SEQ + 1024) * D + tid] = (unsigned char)(cvt4_fp8(((s0 + s1) + (s2 + s3)) * cN * OUT8_SCALE, 0.f, 0.f, 0.f) & 0xffu);
                } else if (kind == 2) {
                    const int b = v / 96, r = v % 96, h = r >> 4, qb = r & 15, kvh = h / 3;
                    const int qt = b * SEQ + qb * 128;
                    int k0 = qb * 128 - 128; if (k0 < 0) k0 = 0;
                    int k1 = qb * 128 + 256; if (k1 > SEQ) k1 = SEQ;
                    const float sink2 = P.in[I_SINK][l * 6 + h] * LOG2E;
                    attn_unit<64, true>(pbq + (long)qt * DIN + PC_QS + h * 64, DIN, ks + kvh * 64, 128, vst + (long)kvh * 64 * T,
                                        b * SEQ + k0, (k1 - k0) >> 7, TL + b * CL, 2, qb * 128, k0, sink2, true, outx + (long)qt * D + 640 + h * 64, lds, tid,
                                        P.in[I_SQG] + l * 64, ropeS, qb * 128, 0.125f * LOG2E);
                } else if (kind == 3) {
                    const int b = v / 12, r = v % 12, h = r >> 1, qb = r & 1;
                    const int qt = TL + b * CL + qb * 128;
                    attn_unit<96, false>(qraw + (long)qt * 576 + h * 96, 576, km + h * 96, 576, vmt + (long)h * 64 * T,
                                         TL + b * CL, 2, 0, 0, 0, 0, 0.f, false, outx + (long)qt * D + 256 + h * 64, lds, tid,
                                         P.in[I_MQG] + l * 96, nullptr, 0, 0.10206207261596577f * LOG2E);
                } else if (kind == 4) {
                    const int b = v / 12, r = v % 12, h = r >> 1, qb = r & 1, kvh = h / 3;
                    const int qt = TL + b * CL + qb * 128;
                    const float sink2 = P.in[I_SINK][l * 6 + h] * LOG2E;
                    attn_unit<64, false>(pbq + (long)qt * DIN + PC_QS + h * 64, DIN, ks + kvh * 64, 128, vst + (long)kvh * 64 * T,
                                         TL + b * CL, 2, 0, 0, 0, 0, sink2, true, outx + (long)qt * D + 640 + h * 64, lds, tid,
                                         P.in[I_SQG] + l * 64, nullptr, 0, 0.125f * LOG2E);
                } else if (kind == 5) {
                    const int b = v >> 2, mt = (v >> 1) & 1, nt = v & 1;
                    GemmDesc g; g.A = csc + (long)mt * 128 * 512; g.lda = 512; g.B = abt + (long)8 * 256 * 4096 + ((long)b * 256 + nt * 128) * 512; g.ldb = 512; g.K = 512;
                    g.aidx = nullptr; g.aidx_stride = 0; g.mvalid = 128;
                    f32x4 acc[4][4];
                    GEMM_SEL(4, g, acc);
                    int tl = tid; asm volatile("" : "+v"(tl));
                    const int ln_ = tl & 63, wd_ = tl >> 6, wr_ = wd_ >> 1, wc_ = wd_ & 1, fr_ = ln_ & 15, fq_ = ln_ >> 4;
#pragma unroll
                    for (int mb = 0; mb < 4; ++mb) {
                        const int t = TL + b * CL + mt * 128 + wr_ * 64 + mb * 16 + fr_;
#pragma unroll
                        for (int nb = 0; nb < 4; ++nb) { const f32x4 a = acc[mb][nb] * OUT8_SCALE;
                            *(unsigned*)(outx + (long)t * D + nt * 128 + wc_ * 64 + nb * 16 + fq_ * 4) = cvt4_fp8(a[0], a[1], a[2], a[3]); }
                    }
                }
            }
            LSEAM(pb + 4); TSTAMP(5);
        }
        if (EN(6) && IN(pb + 5)) {
            PHASE_ENTER();
            const unsigned char* outx = ws + WS_OUTX;
            const unsigned char* w = ws + WS_WOUT + (size_t)l * 1024 * 1024;
            const int nu = MT_Q * 8;
            for (int u_ = slot; u_ < (last ? 16 : 18) * 8; u_ += nsl) {
                if (wsplit && u_ >= 128 && IN(pb + 6)) xcd_local_barrier(bar.bar, (unsigned*)(P.ws + WS_CTL + CTL_LB_OFF) + xq * 32, lgen, (unsigned)nsl);
                const int mt = BRT(u_ >> 3), nt = u_ & 7;
                GemmDesc8 g; g.A = outx + (long)mt * 128 * D; g.lda = D; g.B = w + (long)nt * 128 * 1024; g.ldb = 1024; g.K = 1024; g.aidx = nullptr; g.aidx_stride = 0; g.mvalid = 128;
                f32x4 acc[4][4];
                GEMM8_SEL(5, g, acc);
#pragma unroll
                for (int mb = 0; mb < 4; ++mb) {
                    const int t = mt * 128 + wr * 64 + mb * 16 + fr;
                    const int r = t < TL ? (t >> 11) : 8;
                    bf16_t* xr = xrowb(P, t);
                    const float* g1 = mod + ((long)l * 9 + r) * 6144 + 2048;
#pragma unroll
                    for (int nb = 0; nb < 4; ++nb) {
                        const int col = nt * 128 + wc * 64 + nb * 16 + fq * 4;
                        const f32x4 gv = *(const f32x4*)(g1 + col);
                        f32x4 xv = xb_unpack(*(const u32x2*)(xr + col));
                        xv += gv * (acc[mb][nb] * (1.0f / (W8_SCALE * OUT8_SCALE)));
                        *(u32x2*)(xr + col) = xb_pack(xv);
                    }
                }
            }
            if (wsplit) {
                if (IN(pb + 6)) {
                    if (slot >= 16) xcd_local_barrier(bar.bar, (unsigned*)(P.ws + WS_CTL + CTL_LB_OFF) + xq * 32, lgen, (unsigned)nsl);
                    else xcd_local_barrier(bar.bar, (unsigned*)(P.ws + WS_CTL + CTL_SB_OFF) + xq * 32, sgen, 16u);
                }
            } else LSEAM(pb + 5);
            TSTAMP(6);
        }
        if (EN(7) && IN(pb + 6)) { TID_ENTER(); int l = l0; LAUNDER_S(l); phase_norm2_router(P, l, lds, tid, xq, slot, nsl, wsplit); SEAM(pb + 6); TSTAMP(7); }
        if (EN(8) && (IN(pb + 7) || IN(pb + 8))) {
            PHASE_ENTER();
            const int* cnt = (const int*)(ws + WS_CTL + CTL_CNT_OFF) + l * 16 * 32;
            const int2* list = (const int2*)(ws + WS_LIST);
            const bf16_t* hb = (const bf16_t*)(ws + WS_HBUF);
            bf16_t* act = (bf16_t*)(ws + WS_ACT); bf16_t* ysl = (bf16_t*)(ws + WS_YSLOT);
            const unsigned char* wgu8 = ws + WS_WGU + (size_t)l * NE * 1024 * 1024;
            const unsigned char* wdn8 = ws + WS_WDN + (size_t)l * NE * 1024 * 512;
            int tstart[17];
            {
                int s = 0;
#pragma unroll
                for (int e = 0; e < 16; ++e) { tstart[e] = s; s += (__builtin_amdgcn_readfirstlane(cnt[e * 32]) + 127) >> 7; }
                tstart[16] = s;
            }
            const int nu = tstart[16] * 8;
            if (IN(pb + 7)) {
                XCD_LOOP(tstart[16], 8, rt, nt) {
                    int e = 0;
#pragma unroll
                    for (int j = 1; j < 16; ++j) if (rt >= tstart[j]) e = j;
                    int ts_e = 0;
#pragma unroll
                    for (int j = 0; j < 16; ++j) if (j == e) ts_e = tstart[j];
                    const int mt = rt - ts_e, ce = cnt[e * 32], mv = (ce - mt * 128) < 128 ? (ce - mt * 128) : 128;
                    GemmDesc8 g; g.A = (const unsigned char*)hb; g.lda = D; g.B = (const unsigned char*)wgu8 + ((long)e * 1024 + nt * 128) * 1024; g.ldb = 1024; g.K = 1024;
                    g.aidx = (const int*)(list + (long)e * T + mt * 128); g.aidx_stride = 2; g.mvalid = mv;
                    f32x4 acc[4][4];
                    GEMM8_SEL(6, g, acc);
#pragma unroll
                    for (int mb = 0; mb < 4; ++mb) {
                        const int rl = wr * 64 + mb * 16 + fr;
                        if (rl < mv) {
                            unsigned char* ar = (unsigned char*)act + ((long)rt * 128 + rl) * DE + nt * 64 + wc * 32 + fq * 4;
#pragma unroll
                            for (int p = 0; p < 2; ++p) {
                                const f32x4 gt = acc[mb][2 * p] * (1.0f / W8_SCALE), up = acc[mb][2 * p + 1] * (ACT8_SCALE / W8_SCALE);
                                *(unsigned*)(ar + p * 16) = cvt4_fp8(silu_f(gt[0]) * up[0], silu_f(gt[1]) * up[1], silu_f(gt[2]) * up[2], silu_f(gt[3]) * up[3]);
                            }
                        }
                    }
                }
                SEAM(pb + 7); TSTAMP(8);
            }
            if (IN(pb + 8)) {
                XCD_LOOP(tstart[16], 8, rt, nt) {
                    int e = 0;
#pragma unroll
                    for (int j = 1; j < 16; ++j) if (rt >= tstart[j]) e = j;
                    int ts_e = 0;
#pragma unroll
                    for (int j = 0; j < 16; ++j) if (j == e) ts_e = tstart[j];
                    const int mt = rt - ts_e, ce = cnt[e * 32], mv = (ce - mt * 128) < 128 ? (ce - mt * 128) : 128;
                    GemmDesc8 g; g.A = (const unsigned char*)act + (long)rt * 128 * DE; g.lda = DE; g.B = (const unsigned char*)wdn8 + ((long)e * 1024 + nt * 128) * 512; g.ldb = 512; g.K = 512;
                    g.aidx = nullptr; g.aidx_stride = 0; g.mvalid = 128;
                    f32x4 acc[4][4];
                    GEMM8_SEL(7, g, acc);
#pragma unroll
                    for (int mb = 0; mb < 4; ++mb) {
                        const int rl = wr * 64 + mb * 16 + fr;
                        if (rl < mv) {
                            const int2 le = list[(long)e * T + mt * 128 + rl];
                            const float wgt = __int_as_float(le.y) * (Y8_SCALE / (ACT8_SCALE * W8_SCALE));
                            unsigned char* yr = (unsigned char*)ysl + (long)le.x * D + nt * 128 + wc * 64 + fq * 4;
#pragma unroll
                            for (int nb = 0; nb < 4; ++nb) { const f32x4 a = acc[mb][nb] * wgt; *(unsigned*)(yr + nb * 16) = cvt4_fp8(a[0], a[1], a[2], a[3]); }
                        }
                    }
                }
                SEAM(pb + 8); TSTAMP(9);
            }
        }
    }
    if (EN(9) && IN(1 + DEPTH * 9)) { TID_ENTER(); phase_final(P, tid); }
#undef IN
#undef SEAM
}


#ifndef DUMP_MASK
#define DUMP_MASK 0
#endif
__device__ __forceinline__ float dbg_ld(const unsigned char* ws, size_t off, size_t len, size_t i) { return bf2f(((const bf16_t*)(ws + off))[i % len]); }
__global__ void dump_kernel(float* out, const unsigned char* ws, int mask) {
    const size_t n = (size_t)TL * D;
    for (size_t i = (size_t)blockIdx.x * blockDim.x + threadIdx.x; i < n; i += (size_t)gridDim.x * blockDim.x) {
        float v = 0.f;
        if (mask & 1) v += dbg_ld(ws, WS_HBUF, (size_t)T * D, i);
        if (mask & 2) v += dbg_ld(ws, WS_PBUF, (size_t)T * DIN, i) + dbg_ld(ws, WS_PBUF, (size_t)T * DIN, i + 7500000) + dbg_ld(ws, WS_VST, (size_t)128 * T, i);
        if (mask & 4) v += dbg_ld(ws, WS_QRAW, (size_t)T * 576, i) + dbg_ld(ws, WS_KNRAW, (size_t)T * 384, i) + dbg_ld(ws, WS_VMT, (size_t)T * 384, i) + dbg_ld(ws, WS_ABT, (size_t)T * 512, i);
        if (mask & 8) v += dbg_ld(ws, WS_QM, (size_t)T * 576, i) + dbg_ld(ws, WS_KM, (size_t)T * 576, i) + dbg_ld(ws, WS_QS, (size_t)T * 384, i) + dbg_ld(ws, WS_KS, (size_t)T * 128, i);
        if (mask & 16) v += dbg_ld(ws, WS_OUTX, (size_t)T * D, i);
        { const int c = (int)(i & 1023); const bool sel = ((mask & 64) && c < 256) || ((mask & 128) && c >= 256 && c < 640) || ((mask & 256) && c >= 640);
          if (sel) v += dbg_ld(ws, WS_OUTX, (size_t)T * D, i); }
        if (mask & 32) v += dbg_ld(ws, WS_CS, (size_t)2048 * 4096, i) + dbg_ld(ws, WS_WOUT, (size_t)4 * 1024 * 1024, i) + dbg_ld(ws, WS_WGU, (size_t)64 * 1024 * 1024, i) + dbg_ld(ws, WS_WDN, (size_t)64 * 1024 * 512, i)
                         + ((const float*)(ws + WS_MOD))[i % (size_t)(4 * 9 * 6144)] + ((const float*)(ws + WS_ROPES))[i % (size_t)(2048 * 64)] + ((const float*)(ws + WS_ROPEM))[i % (size_t)(2048 * 32)] + dbg_ld(ws, WS_FW, (size_t)16 * 128 * 128, i);
        out[i] = v;
    }
}
extern "C" void kernel_launch(void* const* d_in, const int* in_sizes, int n_in, void* d_out, int out_size, void* d_ws, size_t ws_size, hipStream_t stream) {
    static int grid = 0;
    if (grid == 0) {
        if (n_in != 26 || ws_size < WS_END) { fprintf(stderr, "kernel_launch: expected 26 inputs and >= %zu bytes of workspace (got %d, %zu)\n", (size_t)WS_END, n_in, ws_size); grid = -1; return; }
        int dev = 0, cus = 0, per_cu = 0;
        hipGetDevice(&dev);
        hipDeviceGetAttribute(&cus, hipDeviceAttributeMultiprocessorCount, dev);
        hipFuncSetAttribute((const void*)fwd_kernel, hipFuncAttributeMaxDynamicSharedMemorySize, LDS_BYTES);
        if (hipOccupancyMaxActiveBlocksPerMultiprocessor(&per_cu, (const void*)fwd_kernel, NTHREADS, LDS_BYTES) != hipSuccess || per_cu < 1) per_cu = 1;
        (void)hipGetLastError();
        grid = cus * (per_cu < 2 ? per_cu : 2);
    }
    if (grid < 0) return;
    hipMemsetAsync((char*)d_ws + WS_CTL, 0, CTL_BYTES, stream);
    Params p{};
    for (int i = 0; i < 26; ++i) p.in[i] = (const float*)d_in[i];
    p.out = (float*)d_out; p.ws = (unsigned char*)d_ws;
#ifndef STOP_PH
#define STOP_PH (2 + DEPTH * 9)
#endif
    constexpr int NPH = STOP_PH;
#if N_LAUNCH_MODE == 1
    p.ph_lo = 0; p.ph_hi = NPH;
    hipLaunchKernelGGL(fwd_kernel, dim3(grid), dim3(NTHREADS), LDS_BYTES, stream, p);
#else
    for (int k = 0; k < NPH; ++k) { p.ph_lo = k; p.ph_hi = k + 1; hipLaunchKernelGGL(fwd_kernel, dim3(grid), dim3(NTHREADS), LDS_BYTES, stream, p); }
#endif
    if (DUMP_MASK) hipLaunchKernelGGL(dump_kernel, dim3(1024), dim3(256), 0, stream, (float*)d_out, (const unsigned char*)d_ws, (int)DUMP_MASK);
}
```
